# Optimizing an MI355X kernel written in HIP

```python
import math
import jax, jax.numpy as jnp
from jax import lax
import numpy as np

D_MODEL = 1024
BATCH = 16
SEQ = 2048
DEPTH = 2

CHUNK = 64
Q_BLOCK = 128

MLA_HEADS = 8
QK_NOPE_DIM = 64
QK_ROPE_DIM = 32
QK_HEAD_DIM = QK_NOPE_DIM + QK_ROPE_DIM
V_HEAD_DIM = 64
MLA_WIDTH = MLA_HEADS * V_HEAD_DIM
Q_LORA_RANK = 384
KV_LORA_RANK = 256
ROPE_THETA = 10000.0

SSM_WIDTH = 512
SSM_GROUP = 16
SSM_GROUPS = SSM_WIDTH // SSM_GROUP
SSM_STATE = 64
DT_MIN = 0.001
DT_MAX = 0.1

N_BRANCH = 2

COL_SPLITS = [
    Q_LORA_RANK,
    Q_LORA_RANK + KV_LORA_RANK,
    Q_LORA_RANK + KV_LORA_RANK + QK_ROPE_DIM,
    Q_LORA_RANK + KV_LORA_RANK + QK_ROPE_DIM + SSM_WIDTH,
]
IN_COLS = COL_SPLITS[-1] + N_BRANCH * D_MODEL

N_EXPERT_GROUPS = 4
EXPERTS_PER_GROUP = 8
N_EXPERTS = N_EXPERT_GROUPS * EXPERTS_PER_GROUP
TOP_K = 2
D_EXPERT = 256

EPS = 1e-6

kernel_name = "hybrid_mla_s5_hmoe_streaming"


def rmsnorm(x, g):
    xf = x.astype(jnp.float32)
    y = xf * lax.rsqrt(jnp.mean(xf * xf, axis=-1, keepdims=True) + EPS)
    return (y * g.astype(jnp.float32)).astype(x.dtype)


def rope_tables(positions):
    half = QK_ROPE_DIM // 2
    inv_freq = ROPE_THETA ** (-jnp.arange(half, dtype=jnp.float32) / half)
    ang = positions.astype(jnp.float32)[..., None] * inv_freq
    return jnp.cos(ang)[:, :, None, :], jnp.sin(ang)[:, :, None, :]


def apply_rope(x, cos, sin):
    half = QK_ROPE_DIM // 2
    x1, x2 = x[..., :half], x[..., half:]
    return jnp.concatenate([x1 * cos - x2 * sin, x2 * cos + x1 * sin], axis=-1).astype(x.dtype)


def mla_branch(q_c, kv_c, k_r, cos, sin, q_lora_g, w_uq, kv_lora_g, w_ukv,
               q_head_g, k_head_g, w_attn_proj):
    bsz, seq, _ = q_c.shape
    q = (rmsnorm(q_c, q_lora_g) @ w_uq).reshape(bsz, seq, MLA_HEADS, QK_HEAD_DIM)
    kv = (rmsnorm(kv_c, kv_lora_g) @ w_ukv).reshape(bsz, seq, MLA_HEADS, QK_NOPE_DIM + V_HEAD_DIM)
    k_nope, v = kv[..., :QK_NOPE_DIM], kv[..., QK_NOPE_DIM:]
    k_pe = jnp.broadcast_to(k_r[:, :, None, :], (bsz, seq, MLA_HEADS, QK_ROPE_DIM))
    k = jnp.concatenate([k_nope, k_pe], axis=-1)
    q = rmsnorm(q, q_head_g)
    k = rmsnorm(k, k_head_g)
    q = jnp.concatenate([q[..., :QK_NOPE_DIM], apply_rope(q[..., QK_NOPE_DIM:], cos, sin)], axis=-1)
    k = jnp.concatenate([k[..., :QK_NOPE_DIM], apply_rope(k[..., QK_NOPE_DIM:], cos, sin)], axis=-1)

    scale = QK_HEAD_DIM ** -0.5
    outs = []
    for qs in range(0, seq, Q_BLOCK):
        ke = qs + Q_BLOCK
        s = jnp.einsum('bqhd,bkhd->bhqk', q[:, qs:ke], k[:, :ke],
                       preferred_element_type=jnp.float32) * scale
        q_chunk = (qs + jnp.arange(Q_BLOCK)) // CHUNK
        k_chunk = jnp.arange(ke) // CHUNK
        mask = k_chunk[None, :] <= q_chunk[:, None]
        s = jnp.where(mask, s, jnp.finfo(jnp.float32).min)
        p = jax.nn.softmax(s, axis=-1).astype(v.dtype)
        outs.append(jnp.einsum('bhqk,bkhd->bqhd', p, v[:, :ke]))
    o = jnp.concatenate(outs, axis=1).reshape(bsz, seq, MLA_WIDTH)
    return o @ w_attn_proj


def _scan_combine(e1, e2):
    a1, b1 = e1
    a2, b2 = e2
    return a1 * a2, a2 * b1 + b2


def s5_branch(u, lam_re, lam_im, log_dt, b_re, b_im, c_re, c_im, d_skip, w_glu):
    bsz, seq, _ = u.shape
    uf = u.astype(jnp.float32).reshape(bsz, seq, SSM_GROUPS, SSM_GROUP)
    lam = lax.complex(lam_re.astype(jnp.float32), lam_im.astype(jnp.float32))
    dt = jnp.exp(log_dt.astype(jnp.float32))[:, None]
    lam_bar = jnp.exp(lam * dt)
    b = lax.complex(b_re.astype(jnp.float32), b_im.astype(jnp.float32))
    b_bar = ((lam_bar - 1.0) / lam)[..., None] * b
    bu = jnp.einsum('blgi,gpi->blgp', uf.astype(jnp.complex64), b_bar)
    a = jnp.broadcast_to(lam_bar[None, None], (1, seq, SSM_GROUPS, SSM_STATE))
    _, states = lax.associative_scan(_scan_combine, (a, bu), axis=1)
    c = lax.complex(c_re.astype(jnp.float32), c_im.astype(jnp.float32))
    y = jnp.einsum('blgp,gip->blgi', states, c).real + d_skip.astype(jnp.float32) * uf
    y = jax.nn.gelu(y.reshape(bsz, seq, SSM_WIDTH)).astype(u.dtype)
    vg = y @ w_glu
    val, gate = vg[..., :D_MODEL], vg[..., D_MODEL:]
    return val * jax.nn.sigmoid(gate)


def hier_moe(h, w_router_group, w_router_expert, w_exp_gate, w_exp_up, w_exp_down):
    bsz, seq, d = h.shape
    t = h.reshape(-1, d)
    n_tok = t.shape[0]
    g_prob = jax.nn.softmax((t @ w_router_group).astype(jnp.float32), axis=-1)
    g_idx = jnp.argmax(g_prob, axis=-1)
    g_w = jnp.take_along_axis(g_prob, g_idx[:, None], axis=-1)
    e_logits = (t @ w_router_expert).astype(jnp.float32).reshape(n_tok, N_EXPERT_GROUPS, EXPERTS_PER_GROUP)
    e_logits = jnp.take_along_axis(e_logits, g_idx[:, None, None], axis=1)[:, 0]
    e_prob = jax.nn.softmax(e_logits, axis=-1)
    top_w, top_i = lax.top_k(e_prob, TOP_K)
    top_w = top_w / jnp.sum(top_w, axis=-1, keepdims=True) * g_w
    eid = g_idx[:, None] * EXPERTS_PER_GROUP + top_i
    combine = jnp.sum(jax.nn.one_hot(eid, N_EXPERTS, dtype=jnp.float32) * top_w[..., None], axis=1)
    out = jnp.zeros((n_tok, d), jnp.float32)
    for e in range(N_EXPERTS):
        hidden = jax.nn.silu(t @ w_exp_gate[e]) * (t @ w_exp_up[e])
        out = out + (hidden @ w_exp_down[e]).astype(jnp.float32) * combine[:, e:e + 1]
    return out.astype(h.dtype).reshape(bsz, seq, d)


def setup_inputs(seed: int = 0) -> dict:
    key = jax.random.key(seed)
    ks = jax.random.split(key, 32)
    f32 = jnp.float32

    def nrm(k, shape, fan_in):
        return jax.random.normal(k, shape, f32) * (fan_in ** -0.5)

    def gain(k, shape):
        return 1.0 + 0.02 * jax.random.normal(k, shape, f32)

    x = jax.random.normal(ks[0], (BATCH, SEQ, D_MODEL), f32)
    offset = jax.random.randint(ks[1], (BATCH, 1), 0, 64, jnp.int32) * CHUNK
    positions = (offset + jnp.arange(SEQ, dtype=jnp.int32)[None, :]).astype(jnp.int32)

    n_idx = jnp.arange(SSM_STATE, dtype=f32)
    lam_re = -0.5 * (1.0 + 0.02 * jax.random.normal(ks[2], (DEPTH, SSM_GROUPS, SSM_STATE), f32))
    lam_im = math.pi * n_idx[None, None, :] + 0.01 * jax.random.normal(ks[3], (DEPTH, SSM_GROUPS, SSM_STATE), f32)
    log_dt = jax.random.uniform(ks[4], (DEPTH, SSM_GROUPS), f32, math.log(DT_MIN), math.log(DT_MAX))

    return {
        "x": x,
        "positions": positions,
        "norm_mix_g": gain(ks[5], (DEPTH, D_MODEL)),
        "w_in": nrm(ks[6], (DEPTH, D_MODEL, IN_COLS), D_MODEL),
        "q_lora_g": gain(ks[7], (DEPTH, Q_LORA_RANK)),
        "w_uq": nrm(ks[8], (DEPTH, Q_LORA_RANK, MLA_HEADS * QK_HEAD_DIM), Q_LORA_RANK),
        "kv_lora_g": gain(ks[9], (DEPTH, KV_LORA_RANK)),
        "w_ukv": nrm(ks[10], (DEPTH, KV_LORA_RANK, MLA_HEADS * (QK_NOPE_DIM + V_HEAD_DIM)), KV_LORA_RANK),
        "q_head_g": gain(ks[11], (DEPTH, QK_HEAD_DIM)),
        "k_head_g": gain(ks[12], (DEPTH, QK_HEAD_DIM)),
        "w_attn_proj": nrm(ks[13], (DEPTH, MLA_WIDTH, D_MODEL), MLA_WIDTH),
        "lam_re": lam_re,
        "lam_im": lam_im,
        "log_dt": log_dt,
        "b_re": nrm(ks[14], (DEPTH, SSM_GROUPS, SSM_STATE, SSM_GROUP), 2 * SSM_GROUP),
        "b_im": nrm(ks[15], (DEPTH, SSM_GROUPS, SSM_STATE, SSM_GROUP), 2 * SSM_GROUP),
        "c_re": nrm(ks[16], (DEPTH, SSM_GROUPS, SSM_GROUP, SSM_STATE), 2 * SSM_STATE),
        "c_im": nrm(ks[17], (DEPTH, SSM_GROUPS, SSM_GROUP, SSM_STATE), 2 * SSM_STATE),
        "d_skip": jax.random.normal(ks[18], (DEPTH, SSM_GROUPS, SSM_GROUP), f32),
        "w_glu": nrm(ks[19], (DEPTH, SSM_WIDTH, 2 * D_MODEL), SSM_WIDTH),
        "w_out": nrm(ks[20], (DEPTH, D_MODEL, D_MODEL), D_MODEL),
        "norm_ffn_g": gain(ks[21], (DEPTH, D_MODEL)),
        "w_router_group": nrm(ks[22], (DEPTH, D_MODEL, N_EXPERT_GROUPS), D_MODEL),
        "w_router_expert": nrm(ks[23], (DEPTH, D_MODEL, N_EXPERTS), D_MODEL),
        "w_exp_gate": nrm(ks[24], (DEPTH, N_EXPERTS, D_MODEL, D_EXPERT), D_MODEL),
        "w_exp_up": nrm(ks[25], (DEPTH, N_EXPERTS, D_MODEL, D_EXPERT), D_MODEL),
        "w_exp_down": nrm(ks[26], (DEPTH, N_EXPERTS, D_EXPERT, D_MODEL), D_EXPERT),
    }


def reference(x, positions, norm_mix_g, w_in, q_lora_g, w_uq, kv_lora_g, w_ukv,
              q_head_g, k_head_g, w_attn_proj, lam_re, lam_im, log_dt, b_re, b_im,
              c_re, c_im, d_skip, w_glu, w_out, norm_ffn_g, w_router_group,
              w_router_expert, w_exp_gate, w_exp_up, w_exp_down):
    bsz, seq, _ = x.shape
    cos, sin = rope_tables(positions)
    for l in range(DEPTH):
        h = rmsnorm(x, norm_mix_g[l])
        proj = h @ w_in[l]
        q_c, kv_c, k_r, u, gates = jnp.split(proj, COL_SPLITS, axis=-1)
        y_attn = mla_branch(q_c, kv_c, k_r, cos, sin, q_lora_g[l], w_uq[l], kv_lora_g[l],
                            w_ukv[l], q_head_g[l], k_head_g[l], w_attn_proj[l])
        y_ssm = s5_branch(u, lam_re[l], lam_im[l], log_dt[l], b_re[l], b_im[l],
                          c_re[l], c_im[l], d_skip[l], w_glu[l])
        g = jax.nn.sigmoid(gates).reshape(bsz, seq, N_BRANCH, D_MODEL)
        merged = g[:, :, 0, :] * y_attn + g[:, :, 1, :] * y_ssm
        x = x + merged @ w_out[l]
        h = rmsnorm(x, norm_ffn_g[l])
        x = x + hier_moe(h, w_router_group[l], w_router_expert[l], w_exp_gate[l],
                         w_exp_up[l], w_exp_down[l])
    return x
```

```cpp
#include <hip/hip_runtime.h>
#include <cstdio>
#include <cstdint>

#define GAS __attribute__((address_space(1)))
#define LAS __attribute__((address_space(3)))
typedef unsigned short bf16_t;
typedef short bf16x8 __attribute__((ext_vector_type(8)));
typedef short s16x4 __attribute__((ext_vector_type(4)));
typedef float f32x4 __attribute__((ext_vector_type(4)));
typedef float f32x2 __attribute__((ext_vector_type(2)));
typedef float f32x16 __attribute__((ext_vector_type(16)));
typedef unsigned u32x4 __attribute__((ext_vector_type(4)));
typedef unsigned u32x2 __attribute__((ext_vector_type(2)));

constexpr int NB = 16, SEQ = 2048, DM = 1024, MT = NB * SEQ, DEPTH = 2;
constexpr int NH = 8, DQK = 96, DV = 64, QL = 384, KVL = 256, DR = 32;
constexpr int SSW = 512, SSG = 32, SSP = 64;
constexpr int LC = 32, NCH = SEQ / LC, KIN = LC * 16 + 128;
constexpr int NIN = 3328;
constexpr int NE = 32, DE = 256;
constexpr float EPS = 1e-6f;
constexpr int MAXTILES = 320, MAXROWS = MAXTILES * 256;

__device__ __forceinline__ unsigned f2bf(float f) { unsigned u = __builtin_bit_cast(unsigned, f); return (u + 0x7fffu + ((u >> 16) & 1u)) >> 16; }
__device__ __forceinline__ unsigned pk2(float lo, float hi) { return f2bf(lo) | (f2bf(hi) << 16); }
__device__ __forceinline__ float bf2f(unsigned short h) { return __builtin_bit_cast(float, (unsigned)h << 16); }
__device__ __forceinline__ float bflo(unsigned w) { return __builtin_bit_cast(float, w << 16); }
__device__ __forceinline__ float bfhi(unsigned w) { return __builtin_bit_cast(float, w & 0xffff0000u); }
__device__ __forceinline__ unsigned cvt_pk_bf16(float lo, float hi) { unsigned r; asm volatile("v_cvt_pk_bf16_f32 %0, %1, %2" : "=v"(r) : "v"(lo), "v"(hi)); return r; }
__device__ __forceinline__ float fast_sigmoid(float v) { return __builtin_amdgcn_rcpf(1.0f + __builtin_amdgcn_exp2f(-1.4426950408889634f * v)); }


__device__ __forceinline__ void swap16(float v, float& a, float& b) { const unsigned u = __builtin_bit_cast(unsigned, v); auto r = __builtin_amdgcn_permlane16_swap(u, u, false, false); const unsigned x = r[0], y = r[1]; a = __builtin_bit_cast(float, x); b = __builtin_bit_cast(float, y); }
__device__ __forceinline__ void swap32(float v, float& a, float& b) { const unsigned u = __builtin_bit_cast(unsigned, v); auto r = __builtin_amdgcn_permlane32_swap(u, u, false, false); const unsigned x = r[0], y = r[1]; a = __builtin_bit_cast(float, x); b = __builtin_bit_cast(float, y); }
__device__ __forceinline__ float sum_x16(float v) { float a, b; swap16(v, a, b); return a + b; }
__device__ __forceinline__ float sum_x32(float v) { float a, b; swap32(v, a, b); return a + b; }
__device__ __forceinline__ float max_x16(float v) { float a, b; swap16(v, a, b); return fmaxf(a, b); }
__device__ __forceinline__ float max_x32(float v) { float a, b; swap32(v, a, b); return fmaxf(a, b); }
__device__ __forceinline__ float from_x32(float v, int lane_hi) { float a, b; swap32(v, a, b); return lane_hi ? a : b; }
template <int CTRL> __device__ __forceinline__ float dpp_f(float v) { const int u = __builtin_bit_cast(int, v); return __builtin_bit_cast(float, __builtin_amdgcn_update_dpp(u, u, CTRL, 0xf, 0xf, false)); }
__device__ __forceinline__ float row_sum16(float v) { v += dpp_f<0xB1>(v); v += dpp_f<0x4E>(v); v += dpp_f<0x124>(v); v += dpp_f<0x128>(v); return v; }
__device__ __forceinline__ float row_max16(float v) { v = fmaxf(v, dpp_f<0xB1>(v)); v = fmaxf(v, dpp_f<0x4E>(v)); v = fmaxf(v, dpp_f<0x124>(v)); v = fmaxf(v, dpp_f<0x128>(v)); return v; }

namespace pg8 {
constexpr int BM = 256, BK = 64, HALF = 128, HTB = HALF * BK * 2, STAGE_BYTES = 8 * HTB, NXCD = 8, WGM = 8;
__host__ __device__ __forceinline__ int lds_byte(int r, int c) { const int st = (r >> 4) * 2 + (c >> 5), rr = r & 15, cc = c & 31, ob = rr * 64 + cc * 2; return st * 1024 + (ob ^ (((ob >> 9) & 1) << 5)); }
__host__ __device__ __forceinline__ void stage_rc(int b, int& R, int& C) { const int st = b / 1024, sb = b % 1024, swz = sb ^ (((sb >> 9) & 1) << 5); R = (st >> 1) * 16 + swz / 64; C = (st & 1) * 32 + (swz % 64) / 2; }
__host__ __device__ __forceinline__ int perm32(int rho) { const int n = rho >> 4, i = rho & 15; return 8 * (i >> 2) + 4 * n + (i & 3); }

struct Unit { int pm, pn; };
struct Gemm { const bf16_t* A; const bf16_t* Bt; int K; int lda; int flags = 0; };

struct StaticOrder {
    static constexpr bool GATHER = false;
    int nM, nN, nwg, G, c;
    __device__ void init(int M, int N, int G_, int c_) { nM = M / BM; nN = N / BM; nwg = nM * nN; G = G_; c = c_; }
    __device__ bool next(int i, Unit& u) const {
        const long L = (long)i * G + c; if (L >= nwg) return false;
        int wgid = (int)L; { const int q = nwg / NXCD, r = nwg % NXCD, xcd = wgid % NXCD, off = wgid / NXCD; wgid = (xcd < r ? xcd * (q + 1) : r * (q + 1) + (xcd - r) * q) + off; }
        const int nig = WGM * nN, gid = wgid / nig, fm = gid * WGM, gsz = (nM - fm) < WGM ? (nM - fm) : WGM;
        u.pm = fm + ((wgid % nig) % gsz); u.pn = (wgid % nig) / gsz; return true;
    }
};

template <class Epi, class Sched>
__device__ __forceinline__ void gemm_phase(LAS unsigned char* lds, LAS int* idxlds, const Gemm g, const Sched& S, const Epi& E) {
    int tid_ = threadIdx.x; asm volatile("" : "+v"(tid_));
    const int tid = tid_, wid = __builtin_amdgcn_readfirstlane(tid >> 6), lane = tid & 63, wr = wid >> 2, wc = wid & 3, fr = lane & 15, fq = lane >> 4;
    const int K = g.K, nt = K / BK, lda = g.lda;
    unsigned voffB[2], vA[2][2], vAn[2][2];
#pragma unroll
    for (int i = 0; i < 2; ++i) { int R, C; stage_rc(tid * 16 + i * 8192, R, C); const int Rb = Epi::PERM ? ((R & ~31) + perm32(R & 31)) : R;
        voffB[i] = (unsigned)(Rb * K + C) * 2u;
        vA[0][i] = (unsigned)(R * lda + C) * 2u; vA[1][i] = vA[0][i]; vAn[0][i] = vA[0][i]; vAn[1][i] = vA[0][i]; }
    const unsigned kstep = (unsigned)(BK * 2);
    const unsigned hstepB = (unsigned)HALF * K * 2, tstepB = 2 * hstepB;
    const unsigned hstepA = Sched::GATHER ? 0u : (unsigned)HALF * lda * 2, tstepA = Sched::GATHER ? 0u : (unsigned)BM * lda * 2;
    const unsigned ldsw = (unsigned)wid * 1024u;
    const int aoff = lds_byte(wr * 64 + fr, fq * 8), boff = lds_byte(wc * 32 + fr, fq * 8);
#define PG8_SA(b, h) (((b) * 2 + (h)) * HTB)
#define PG8_SB(b, h) ((4 + (b) * 2 + (h)) * HTB)
#define PG8_STAGE(bufoff, gbase, voff) do { const char* gb_ = (const char*)(gbase); asm volatile("" : "+s"(gb_));   \
        _Pragma("unroll") for (int _i = 0; _i < 2; ++_i) \
        __builtin_amdgcn_global_load_lds((const unsigned*)(gb_ + (voff)[_i]), (LAS unsigned*)(lds + (bufoff) + ldsw + _i * 8192), 16, 0, 0); } while (0)
#define PG8_STAGE_A(bufoff, gbase, h, NXT) do { if constexpr (Sched::GATHER) { if (NXT) PG8_STAGE(bufoff, gbase, vAn[h]); else PG8_STAGE(bufoff, gbase, vA[h]); } \
        else PG8_STAGE(bufoff, (gbase) + (h) * hstepA, vA[0]); } while (0)
#define PG8_LDA(dst, b, h) do { _Pragma("unroll") for (int m = 0; m < 4; ++m) _Pragma("unroll") for (int k = 0; k < 2; ++k) dst[m][k] = *(const LAS bf16x8*)(lds + PG8_SA(b, h) + aoff + m * 2048 + k * 1024); } while (0)
#define PG8_LDB(dst, b, h) do { _Pragma("unroll") for (int n = 0; n < 2; ++n) _Pragma("unroll") for (int k = 0; k < 2; ++k) dst[n][k] = *(const LAS bf16x8*)(lds + PG8_SB(b, h) + boff + n * 2048 + k * 1024); } while (0)
#define PG8_MMA(ai, bj, At, Bt) do { __builtin_amdgcn_s_setprio(1); _Pragma("unroll") for (int m = 0; m < 4; ++m) _Pragma("unroll") for (int n = 0; n < 2; ++n) _Pragma("unroll") for (int k = 0; k < 2; ++k) \
        acc[ai][bj][m][n] = __builtin_amdgcn_mfma_f32_16x16x32_bf16(Bt[n][k], At[m][k], acc[ai][bj][m][n], 0, 0, 0); __builtin_amdgcn_s_setprio(0); } while (0)
#define PG8_WAIT_V(n) asm volatile("s_waitcnt vmcnt(" #n ")" ::: "memory")
#define PG8_WAIT_L(n) asm volatile("s_waitcnt lgkmcnt(" #n ")" ::: "memory")
#define PG8_BAR __builtin_amdgcn_s_barrier()
#define PG8_SCHED __builtin_amdgcn_sched_barrier(0)
#define PG8_GOFF(dst, ui_) do { _Pragma("unroll") for (int _i = 0; _i < 2; ++_i) { int _R, _C; stage_rc(tid * 16 + _i * 8192, _R, _C); _Pragma("unroll") for (int _h = 0; _h < 2; ++_h) \
        dst[_h][_i] = (unsigned)(idxlds[(ui_) * 256 + _h * 128 + _R] * lda + _C) * 2u; } } while (0)
    Unit cur, nxt; int ui = 0;
    if (!S.next(0, cur)) return;
    if constexpr (Sched::GATHER) {
        for (int i = 0; i < 4; ++i) { Unit u; if (!S.next(i, u)) break; if (tid < 256) { const int t = S.gidx[u.pm * 256 + tid]; idxlds[i * 256 + tid] = t < 0 ? 0 : t; } }
        asm volatile("s_waitcnt vmcnt(0) lgkmcnt(0)" ::: "memory"); __builtin_amdgcn_s_barrier(); asm volatile("" ::: "memory");
        PG8_GOFF(vA, 0);
    }
    f32x4 acc[2][2][4][2];
#pragma unroll
    for (int a = 0; a < 2; ++a)
#pragma unroll
        for (int b = 0; b < 2; ++b)
#pragma unroll
            for (int m = 0; m < 4; ++m)
#pragma unroll
                for (int n = 0; n < 2; ++n) acc[a][b][m][n] = (f32x4){0.f, 0.f, 0.f, 0.f};
    bf16x8 At[4][2], B0[2][2], B1[2][2];
    const char* cA = (const char*)g.A + (size_t)cur.pm * (size_t)tstepA; const char* cB = (const char*)g.Bt + (size_t)cur.pn * (size_t)tstepB;
    PG8_STAGE(PG8_SB(0, 0), cB, voffB); PG8_STAGE(PG8_SB(0, 1), cB + hstepB, voffB); PG8_STAGE_A(PG8_SA(0, 0), cA, 0, false); PG8_STAGE_A(PG8_SA(0, 1), cA, 1, false);
    if (wr == 1) PG8_BAR;
    PG8_WAIT_V(2); PG8_BAR;
    PG8_STAGE(PG8_SB(1, 0), cB + kstep, voffB); PG8_STAGE_A(PG8_SA(1, 0), cA + kstep, 0, false); PG8_STAGE(PG8_SB(1, 1), cB + hstepB + kstep, voffB);
    PG8_WAIT_V(6); PG8_BAR;
    for (;;) {
        const bool has_next = S.next(ui + 1, nxt);
        const char* nA = has_next ? (const char*)g.A + (size_t)nxt.pm * (size_t)tstepA : cA; const char* nB = has_next ? (const char*)g.Bt + (size_t)nxt.pn * (size_t)tstepB : cB;
        for (int t = 0; t < nt; t += 2) {
            const bool last = (t == nt - 2);
            const char* a1 = cA + (size_t)(t + 1) * kstep;
            const char* a2 = last ? nA : cA + (size_t)(t + 2) * kstep; const char* b2 = last ? nB : cB + (size_t)(t + 2) * kstep;
            const char* a3 = a2 + kstep; const char* b3 = b2 + kstep;
            if constexpr (Sched::GATHER) { if (last) { if (has_next) PG8_GOFF(vAn, ui + 1); else {
#pragma unroll
                for (int h = 0; h < 2; ++h) { vAn[h][0] = vA[h][0]; vAn[h][1] = vA[h][1]; } } } }
            PG8_LDB(B0, 0, 0); PG8_LDB(B1, 0, 1); PG8_SCHED; PG8_LDA(At, 0, 0); PG8_STAGE_A(PG8_SA(1, 1), a1, 1, false);
            PG8_WAIT_V(8); PG8_WAIT_L(0); PG8_BAR; PG8_MMA(0, 0, At, B0); PG8_MMA(0, 1, At, B1); PG8_BAR; PG8_SCHED;
            PG8_LDA(At, 0, 1); PG8_STAGE(PG8_SB(0, 0), b2, voffB); PG8_STAGE(PG8_SB(0, 1), b2 + hstepB, voffB); PG8_STAGE_A(PG8_SA(0, 0), a2, 0, last);
            PG8_WAIT_V(8); PG8_WAIT_L(0); PG8_BAR; PG8_MMA(1, 0, At, B0); PG8_MMA(1, 1, At, B1); PG8_BAR; PG8_SCHED;
            PG8_LDB(B0, 1, 0); PG8_LDB(B1, 1, 1); PG8_SCHED; PG8_LDA(At, 1, 0); PG8_STAGE_A(PG8_SA(0, 1), a2, 1, last);
            PG8_WAIT_V(8); PG8_WAIT_L(0); PG8_BAR; PG8_MMA(0, 0, At, B0); PG8_MMA(0, 1, At, B1); PG8_BAR; PG8_SCHED;
            PG8_LDA(At, 1, 1); PG8_STAGE(PG8_SB(1, 0), b3, voffB); PG8_STAGE(PG8_SB(1, 1), b3 + hstepB, voffB); PG8_STAGE_A(PG8_SA(1, 0), a3, 0, last);
            PG8_WAIT_V(8); PG8_WAIT_L(0); PG8_BAR; PG8_MMA(1, 0, At, B0); PG8_MMA(1, 1, At, B1); PG8_BAR; PG8_SCHED;
        }
        if (wr == 0) PG8_BAR;
        if (!(g.flags & 1)) { int te = threadIdx.x; asm volatile("" : "+v"(te)); const int le = te & 63; E(acc, cur, wr, wc, le & 15, le >> 4); }
        if (!has_next) break;
#pragma unroll
        for (int a = 0; a < 2; ++a)
#pragma unroll
            for (int b = 0; b < 2; ++b)
#pragma unroll
                for (int m = 0; m < 4; ++m)
#pragma unroll
                    for (int n = 0; n < 2; ++n) acc[a][b][m][n] = (f32x4){0.f, 0.f, 0.f, 0.f};
        cur = nxt; cA = nA; cB = nB; ++ui;
        if constexpr (Sched::GATHER) {
#pragma unroll
            for (int h = 0; h < 2; ++h) { vA[h][0] = vAn[h][0]; vA[h][1] = vAn[h][1]; } }
        if (wr == 1) PG8_BAR;
    }
    PG8_WAIT_V(0);
    PG8_BAR;
#undef PG8_SA
#undef PG8_SB
#undef PG8_STAGE
#undef PG8_STAGE_A
#undef PG8_LDA
#undef PG8_LDB
#undef PG8_MMA
#undef PG8_WAIT_V
#undef PG8_WAIT_L
#undef PG8_BAR
#undef PG8_SCHED
#undef PG8_GOFF
}
}

#define XB_TMO      128
#define XB_XCNT(j)  (256  + 64 * (j))
#define XB_XSUB(j)  (1280 + 64 * (j))
#define XB_XGEN(j)  (2304 + 64 * (j))
#define XB_TOP      3328
#define XB_TOPGEN   3392
#define XCD_BAR_WORDS 3456
#define XB_SPIN_CAP (1u << 18)
__device__ __forceinline__ unsigned xb_ld(unsigned* p)              { return __hip_atomic_load(p, __ATOMIC_RELAXED, __HIP_MEMORY_SCOPE_AGENT); }
__device__ __forceinline__ unsigned xb_add(unsigned* p, unsigned v) { return __hip_atomic_fetch_add(p, v, __ATOMIC_RELAXED, __HIP_MEMORY_SCOPE_AGENT); }
__device__ __forceinline__ unsigned xb_xcc_id() { return (unsigned)__builtin_amdgcn_s_getreg((3 << 11) | 20) & 0xFu; }
#define XB_SPIN(cond, bar) do { unsigned _sp = 0; while (cond) { __builtin_amdgcn_s_sleep(1); \
    if ((++_sp & 255u) == 0u) { if (xb_ld(&(bar)[XB_TMO])) break; if (_sp > XB_SPIN_CAP) { atomicAdd(&(bar)[XB_TMO], 1u); break; } } } } while (0)
struct XcdBarrier { unsigned* bar; unsigned x; volatile LAS unsigned* st; };
__device__ __forceinline__ XcdBarrier xcd_barrier_post(unsigned* bar, volatile LAS unsigned* st) {
    XcdBarrier b; b.bar = bar; b.x = xb_xcc_id(); b.st = st;
    if (threadIdx.x == 0) (void)xb_add(&bar[XB_XCNT(b.x)], 1u);
    return b;
}
__device__ __forceinline__ void xcd_barrier_complete(unsigned* bar, unsigned x, unsigned& nloc, unsigned& nx) {
    const unsigned G = gridDim.x * gridDim.y * gridDim.z;
    unsigned sum, cnt, mine, sp = 0u;
    for (;;) {
        sum = 0u; cnt = 0u; mine = 0u;
#pragma unroll
        for (unsigned j = 0; j < 16; ++j) { const unsigned c = xb_ld(&bar[XB_XCNT(j)]); sum += c; cnt += (c > 0u) ? 1u : 0u; mine = (j == x) ? c : mine; }
        if (sum == G) break;
        __builtin_amdgcn_s_sleep(1);
        if ((++sp & 255u) == 0u) { if (xb_ld(&bar[XB_TMO])) break; if (sp > XB_SPIN_CAP) { atomicAdd(&bar[XB_TMO], 1u); break; } }
    }
    nloc = mine > 0u ? mine : 1u; nx = cnt > 0u ? cnt : 1u;
}
__device__ __forceinline__ void xcd_barrier(const XcdBarrier& b) {
    asm volatile("s_waitcnt vmcnt(0)" ::: "memory");
    __syncthreads();
    if (threadIdx.x == 0) {
        unsigned* bar = b.bar; unsigned bx = b.x;
        asm volatile("" : "+s"(bar), "+s"(bx));
        __builtin_amdgcn_s_waitcnt(0);
        unsigned nloc = b.st[0], nx = b.st[1];
        if (nloc == 0u) { xcd_barrier_complete(bar, bx, nloc, nx); b.st[0] = nloc; b.st[1] = nx; }
        const unsigned old = xb_add(&bar[XB_XSUB(bx)], 1u);
        const unsigned gen = old / nloc;
        if (old + 1u == (gen + 1u) * nloc) {
            __builtin_amdgcn_fence(__ATOMIC_RELEASE, "agent");
            asm volatile("s_waitcnt vmcnt(0)" ::: "memory");
            const unsigned og = xb_add(&bar[XB_TOP], 1u);
            const unsigned tg = og / nx;
            if (og + 1u == (tg + 1u) * nx) xb_add(&bar[XB_TOPGEN], 1u);
            else XB_SPIN(xb_ld(&bar[XB_TOPGEN]) == tg, bar);
            __builtin_amdgcn_fence(__ATOMIC_ACQUIRE, "agent");
            xb_add(&bar[XB_XGEN(bx)], 1u);
            asm volatile("s_waitcnt vmcnt(0)" ::: "memory");
        } else {
            XB_SPIN(xb_ld(&bar[XB_XGEN(bx)]) == gen, bar);
            __builtin_amdgcn_fence(__ATOMIC_ACQUIRE, "agent");
            asm volatile("s_waitcnt vmcnt(0)" ::: "memory");
        }
    }
    __syncthreads();
}
constexpr size_t MiB = 1u << 20;
constexpr size_t WS_CTL = 0, CTL_ZERO_BYTES = 64 * 1024;
constexpr size_t WS_SSX  = 1 * MiB;
constexpr size_t WS_KVSS = 3 * MiB;
constexpr size_t WS_QSS  = WS_KVSS + 512 * 1024;
constexpr size_t WS_KRSS = WS_QSS + 1 * MiB;
constexpr size_t WS_TE   = WS_KRSS + 128 * 1024;
constexpr size_t WS_TW   = WS_TE + 256 * 1024;
constexpr size_t WS_TRS  = WS_TW + 256 * 1024;
constexpr size_t WS_CNT  = WS_TRS + 128 * 1024;
constexpr size_t WS_ATOK = WS_CNT + 64 * 1024;
constexpr size_t WS_AW   = WS_ATOK + 320 * 1024;
constexpr size_t WS_ARS  = WS_AW + 320 * 1024;
constexpr size_t WS_TSEG = WS_ARS + 320 * 1024;
constexpr size_t WS_LAM  = WS_TSEG + 4096;
constexpr size_t WS_ROPE = 8 * MiB;
constexpr size_t WS_ROPEB = 12 * MiB;
constexpr size_t WS_WMIX = 16 * MiB, WMIX_LAYER = 13 * MiB;
constexpr size_t WM_IN = 0, WM_UQ = WM_IN + (size_t)NIN * 1024 * 2, WM_UKV = WM_UQ + 768 * 384 * 2, WM_PROJ = WM_UKV + 1024 * 256 * 2, WM_GLU = WM_PROJ + 1024 * 512 * 2,
                 WM_OUT = WM_GLU + 2048 * 512 * 2, WM_R = WM_OUT + 1024 * 1024 * 2, WM_END = WM_R + 48 * 1024 * 2;
static_assert(WM_END <= WMIX_LAYER, "mixer weights");
constexpr size_t WS_TMAT = 42 * MiB;
constexpr size_t WS_WST  = 62 * MiB;
constexpr size_t WS_XB   = 70 * MiB;
constexpr size_t WS_IN   = 134 * MiB;
constexpr size_t WS_OB   = 174 * MiB;
constexpr size_t WS_YB   = 206 * MiB;
constexpr size_t WS_SST  = 222 * MiB;
constexpr size_t WS_KVC  = 174 * MiB, WS_QC = 190 * MiB, WS_KR = 214 * MiB;
constexpr size_t WS_HH   = 174 * MiB;
constexpr size_t WS_TQ   = 238 * MiB, WS_KB = 286 * MiB, WS_VB = 334 * MiB;
constexpr size_t WS_S5G  = 238 * MiB, WS_MG = 302 * MiB;
constexpr size_t WS_GT   = 366 * MiB;
constexpr size_t WS_WGU  = 366 * MiB, WS_WD = 398 * MiB;
constexpr size_t WS_END  = 494 * MiB;

constexpr int RING_BYTES = 131072, IDX_OFF = RING_BYTES, MISC_OFF = IDX_OFF + 4096, LDS_BYTES = 147456;
static_assert(MISC_OFF + 256 <= LDS_BYTES, "LDS map");

struct Params {
    const float* in[27];
    float* out; unsigned char* ws;
    int ph_lo, ph_hi, variant, pad_;
};
__device__ __forceinline__ Params load_params() {
    typedef const __attribute__((address_space(4))) Params* KP;
    KP ka = (KP)__builtin_amdgcn_kernarg_segment_ptr();
    asm volatile("" : "+s"(ka));
    Params p;
#pragma unroll
    for (int i = 0; i < 27; ++i) p.in[i] = ka->in[i];
    p.out = ka->out; p.ws = ka->ws; p.ph_lo = ka->ph_lo; p.ph_hi = ka->ph_hi; p.variant = ka->variant; p.pad_ = 0;
    return p;
}

__device__ __forceinline__ float row_rstd16(const GAS float* ss, int row, int fq, float inv_n) {
    const f32x4 v = *(const GAS f32x4*)(ss + (size_t)row * 16 + 4 * fq);
    float s = (v[0] + v[1]) + (v[2] + v[3]);
    s = sum_x16(s); s = sum_x32(s);
    return __builtin_amdgcn_rsqf(s * inv_n + EPS);
}
__device__ __forceinline__ float sumsq16(const f32x4& a, const f32x4& b, const f32x4& c, const f32x4& d) {
    return ((a[0]*a[0] + a[1]*a[1]) + (a[2]*a[2] + a[3]*a[3])) + ((b[0]*b[0] + b[1]*b[1]) + (b[2]*b[2] + b[3]*b[3])) + ((c[0]*c[0] + c[1]*c[1]) + (c[2]*c[2] + c[3]*c[3])) + ((d[0]*d[0] + d[1]*d[1]) + (d[2]*d[2] + d[3]*d[3]));
}
__device__ __forceinline__ u32x4 pack8(const f32x4& a, const f32x4& b) { u32x4 w; w.x = cvt_pk_bf16(a[0], a[1]); w.y = cvt_pk_bf16(a[2], a[3]); w.z = cvt_pk_bf16(b[0], b[1]); w.w = cvt_pk_bf16(b[2], b[3]); return w; }

__device__ __forceinline__ unsigned pack4_u8(const f32x4& v) {
    const unsigned a = (unsigned)(v[0] * 255.0f + 0.5f), b = (unsigned)(v[1] * 255.0f + 0.5f), c = (unsigned)(v[2] * 255.0f + 0.5f), d = (unsigned)(v[3] * 255.0f + 0.5f);
    return a | (b << 8) | (c << 16) | (d << 24);
}
__device__ __forceinline__ f32x4 unpack4_u8(unsigned w) { return (f32x4){(float)(w & 0xffu), (float)((w >> 8) & 0xffu), (float)((w >> 16) & 0xffu), (float)(w >> 24)} * (1.0f / 255.0f); }

using pg8::Unit;
typedef f32x4 Acc[2][2][4][2];

#define ROWS8(ai, m) _Pragma("unroll") for (int ai = 0; ai < 2; ++ai) _Pragma("unroll") for (int m = 0; m < 4; ++m)
#define EPI_ROW(u, ai, m) ((u).pm * 256 + (ai) * 128 + wr * 64 + (m) * 16 + fr)

struct EpiIn {
    static constexpr bool PERM = true;
    unsigned char* ws;
    __device__ __forceinline__ void operator()(const Acc& acc, const Unit& u, int wr, int wc, int fr, int fq) const {
        GAS unsigned char* w = (GAS unsigned char*)ws; asm volatile("" : "+s"(w));
        const GAS float* ssx = (const GAS float*)(w + WS_SSX); GAS unsigned char* gt = (GAS unsigned char*)(w + WS_GT); GAS bf16_t* inb = (GAS bf16_t*)(w + WS_IN); GAS bf16_t* kvc = (GAS bf16_t*)(w + WS_KVC); GAS bf16_t* qc = (GAS bf16_t*)(w + WS_QC);
        GAS bf16_t* kr = (GAS bf16_t*)(w + WS_KR); GAS float* kvss = (GAS float*)(w + WS_KVSS); GAS float* qss = (GAS float*)(w + WS_QSS); GAS float* krss = (GAS float*)(w + WS_KRSS);
        const int pn = u.pn;
        f32x4 sv[2][4];
        ROWS8(ai, m) sv[ai][m] = *(const GAS f32x4*)(ssx + (size_t)EPI_ROW(u, ai, m) * 16 + 4 * fq);
        ROWS8(ai, m) {
                const int row = EPI_ROW(u, ai, m);
                float st = (sv[ai][m][0] + sv[ai][m][1]) + (sv[ai][m][2] + sv[ai][m][3]); st = sum_x16(st); st = sum_x32(st);
                const float rs = __builtin_amdgcn_rsqf(st * (1.0f / 1024.0f) + EPS);
                f32x4 v00 = acc[ai][0][m][0] * rs, v01 = acc[ai][0][m][1] * rs, v10 = acc[ai][1][m][0] * rs, v11 = acc[ai][1][m][1] * rs;
                if (pn < 8) {
#pragma unroll
                    for (int j = 0; j < 4; ++j) { v00[j] = fast_sigmoid(v00[j]); v01[j] = fast_sigmoid(v01[j]); v10[j] = fast_sigmoid(v10[j]); v11[j] = fast_sigmoid(v11[j]); }
                    GAS unsigned char* p = gt + (size_t)row * 2048 + pn * 256 + wc * 32 + 8 * fq;
                    *(GAS u32x2*)p = (u32x2){pack4_u8(v00), pack4_u8(v01)}; *(GAS u32x2*)(p + 128) = (u32x2){pack4_u8(v10), pack4_u8(v11)};
                } else if (pn < 10) {
                    const int b = row >> 11, ts = row & 2047, c = ts >> 5, s = ts & 31;
#pragma unroll
                    for (int bj = 0; bj < 2; ++bj) { const int cu = (pn - 8) * 256 + bj * 128 + wc * 32 + 8 * fq, g = cu >> 4, j0 = cu & 15;
                        GAS bf16_t* p = inb + ((size_t)(g * 1024 + b * 64 + c) * KIN + s * 16 + j0);
                        *(GAS u32x4*)p = bj ? pack8(v10, v11) : pack8(v00, v01); }
                } else if (pn == 10) {
                    GAS bf16_t* p = kvc + (size_t)row * 256 + wc * 32 + 8 * fq;
                    *(GAS u32x4*)p = pack8(v00, v01); *(GAS u32x4*)(p + 128) = pack8(v10, v11);
                    float s = sumsq16(v00, v01, v10, v11); s = sum_x16(s); s = sum_x32(s);
                    if (fq == 0) kvss[(size_t)row * 4 + wc] = s;
                } else if (pn == 11) {
                    GAS bf16_t* p = qc + (size_t)row * 384 + wc * 32 + 8 * fq;
                    *(GAS u32x4*)p = pack8(v00, v01); *(GAS u32x4*)(p + 128) = pack8(v10, v11);
                    float s = sumsq16(v00, v01, v10, v11); s = sum_x16(s); s = sum_x32(s);
                    if (fq == 0) qss[(size_t)row * 8 + wc] = s;
                } else {
                    GAS bf16_t* p = qc + (size_t)row * 384 + 256 + wc * 32 + 8 * fq;
                    *(GAS u32x4*)p = pack8(v00, v01);
                    const f32x4 z = (f32x4){0.f, 0.f, 0.f, 0.f};
                    float s = sumsq16(v00, v01, z, z); s = sum_x16(s); s = sum_x32(s);
                    if (fq == 0) qss[(size_t)row * 8 + 4 + wc] = s;
                    float s2 = sumsq16(v10, v11, z, z); s2 = sum_x16(s2); s2 = sum_x32(s2);
                    if (wc == 0) { *(GAS u32x4*)(kr + (size_t)row * 32 + 8 * fq) = pack8(v10, v11); if (fq == 0) krss[row] = s2; }
                }
                asm volatile("" ::: "memory");
            }
    }
};

struct EpiPlain {
    static constexpr bool PERM = true;
    unsigned char* ws; size_t off; int ldc;
    __device__ __forceinline__ void operator()(const Acc& acc, const Unit& u, int wr, int wc, int fr, int fq) const {
        GAS unsigned char* w = (GAS unsigned char*)ws; asm volatile("" : "+s"(w)); GAS bf16_t* o = (GAS bf16_t*)(w + off);
        ROWS8(ai, m) {
                const int row = EPI_ROW(u, ai, m);
                GAS bf16_t* p = o + (size_t)row * ldc + u.pn * 256 + wc * 32 + 8 * fq;
                *(GAS u32x4*)p = pack8(acc[ai][0][m][0], acc[ai][0][m][1]); *(GAS u32x4*)(p + 128) = pack8(acc[ai][1][m][0], acc[ai][1][m][1]);
                asm volatile("" ::: "memory");
            }
    }
};

struct EpiKV {
    static constexpr bool PERM = true;
    unsigned char* ws; LAS const float* gkl;
    __device__ __forceinline__ void operator()(const Acc& acc, const Unit& u, int wr, int wc, int fr, int fq) const {
        GAS unsigned char* w = (GAS unsigned char*)ws; asm volatile("" : "+s"(w));
        const GAS float* kvss = (const GAS float*)(w + WS_KVSS); const GAS float* krss = (const GAS float*)(w + WS_KRSS); const GAS bf16_t* kr = (const GAS bf16_t*)(w + WS_KR); const GAS bf16_t* ropeb = (const GAS bf16_t*)(w + WS_ROPEB);
        GAS bf16_t* kb = (GAS bf16_t*)(w + WS_KB); GAS bf16_t* vb = (GAS bf16_t*)(w + WS_VB);
        const int pn = u.pn;
        if (pn < 2) {
            const int h = pn * 4 + wc, i0 = 8 * (fq & 1);
#pragma unroll
            for (int ai = 0; ai < 2; ++ai) {
                float kq[4], krs[4]; u32x4 kA[4], kB[4], cw4[4], sw4[4];
#pragma unroll
                for (int m = 0; m < 4; ++m) { const int row = EPI_ROW(u, ai, m); kq[m] = kvss[(size_t)row * 4 + fq]; krs[m] = krss[row];
                    const GAS bf16_t* kp0 = kr + (size_t)row * 32 + i0; kA[m] = *(const GAS u32x4*)kp0; kB[m] = *(const GAS u32x4*)(kp0 + 16);
                    const GAS bf16_t* rp = ropeb + (size_t)row * 32 + i0; cw4[m] = *(const GAS u32x4*)rp; sw4[m] = *(const GAS u32x4*)(rp + 16); }
#pragma unroll
                for (int m = 0; m < 4; ++m) {
                    const int row = EPI_ROW(u, ai, m);
                    float ks = kq[m]; ks = sum_x16(ks); ks = sum_x32(ks);
                    const float rkv = __builtin_amdgcn_rsqf(ks * (1.0f / 256.0f) + EPS);
                    f32x4 v00 = acc[ai][0][m][0] * rkv, v01 = acc[ai][0][m][1] * rkv, v10 = acc[ai][1][m][0] * rkv, v11 = acc[ai][1][m][1] * rkv;
                    float s = sumsq16(v00, v01, v10, v11); s = sum_x16(s); s = sum_x32(s);
                    const float rk = __builtin_amdgcn_rsqf((s + krs[m]) * (1.0f / 96.0f) + EPS);
                    const int b = row >> 11, sq = row & 2047;
                    GAS bf16_t* kp = kb + ((size_t)((b * NH + h) * SEQ + sq)) * 96;
                    { const f32x4 g0a = *(LAS const f32x4*)(gkl + 8 * fq), g0b = *(LAS const f32x4*)(gkl + 8 * fq + 4);
                      *(GAS u32x4*)(kp + 8 * fq) = pack8(v00 * g0a * rk, v01 * g0b * rk); }
                    { const f32x4 g1a = *(LAS const f32x4*)(gkl + 32 + 8 * fq), g1b = *(LAS const f32x4*)(gkl + 32 + 8 * fq + 4);
                      *(GAS u32x4*)(kp + 32 + 8 * fq) = pack8(v10 * g1a * rk, v11 * g1b * rk); }
                    asm volatile("" ::: "memory");
                    const f32x4 gAa = *(LAS const f32x4*)(gkl + 64 + i0), gAb = *(LAS const f32x4*)(gkl + 64 + i0 + 4), gBa = *(LAS const f32x4*)(gkl + 80 + i0), gBb = *(LAS const f32x4*)(gkl + 80 + i0 + 4);
                    const u32x4 a4 = kA[m], b4 = kB[m], cq = cw4[m], sq4 = sw4[m];
                    const f32x4 xAa = (f32x4){bflo(a4.x), bfhi(a4.x), bflo(a4.y), bfhi(a4.y)} * gAa * rk, xAb = (f32x4){bflo(a4.z), bfhi(a4.z), bflo(a4.w), bfhi(a4.w)} * gAb * rk;
                    const f32x4 xBa = (f32x4){bflo(b4.x), bfhi(b4.x), bflo(b4.y), bfhi(b4.y)} * gBa * rk, xBb = (f32x4){bflo(b4.z), bfhi(b4.z), bflo(b4.w), bfhi(b4.w)} * gBb * rk;
                    const f32x4 ca = (f32x4){bflo(cq.x), bfhi(cq.x), bflo(cq.y), bfhi(cq.y)}, cb = (f32x4){bflo(cq.z), bfhi(cq.z), bflo(cq.w), bfhi(cq.w)};
                    const f32x4 sa = (f32x4){bflo(sq4.x), bfhi(sq4.x), bflo(sq4.y), bfhi(sq4.y)}, sb = (f32x4){bflo(sq4.z), bfhi(sq4.z), bflo(sq4.w), bfhi(sq4.w)};
                    f32x4 oa, ob;
                    if (fq < 2) { oa = xAa * ca - xBa * sa; ob = xAb * cb - xBb * sb; } else { oa = xBa * ca + xAa * sa; ob = xBb * cb + xAb * sb; }
                    *(GAS u32x4*)(kp + 64 + 8 * fq) = pack8(oa, ob);
                    asm volatile("" ::: "memory");
                }
            }
        } else {
            const int h = (pn - 2) * 4 + wc;
            float kq[2][4];
            ROWS8(ai, m) kq[ai][m] = kvss[(size_t)EPI_ROW(u, ai, m) * 4 + fq];
            ROWS8(ai, m) {
                    const int row = EPI_ROW(u, ai, m);
                    float ks = kq[ai][m]; ks = sum_x16(ks); ks = sum_x32(ks);
                    const float rkv = __builtin_amdgcn_rsqf(ks * (1.0f / 256.0f) + EPS);
                    const int b = row >> 11, sq = row & 2047;
                    GAS bf16_t* vp = vb + ((size_t)((b * NH + h) * SEQ + sq)) * 64;
                    *(GAS u32x4*)(vp + 8 * fq) = pack8(acc[ai][0][m][0] * rkv, acc[ai][0][m][1] * rkv);
                    *(GAS u32x4*)(vp + 32 + 8 * fq) = pack8(acc[ai][1][m][0] * rkv, acc[ai][1][m][1] * rkv);
                    asm volatile("" ::: "memory");
                }
        }
    }
};

struct EpiS {
    static constexpr bool PERM = false;
    unsigned char* ws;
    __device__ __forceinline__ void operator()(const Acc& acc, const Unit& u, int wr, int wc, int fr, int fq) const {
        GAS unsigned char* w = (GAS unsigned char*)ws; asm volatile("" : "+s"(w)); GAS float* sst = (GAS float*)(w + WS_SST);
        ROWS8(ai, m) {
                const int row = EPI_ROW(u, ai, m);
                GAS float* p = sst + (size_t)row * 128 + wc * 32 + 4 * fq;
                *(GAS f32x4*)p = acc[ai][0][m][0]; *(GAS f32x4*)(p + 16) = acc[ai][0][m][1];
            }
    }
};

__device__ __forceinline__ float gelu_tanh(float x) {
    const float z = 0.7978845608028654f * (x + 0.044715f * x * x * x);
    return x * __builtin_amdgcn_rcpf(1.0f + __builtin_amdgcn_exp2f(-2.8853900817779268f * z));
}
struct EpiY {
    static constexpr bool PERM = true;
    unsigned char* ws;
    __device__ __forceinline__ void operator()(const Acc& acc, const Unit& u, int wr, int wc, int fr, int fq) const {
        GAS unsigned char* w = (GAS unsigned char*)ws; asm volatile("" : "+s"(w)); GAS bf16_t* yb = (GAS bf16_t*)(w + WS_YB);
        const int g = u.pm >> 2, pnl = u.pn & 1;
        ROWS8(ai, m) {
                const int rg = (u.pm & 3) * 256 + ai * 128 + wr * 64 + m * 16 + fr, b = rg >> 6, c = rg & 63;
#pragma unroll
                for (int bj = 0; bj < 2; ++bj) {
                    const int nl = pnl * 256 + bj * 128 + wc * 32 + 8 * fq, t = nl >> 4, i0 = nl & 15;
                    f32x4 a = acc[ai][bj][m][0], bq = acc[ai][bj][m][1];
#pragma unroll
                    for (int j = 0; j < 4; ++j) { a[j] = gelu_tanh(a[j]); bq[j] = gelu_tanh(bq[j]); }
                    GAS bf16_t* p = yb + (size_t)(b * SEQ + c * LC + t) * 512 + g * 16 + i0;
                    *(GAS u32x4*)p = pack8(a, bq);
                }
                asm volatile("" ::: "memory");
            }
    }
};

struct EpiProj {
    static constexpr bool PERM = true;
    unsigned char* ws;
    __device__ __forceinline__ void operator()(const Acc& acc, const Unit& u, int wr, int wc, int fr, int fq) const {
        GAS unsigned char* w = (GAS unsigned char*)ws; asm volatile("" : "+s"(w)); const GAS unsigned char* gt = (const GAS unsigned char*)(w + WS_GT); GAS bf16_t* mg = (GAS bf16_t*)(w + WS_MG);
        u32x2 gw[2][4][2];
        ROWS8(ai, m) { const GAS unsigned char* gp = gt + (size_t)EPI_ROW(u, ai, m) * 2048 + u.pn * 256 + wc * 32 + 8 * fq; gw[ai][m][0] = *(const GAS u32x2*)gp; gw[ai][m][1] = *(const GAS u32x2*)(gp + 128); }
        ROWS8(ai, m) {
                const int row = EPI_ROW(u, ai, m);
#pragma unroll
                for (int bj = 0; bj < 2; ++bj) {
                    const int col = u.pn * 256 + bj * 128 + wc * 32 + 8 * fq; const u32x2 g = gw[ai][m][bj];
                    const f32x4 a = acc[ai][bj][m][0] * unpack4_u8(g.x), b = acc[ai][bj][m][1] * unpack4_u8(g.y);
                    *(GAS u32x4*)(mg + (size_t)row * 1024 + col) = pack8(a, b);
                }
                asm volatile("" ::: "memory");
            }
    }
};

struct EpiGlu {
    static constexpr bool PERM = true;
    unsigned char* ws;
    __device__ __forceinline__ void operator()(const Acc& acc, const Unit& u, int wr, int wc, int fr, int fq) const {
        GAS unsigned char* w = (GAS unsigned char*)ws; asm volatile("" : "+s"(w)); const GAS unsigned char* gt = (const GAS unsigned char*)(w + WS_GT); GAS bf16_t* mg = (GAS bf16_t*)(w + WS_MG);
        u32x2 gw[2][4]; u32x4 mw[2][4];
        ROWS8(ai, m) { const size_t row = (size_t)EPI_ROW(u, ai, m); const int col = u.pn * 128 + wc * 32 + 8 * fq; gw[ai][m] = *(const GAS u32x2*)(gt + row * 2048 + 1024 + col); mw[ai][m] = *(const GAS u32x4*)(mg + row * 1024 + col); }
        ROWS8(ai, m) {
                const int row = EPI_ROW(u, ai, m), col = u.pn * 128 + wc * 32 + 8 * fq;
                const u32x2 g = gw[ai][m]; const u32x4 mo = mw[ai][m];
                const f32x4 g1a = unpack4_u8(g.x), g1b = unpack4_u8(g.y);
                f32x4 va = acc[ai][0][m][0], vb = acc[ai][0][m][1]; const f32x4 ga = acc[ai][1][m][0], gb = acc[ai][1][m][1];
                const f32x4 ma = (f32x4){bflo(mo.x), bfhi(mo.x), bflo(mo.y), bfhi(mo.y)}, mb = (f32x4){bflo(mo.z), bfhi(mo.z), bflo(mo.w), bfhi(mo.w)};
#pragma unroll
                for (int j = 0; j < 4; ++j) { va[j] = ma[j] + va[j] * fast_sigmoid(ga[j]) * g1a[j]; vb[j] = mb[j] + vb[j] * fast_sigmoid(gb[j]) * g1b[j]; }
                *(GAS u32x4*)(mg + (size_t)row * 1024 + col) = pack8(va, vb);
                asm volatile("" ::: "memory");
            }
    }
};

struct EpiOut {
    static constexpr bool PERM = true;
    unsigned char* ws;
    __device__ __forceinline__ void operator()(const Acc& acc, const Unit& u, int wr, int wc, int fr, int fq) const {
        GAS unsigned char* w = (GAS unsigned char*)ws; asm volatile("" : "+s"(w)); GAS bf16_t* xb = (GAS bf16_t*)(w + WS_XB); GAS float* ssx = (GAS float*)(w + WS_SSX);
        u32x4 xw[2][4][2];
        ROWS8(ai, m) { const GAS bf16_t* p = xb + (size_t)EPI_ROW(u, ai, m) * 1024 + u.pn * 256 + wc * 32 + 8 * fq; xw[ai][m][0] = *(const GAS u32x4*)p; xw[ai][m][1] = *(const GAS u32x4*)(p + 128); }
        ROWS8(ai, m) {
                const int row = EPI_ROW(u, ai, m);
                float s = 0.f;
#pragma unroll
                for (int bj = 0; bj < 2; ++bj) {
                    GAS bf16_t* p = xb + (size_t)row * 1024 + u.pn * 256 + bj * 128 + wc * 32 + 8 * fq; const u32x4 x4 = xw[ai][m][bj];
                    const f32x4 a = (f32x4){bflo(x4.x), bfhi(x4.x), bflo(x4.y), bfhi(x4.y)} + acc[ai][bj][m][0], b = (f32x4){bflo(x4.z), bfhi(x4.z), bflo(x4.w), bfhi(x4.w)} + acc[ai][bj][m][1];
                    *(GAS u32x4*)p = pack8(a, b);
                    s += ((a[0] * a[0] + a[1] * a[1]) + (a[2] * a[2] + a[3] * a[3])) + ((b[0] * b[0] + b[1] * b[1]) + (b[2] * b[2] + b[3] * b[3]));
                }
                s = sum_x16(s); s = sum_x32(s);
                if (fq == 0) ssx[(size_t)row * 16 + u.pn * 4 + wc] = s;
                asm volatile("" ::: "memory");
            }
    }
};

struct MoeOrder {
    static constexpr bool GATHER = false;
    const int* tseg; int tile0, ntile, NC, G, c;
    int loff = 0, lmax = 0x7fffffff;
    __device__ int vcu() const { return (G % 8 == 0) ? (c % 8) * (G / 8) + c / 8 : c; }
    __device__ bool unit(int L, Unit& u) const { const int pm = tile0 + L / NC, pnl = L % NC; u.pm = pm; u.pn = (tseg[pm] & 31) * NC + pnl; return true; }
    __device__ bool next(int i, Unit& u) const {
        const int L = i * G + vcu() + loff; if (L >= ntile * NC || L >= lmax) return false;
        return unit(L, u);
    }
};
struct MoeGatherOrder : MoeOrder { static constexpr bool GATHER = true; const int* gidx; };
struct MoeDownAOrder : MoeOrder {
    int nbusy;
    __device__ bool next(int i, Unit& u) const {
        const int vc = vcu(), F = G - nbusy; int L;
        if (vc >= nbusy) { const int j = vc - nbusy; L = (i < 2) ? i * F + j : 2 * F + (i - 2) * G + vc; }
        else L = 2 * F + i * G + vc;
        if (L >= ntile * NC) return false;
        return unit(L, u);
    }
};

struct EpiGU {
    static constexpr bool PERM = true;
    unsigned char* ws;
    __device__ __forceinline__ void operator()(const Acc& acc, const Unit& u, int wr, int wc, int fr, int fq) const {
        GAS unsigned char* w = (GAS unsigned char*)ws; asm volatile("" : "+s"(w)); const GAS float* ars = (const GAS float*)(w + WS_ARS); GAS bf16_t* hh = (GAS bf16_t*)(w + WS_HH);
        const int pnl = u.pn & 1;
        float rsv[2][4];
        ROWS8(ai, m) rsv[ai][m] = ars[EPI_ROW(u, ai, m)];
        ROWS8(ai, m) {
                const int row = EPI_ROW(u, ai, m);
                const float rs = rsv[ai][m];
                f32x4 ga = acc[ai][0][m][0] * rs, gb = acc[ai][0][m][1] * rs, ua = acc[ai][1][m][0] * rs, ub = acc[ai][1][m][1] * rs;
#pragma unroll
                for (int j = 0; j < 4; ++j) { ga[j] = ga[j] * fast_sigmoid(ga[j]) * ua[j]; gb[j] = gb[j] * fast_sigmoid(gb[j]) * ub[j]; }
                *(GAS u32x4*)(hh + (size_t)row * 256 + pnl * 128 + wc * 32 + 8 * fq) = pack8(ga, gb);
                asm volatile("" ::: "memory");
            }
    }
};

template <bool PASS_B> struct EpiDown {
    static constexpr bool PERM = true;
    unsigned char* ws; float* out;
    __device__ __forceinline__ void operator()(const Acc& acc, const Unit& u, int wr, int wc, int fr, int fq) const {
        GAS unsigned char* w = (GAS unsigned char*)ws; asm volatile("" : "+s"(w)); const GAS int* atok = (const GAS int*)(w + WS_ATOK); const GAS float* aw = (const GAS float*)(w + WS_AW); GAS bf16_t* xb = (GAS bf16_t*)(w + WS_XB); GAS float* ssx = (GAS float*)(w + WS_SSX);
        GAS float* og = (GAS float*)out;
        const int pnl = u.pn & 3;
        int tk[2][4]; float wg[2][4]; u32x4 xw[2][4][2];
        ROWS8(ai, m) { const int row = EPI_ROW(u, ai, m); tk[ai][m] = atok[row]; wg[ai][m] = aw[row]; }
        ROWS8(ai, m) { const int t0 = tk[ai][m] < 0 ? 0 : tk[ai][m]; const GAS bf16_t* p = xb + (size_t)t0 * 1024 + pnl * 256 + wc * 32 + 8 * fq; xw[ai][m][0] = *(const GAS u32x4*)p; xw[ai][m][1] = *(const GAS u32x4*)(p + 128); }
        ROWS8(ai, m) {
                const int tok = tk[ai][m]; const float wgt = wg[ai][m];
                const int t0 = tok < 0 ? 0 : tok;
                float s = 0.f;
#pragma unroll
                for (int bj = 0; bj < 2; ++bj) {
                    const size_t o = (size_t)t0 * 1024 + pnl * 256 + bj * 128 + wc * 32 + 8 * fq; const u32x4 x4 = xw[ai][m][bj];
                    const f32x4 a = (f32x4){bflo(x4.x), bfhi(x4.x), bflo(x4.y), bfhi(x4.y)} + acc[ai][bj][m][0] * wgt, b = (f32x4){bflo(x4.z), bfhi(x4.z), bflo(x4.w), bfhi(x4.w)} + acc[ai][bj][m][1] * wgt;
                    if (tok >= 0) { *(GAS u32x4*)(xb + o) = pack8(a, b);
                        if (PASS_B && og) { *(GAS f32x4*)(og + o) = a; *(GAS f32x4*)(og + o + 4) = b; } }
                    s += ((a[0] * a[0] + a[1] * a[1]) + (a[2] * a[2] + a[3] * a[3])) + ((b[0] * b[0] + b[1] * b[1]) + (b[2] * b[2] + b[3] * b[3]));
                }
                if (PASS_B) { s = sum_x16(s); s = sum_x32(s); if (fq == 0 && tok >= 0) ssx[(size_t)tok * 16 + pnl * 4 + wc] = s; }
                asm volatile("" ::: "memory");
            }
    }
};

struct SsmSOrder {
    static constexpr bool GATHER = false; int G, c;
    __device__ bool next(int i, Unit& u) const { const int cc = (c + G / 2) % G; const int L = i * G + cc; if (L >= 128) return false; u.pm = L; u.pn = L >> 2; return true; }
};
struct SsmYOrder {
    static constexpr bool GATHER = false; int G, c;
    __device__ bool next(int i, Unit& u) const { const int vc = (G % 8 == 0) ? (c % 8) * (G / 8) + c / 8 : c; const int L = i * G + vc; if (L >= 256) return false; u.pm = L >> 1; u.pn = (L >> 3) * 2 + (L & 1); return true; }
};
namespace att {
#define KSWZ(row, colB) ((row) * 256 + ((colB) ^ (((row) & 15) << 4)))
#define SBAR() __builtin_amdgcn_sched_barrier(0)
constexpr int SHM_K = 32768, SHM_V = 16384, OFF_V = 2 * SHM_K, OFF_WS = 2 * SHM_K + 2 * SHM_V;
__device__ __forceinline__ int crow(int r, int hi) { return (r & 3) + 8 * (r >> 2) + 4 * hi; }
__device__ __forceinline__ int v_st(int k, int c) { const int kk = (k & ~0xC) | ((k & 4) << 1) | ((k & 8) >> 1); return ((kk >> 3) * 2 + (c >> 5)) * 512 + ((kk & 7) * 32 + (c & 31)) * 2; }
__device__ __forceinline__ int v_rd_base(int lane) { return ((lane & 3) << 3) | (((lane >> 2) & 3) << 6) | (((lane >> 4) & 1) << 5) | (((lane >> 5) & 1) << 8); }
constexpr int v_rd_off(int d0, int ks, int half) { return d0 * 512 + ks * 2048 + half * 1024; }
template <int OFF> __device__ __forceinline__ s16x4 tr_read(int vb) {
    s16x4 r; asm volatile("ds_read_b64_tr_b16 %0, %1 offset:%2" : "=&v"(r) : "v"(vb), "i"(OFF) : "memory"); return r;
}
template <int D0> __device__ __forceinline__ void pv_one(f32x16& od, int vb, bf16x8 pa0, bf16x8 pa1, bf16x8 pa2, bf16x8 pa3) {
    const s16x4 l0 = tr_read<v_rd_off(D0, 0, 0)>(vb), h0 = tr_read<v_rd_off(D0, 0, 1)>(vb), l1 = tr_read<v_rd_off(D0, 1, 0)>(vb), h1 = tr_read<v_rd_off(D0, 1, 1)>(vb);
    const s16x4 l2 = tr_read<v_rd_off(D0, 2, 0)>(vb), h2 = tr_read<v_rd_off(D0, 2, 1)>(vb), l3 = tr_read<v_rd_off(D0, 3, 0)>(vb), h3 = tr_read<v_rd_off(D0, 3, 1)>(vb);
    asm volatile("s_waitcnt lgkmcnt(0)" ::: "memory"); SBAR();
#define PK(L, H) (bf16x8){L[0], L[1], L[2], L[3], H[0], H[1], H[2], H[3]}
    od = __builtin_amdgcn_mfma_f32_32x32x16_bf16(pa0, PK(l0, h0), od, 0, 0, 0);
    od = __builtin_amdgcn_mfma_f32_32x32x16_bf16(pa1, PK(l1, h1), od, 0, 0, 0);
    od = __builtin_amdgcn_mfma_f32_32x32x16_bf16(pa2, PK(l2, h2), od, 0, 0, 0);
    od = __builtin_amdgcn_mfma_f32_32x32x16_bf16(pa3, PK(l3, h3), od, 0, 0, 0);
#undef PK
}
__device__ __forceinline__ void attn_unit(char* lds, int b, int h, int qb, const bf16_t* TQ, const float* qss, const float* rope, const float* gq, float kbound,
                                          const bf16_t* KB, const bf16_t* VB, bf16_t* OB, int variant = 0) {
    int tid_ = threadIdx.x; asm volatile("" : "+v"(tid_));
    const int tid = tid_, wid = tid >> 6, lane = tid & 63, r32 = lane & 31, hi = lane >> 5;
    char* K_lds = lds; char* V_lds = lds + OFF_V; float* li_l = (float*)(lds + OFF_WS) + wid * 64;
    constexpr float C = 0.10206207261596575f * 1.4426950408889634f;
    const int row = b * SEQ + qb * 256 + wid * 32 + r32;
    const bf16_t* Kh = KB + (size_t)(b * NH + h) * SEQ * 96; const bf16_t* Vh = VB + (size_t)(b * NH + h) * SEQ * 64;
    const int sr = tid >> 2, sc = tid & 3;
    const int vb0 = (int)(uintptr_t)V_lds + v_rd_base(lane);
    const int NS = 2 * qb + 2, cw = 4 * qb + (wid >> 1);
    float l_reg = 0.f; f32x16 o0 = {}, o1 = {};
    bf16x8 k0r, k1r, k2r, v0r, v1r;
#define SLOAD(key0) do { const bf16_t* kp_ = Kh + (size_t)((key0) + sr) * 96 + sc * 8; k0r = *(const bf16x8*)kp_; k1r = *(const bf16x8*)(kp_ + 32); k2r = *(const bf16x8*)(kp_ + 64); \
        const bf16_t* vp_ = Vh + (size_t)((key0) + sr) * 64 + sc * 8; v0r = *(const bf16x8*)vp_; v1r = *(const bf16x8*)(vp_ + 32); } while (0)
    SLOAD(0);
    bf16x8 qr[6]; float mb;
    {
        const bf16_t* tq = TQ + (size_t)row * 768 + h * 96 + hi * 8;
        float qf[6][8]; float ss = 0.f;
#pragma unroll
        for (int d0 = 0; d0 < 6; ++d0) { const u32x4 w = *(const u32x4*)(tq + d0 * 16);
            qf[d0][0] = bflo(w.x); qf[d0][1] = bfhi(w.x); qf[d0][2] = bflo(w.y); qf[d0][3] = bfhi(w.y); qf[d0][4] = bflo(w.z); qf[d0][5] = bfhi(w.z); qf[d0][6] = bflo(w.w); qf[d0][7] = bfhi(w.w);
#pragma unroll
            for (int j = 0; j < 8; ++j) ss += qf[d0][j] * qf[d0][j]; }
        ss = sum_x32(ss);
        const f32x4 qa = *(const f32x4*)(qss + (size_t)row * 8), qb4 = *(const f32x4*)(qss + (size_t)row * 8 + 4);
        const float a = __builtin_amdgcn_rsqf((((qa[0] + qa[1]) + (qa[2] + qa[3])) + ((qb4[0] + qb4[1]) + (qb4[2] + qb4[3]))) * (1.0f / 384.0f) + EPS);
        const float f = a * __builtin_amdgcn_rsqf(a * a * ss * (1.0f / 96.0f) + EPS);
#pragma unroll
        for (int d0 = 0; d0 < 6; ++d0) { const f32x4 g0 = *(const f32x4*)(gq + d0 * 16 + hi * 8), g1 = *(const f32x4*)(gq + d0 * 16 + hi * 8 + 4);
#pragma unroll
            for (int j = 0; j < 4; ++j) { qf[d0][j] *= f * g0[j]; qf[d0][4 + j] *= f * g1[j]; } }
        const float* rp = rope + (size_t)row * 32 + hi * 8;
        const f32x4 c0 = *(const f32x4*)rp, c1 = *(const f32x4*)(rp + 4), s0 = *(const f32x4*)(rp + 16), s1 = *(const f32x4*)(rp + 20);
#pragma unroll
        for (int j = 0; j < 8; ++j) { const float cs = j < 4 ? c0[j & 3] : c1[j & 3], sn = j < 4 ? s0[j & 3] : s1[j & 3]; const float x1 = qf[4][j], x2 = qf[5][j];
            qf[4][j] = x1 * cs - x2 * sn; qf[5][j] = x2 * cs + x1 * sn; }
        float qn = 0.f;
#pragma unroll
        for (int d0 = 0; d0 < 6; ++d0)
#pragma unroll
            for (int j = 0; j < 8; ++j) qn += qf[d0][j] * qf[d0][j];
        qn = sum_x32(qn);
        mb = sqrtf(qn) * kbound * C;
#pragma unroll
        for (int d0 = 0; d0 < 6; ++d0) { u32x4 w; w.x = cvt_pk_bf16(qf[d0][0] * C, qf[d0][1] * C); w.y = cvt_pk_bf16(qf[d0][2] * C, qf[d0][3] * C); w.z = cvt_pk_bf16(qf[d0][4] * C, qf[d0][5] * C); w.w = cvt_pk_bf16(qf[d0][6] * C, qf[d0][7] * C);
            qr[d0] = *reinterpret_cast<bf16x8*>(&w); }
    }
#define SWRITE(bf) do { int t_ = threadIdx.x; asm volatile("" : "+v"(t_)); const int sr_ = t_ >> 2, sc_ = t_ & 3; \
        char* kd_ = K_lds + (bf) * SHM_K; *(bf16x8*)(kd_ + KSWZ(sr_, sc_ * 16)) = k0r; *(bf16x8*)(kd_ + KSWZ(sr_, (sc_ + 4) * 16)) = k1r; *(bf16x8*)(kd_ + KSWZ(sr_, (sc_ + 8) * 16)) = k2r; \
        char* vd_ = V_lds + (bf) * SHM_V + (sr_ >> 6) * 8192; *(bf16x8*)(vd_ + v_st(sr_ & 63, sc_ * 8)) = v0r; *(bf16x8*)(vd_ + v_st(sr_ & 63, (sc_ + 4) * 8)) = v1r; } while (0)
#define QKT(P0, P1, KS) do { const char* Ks_ = (KS); _Pragma("unroll") for (int r = 0; r < 16; ++r) { P0[r] = -mb; P1[r] = -mb; } \
        bf16x8 kf0[6], kf1[6]; \
        _Pragma("unroll") for (int d0 = 0; d0 < 6; ++d0) { const int cb = (d0 * 16 + hi * 8) * 2; \
            kf0[d0] = *reinterpret_cast<const bf16x8*>(Ks_ + KSWZ(r32, cb)); kf1[d0] = *reinterpret_cast<const bf16x8*>(Ks_ + KSWZ(32 + r32, cb)); } \
        SBAR();   \
        _Pragma("unroll") for (int d0 = 0; d0 < 6; ++d0) { \
            P0 = __builtin_amdgcn_mfma_f32_32x32x16_bf16(kf0[d0], qr[d0], P0, 0, 0, 0); P1 = __builtin_amdgcn_mfma_f32_32x32x16_bf16(kf1[d0], qr[d0], P1, 0, 0, 0); } } while (0)
#define PK4(P, BASE, OUT) do { unsigned a0 = cvt_pk_bf16(P[BASE + 0], P[BASE + 1]), a1 = cvt_pk_bf16(P[BASE + 2], P[BASE + 3]);   \
    unsigned b0_ = cvt_pk_bf16(P[BASE + 4], P[BASE + 5]), b1_ = cvt_pk_bf16(P[BASE + 6], P[BASE + 7]);                              \
    auto r0 = __builtin_amdgcn_permlane32_swap(a0, b0_, false, false); auto r1 = __builtin_amdgcn_permlane32_swap(a1, b1_, false, false); \
    u32x4 w = {r0[0], r1[0], r0[1], r1[1]}; OUT = *reinterpret_cast<bf16x8*>(&w); } while (0)
#define SMX(P0, P1) do { float ps = 0.f; _Pragma("unroll") for (int r = 0; r < 16; ++r) { P0[r] = __builtin_amdgcn_exp2f(P0[r]); P1[r] = __builtin_amdgcn_exp2f(P1[r]); ps += P0[r] + P1[r]; } \
        ps = sum_x32(ps); l_reg += ps; PK4(P0, 0, pa0); PK4(P0, 8, pa1); PK4(P1, 0, pa2); PK4(P1, 8, pa3); } while (0)
#define PV(VB_) do { const int vb_ = (VB_); pv_one<0>(o0, vb_, pa0, pa1, pa2, pa3); pv_one<1>(o1, vb_, pa0, pa1, pa2, pa3); } while (0)
#define PKV(L, H) (bf16x8){L[0], L[1], L[2], L[3], H[0], H[1], H[2], H[3]}
#define GAP_EXP4(P, B) do { P[B] = __builtin_amdgcn_exp2f(P[B]); P[B + 1] = __builtin_amdgcn_exp2f(P[B + 1]); P[B + 2] = __builtin_amdgcn_exp2f(P[B + 2]); P[B + 3] = __builtin_amdgcn_exp2f(P[B + 3]); asm volatile("" : "+v"(P)); SBAR(); } while (0)
#define GAP_SUM8(P, B) do { psum_ += ((P[B] + P[B + 1]) + (P[B + 2] + P[B + 3])) + ((P[B + 4] + P[B + 5]) + (P[B + 6] + P[B + 7])); asm volatile("" : "+v"(psum_)); SBAR(); } while (0)
#define GAP_PK(P, BASE, OUT) do { PK4(P, BASE, OUT); asm volatile("" : "+v"(OUT)); SBAR(); } while (0)
#define EXPALL(P0, P1) do { _Pragma("unroll") for (int r = 0; r < 16; ++r) { P0[r] = __builtin_amdgcn_exp2f(P0[r]); P1[r] = __builtin_amdgcn_exp2f(P1[r]); } } while (0)
#define SUMPACK(P0, P1) do { float ps = 0.f; _Pragma("unroll") for (int r = 0; r < 16; ++r) ps += P0[r] + P1[r]; ps = sum_x32(ps); l_reg += ps; PK4(P0, 0, pa0); PK4(P0, 8, pa1); PK4(P1, 0, pa2); PK4(P1, 8, pa3); } while (0)
#define BLK_QK(P0, P1, KS, S0, S1) do { const char* Ks_ = (KS); bf16x8 kf0[6], kf1[6]; \
        _Pragma("unroll") for (int d0 = 0; d0 < 6; ++d0) { const int cb = (d0 * 16 + hi * 8) * 2; kf0[d0] = *reinterpret_cast<const bf16x8*>(Ks_ + KSWZ(r32, cb)); kf1[d0] = *reinterpret_cast<const bf16x8*>(Ks_ + KSWZ(32 + r32, cb)); } \
        SBAR(); _Pragma("unroll") for (int r = 0; r < 16; ++r) { P0[r] = -mb; P1[r] = -mb; } float psum_ = 0.f; \
        P0 = __builtin_amdgcn_mfma_f32_32x32x16_bf16(kf0[0], qr[0], P0, 0, 0, 0); GAP_SUM8(S0, 0); \
        P1 = __builtin_amdgcn_mfma_f32_32x32x16_bf16(kf1[0], qr[0], P1, 0, 0, 0); GAP_SUM8(S0, 8); \
        P0 = __builtin_amdgcn_mfma_f32_32x32x16_bf16(kf0[1], qr[1], P0, 0, 0, 0); GAP_SUM8(S1, 0); \
        P1 = __builtin_amdgcn_mfma_f32_32x32x16_bf16(kf1[1], qr[1], P1, 0, 0, 0); GAP_SUM8(S1, 8); \
        P0 = __builtin_amdgcn_mfma_f32_32x32x16_bf16(kf0[2], qr[2], P0, 0, 0, 0); GAP_PK(S0, 0, pa0); \
        P1 = __builtin_amdgcn_mfma_f32_32x32x16_bf16(kf1[2], qr[2], P1, 0, 0, 0); GAP_PK(S0, 8, pa1); \
        P0 = __builtin_amdgcn_mfma_f32_32x32x16_bf16(kf0[3], qr[3], P0, 0, 0, 0); GAP_PK(S1, 0, pa2); \
        P1 = __builtin_amdgcn_mfma_f32_32x32x16_bf16(kf1[3], qr[3], P1, 0, 0, 0); GAP_PK(S1, 8, pa3); \
        P0 = __builtin_amdgcn_mfma_f32_32x32x16_bf16(kf0[4], qr[4], P0, 0, 0, 0); P1 = __builtin_amdgcn_mfma_f32_32x32x16_bf16(kf1[4], qr[4], P1, 0, 0, 0); \
        P0 = __builtin_amdgcn_mfma_f32_32x32x16_bf16(kf0[5], qr[5], P0, 0, 0, 0); P1 = __builtin_amdgcn_mfma_f32_32x32x16_bf16(kf1[5], qr[5], P1, 0, 0, 0); \
        psum_ = sum_x32(psum_); l_reg += psum_; SBAR(); } while (0)
#define BLK_PV(VB_, X0, X1) do { const int vb_ = (VB_); \
        const s16x4 a0l = tr_read<v_rd_off(0, 0, 0)>(vb_), a0h = tr_read<v_rd_off(0, 0, 1)>(vb_), b0l = tr_read<v_rd_off(1, 0, 0)>(vb_), b0h = tr_read<v_rd_off(1, 0, 1)>(vb_); \
        const s16x4 a1l = tr_read<v_rd_off(0, 1, 0)>(vb_), a1h = tr_read<v_rd_off(0, 1, 1)>(vb_), b1l = tr_read<v_rd_off(1, 1, 0)>(vb_), b1h = tr_read<v_rd_off(1, 1, 1)>(vb_); \
        const s16x4 a2l = tr_read<v_rd_off(0, 2, 0)>(vb_), a2h = tr_read<v_rd_off(0, 2, 1)>(vb_), b2l = tr_read<v_rd_off(1, 2, 0)>(vb_), b2h = tr_read<v_rd_off(1, 2, 1)>(vb_); \
        const s16x4 a3l = tr_read<v_rd_off(0, 3, 0)>(vb_), a3h = tr_read<v_rd_off(0, 3, 1)>(vb_), b3l = tr_read<v_rd_off(1, 3, 0)>(vb_), b3h = tr_read<v_rd_off(1, 3, 1)>(vb_); \
        asm volatile("s_waitcnt lgkmcnt(0)" ::: "memory"); SBAR(); \
        o0 = __builtin_amdgcn_mfma_f32_32x32x16_bf16(pa0, PKV(a0l, a0h), o0, 0, 0, 0); GAP_EXP4(X0, 0); \
        o1 = __builtin_amdgcn_mfma_f32_32x32x16_bf16(pa0, PKV(b0l, b0h), o1, 0, 0, 0); GAP_EXP4(X0, 4); \
        o0 = __builtin_amdgcn_mfma_f32_32x32x16_bf16(pa1, PKV(a1l, a1h), o0, 0, 0, 0); GAP_EXP4(X0, 8); \
        o1 = __builtin_amdgcn_mfma_f32_32x32x16_bf16(pa1, PKV(b1l, b1h), o1, 0, 0, 0); GAP_EXP4(X0, 12); \
        o0 = __builtin_amdgcn_mfma_f32_32x32x16_bf16(pa2, PKV(a2l, a2h), o0, 0, 0, 0); GAP_EXP4(X1, 0); \
        o1 = __builtin_amdgcn_mfma_f32_32x32x16_bf16(pa2, PKV(b2l, b2h), o1, 0, 0, 0); GAP_EXP4(X1, 4); \
        o0 = __builtin_amdgcn_mfma_f32_32x32x16_bf16(pa3, PKV(a3l, a3h), o0, 0, 0, 0); GAP_EXP4(X1, 8); \
        o1 = __builtin_amdgcn_mfma_f32_32x32x16_bf16(pa3, PKV(b3l, b3h), o1, 0, 0, 0); GAP_EXP4(X1, 12); } while (0)
    bool pend = false;
    if (wid < 4) __builtin_amdgcn_s_setprio(1);
    f32x16 pA0 = {}, pA1 = {}, pB0 = {}, pB1 = {}; bf16x8 pa0 = {}, pa1 = {}, pa2 = {}, pa3 = {};
    for (int s = 0; s < NS; ++s) {
        const int bf = s & 1;
        asm volatile("s_waitcnt vmcnt(0)" ::: "memory");
        SWRITE(bf);
        if (s + 1 < NS) SLOAD((s + 1) * 128);
        __syncthreads();
        const bool va = 2 * s <= cw, vb2 = 2 * s + 1 <= cw;
        const char* Kb_ = K_lds + bf * SHM_K; const int vbase = vb0 + bf * SHM_V;
        SBAR();
        if (va && vb2 && pend) {
            const int vprev = vb0 + (bf ^ 1) * SHM_V + 8192;
            BLK_QK(pA0, pA1, Kb_, pB0, pB1);
            BLK_PV(vprev, pA0, pA1);
            BLK_QK(pB0, pB1, Kb_ + 16384, pA0, pA1);
            BLK_PV(vbase, pB0, pB1);
        } else {
            if (pend) { SUMPACK(pB0, pB1); SBAR(); PV(vb0 + (bf ^ 1) * SHM_V + 8192); }
            if (va) { QKT(pA0, pA1, Kb_); EXPALL(pA0, pA1); SUMPACK(pA0, pA1); SBAR(); PV(vbase); }
            if (vb2) { QKT(pB0, pB1, Kb_ + 16384); EXPALL(pB0, pB1); }
        }
        pend = vb2;
    }
    if (pend) { SUMPACK(pB0, pB1); SBAR(); PV(vb0 + ((NS - 1) & 1) * SHM_V + 8192); }
    __builtin_amdgcn_s_setprio(0);
#undef BLK_QK
#undef BLK_PV
#undef SUMPACK
#undef EXPALL
#undef GAP_EXP4
#undef GAP_SUM8
#undef GAP_PK
#undef PKV
#undef SLOAD
#undef SWRITE
#undef QKT
#undef SMX
#undef PK4
#undef PV
    if (hi == 0) li_l[r32] = l_reg; asm volatile("s_waitcnt lgkmcnt(0)" ::: "memory");
    bf16_t* ot = (bf16_t*)(lds + OFF_WS + 2048) + wid * 2048;
#pragma unroll
    for (int r = 0; r < 16; ++r) { const int orow = crow(r, hi); const float rl = __builtin_amdgcn_rcpf(li_l[orow]);
        ot[orow * 64 + r32] = (bf16_t)f2bf(o0[r] * rl); ot[orow * 64 + 32 + r32] = (bf16_t)f2bf(o1[r] * rl); }
    asm volatile("s_waitcnt lgkmcnt(0)" ::: "memory");
    bf16_t* Ow = OB + (size_t)(b * SEQ + qb * 256 + wid * 32) * 512 + h * 64;
#pragma unroll
    for (int i = 0; i < 4; ++i) { const int ch = i * 64 + lane, orow = ch >> 3, oc = (ch & 7) * 8;
        *(u32x4*)(Ow + (size_t)orow * 512 + oc) = *(const u32x4*)(ot + orow * 64 + oc); }
    asm volatile("s_waitcnt lgkmcnt(0)" ::: "memory");
}
#undef KSWZ
}

__device__ __forceinline__ float wave_sum(float v) {
    return sum_x32(sum_x16(row_sum16(v)));
}
__device__ __forceinline__ float wave_max(float v) {
    return max_x32(max_x16(row_max16(v)));
}

struct TDesc { const float* W; const float* gain; bf16_t* WT; int K, N, kb, dr0, sc0; };
__device__ __forceinline__ void tr_load(const TDesc& d, f32x4 (&v)[8], int lane) {
    if (d.sc0 < 0) { float z = 0.f; asm volatile("" : "+v"(z));
#pragma unroll
        for (int i = 0; i < 8; ++i) v[i] = (f32x4){z, z, z, z};
        return; }
    const float* src = d.W + (size_t)(64 * d.kb + (lane >> 3)) * d.N + d.sc0 + 4 * (lane & 7);
#pragma unroll
    for (int i = 0; i < 8; ++i) v[i] = __builtin_nontemporal_load((const f32x4*)(src + (size_t)(8 * i) * d.N));
}
__device__ __forceinline__ void tr_store(const TDesc& d, const f32x4 (&v)[8], LAS float* scr, int lane) {
    const int k0 = 64 * d.kb, K = d.K;
    if (d.sc0 < 0) {
#pragma unroll
        for (int j = 0; j < 4; ++j) { const int n = (lane >> 3) + 8 * j; *(u32x4*)(d.WT + (size_t)(d.dr0 + n) * K + k0 + 8 * (lane & 7)) = (u32x4){0u, 0u, 0u, 0u}; }
        return;
    }
#pragma unroll
    for (int i = 0; i < 8; ++i) { const int kk = 8 * i + (lane >> 3); const float g = d.gain ? d.gain[k0 + kk] : 1.0f; LAS float* s = scr + kk * 33 + 4 * (lane & 7);
        s[0] = v[i][0] * g; s[1] = v[i][1] * g; s[2] = v[i][2] * g; s[3] = v[i][3] * g; }
    asm volatile("s_waitcnt lgkmcnt(0)" ::: "memory");
    const int c = lane & 7;
#pragma unroll
    for (int j = 0; j < 4; ++j) { const int n = (lane >> 3) + 8 * j; const LAS float* s = scr + (8 * c) * 33 + n;
        u32x4 o; o.x = cvt_pk_bf16(s[0 * 33], s[1 * 33]); o.y = cvt_pk_bf16(s[2 * 33], s[3 * 33]); o.z = cvt_pk_bf16(s[4 * 33], s[5 * 33]); o.w = cvt_pk_bf16(s[6 * 33], s[7 * 33]);
        *(u32x4*)(d.WT + (size_t)(d.dr0 + n) * K + k0 + 8 * c) = o; }
    asm volatile("s_waitcnt lgkmcnt(0)" ::: "memory");
}
__device__ __forceinline__ int win_src(int nb) {
    if (nb < 64) return 1184 + 32 * nb;
    if (nb < 80) return 672 + 32 * (nb - 64);
    if (nb < 88) return 384 + 32 * (nb - 80);
    if (nb < 96) return 32 * (nb - 88);
    if (nb < 100) return 256 + 32 * (nb - 96);
    if (nb == 100) return 640;
    return -1;
}
__device__ __forceinline__ int ukv_src(int nb) { const int pn = nb >> 3, bj = (nb >> 2) & 1, wc = nb & 3; return pn < 2 ? 128 * (4 * pn + wc) + 32 * bj : 128 * (4 * (pn - 2) + wc) + 64 + 32 * bj; }

constexpr int MIXW_ITEMS = 16 * 104 + 6 * 24 + 4 * 32 + 8 * 32 + 8 * 64 + 16 * 32;
__device__ __forceinline__ TDesc mixw_desc(const Params& P, int it2) {
    const int l = it2 / MIXW_ITEMS; int r = it2 % MIXW_ITEMS;
    bf16_t* wm = (bf16_t*)(P.ws + WS_WMIX + (unsigned)(l * (int)WMIX_LAYER));
    if (r < 16 * 104) { const int kb = r / 104, nb = r % 104; return TDesc{P.in[3] + (unsigned)(l * 1024 * 3232), P.in[2] + l * 1024, wm + WM_IN / 2, 1024, 3232, kb, 32 * nb, win_src(nb)}; } r -= 16 * 104;
    if (r < 6 * 24) { const int kb = r / 24, nb = r % 24; return TDesc{P.in[5] + (unsigned)(l * 384 * 768), P.in[4] + l * 384, wm + WM_UQ / 2, 384, 768, kb, 32 * nb, 32 * nb}; } r -= 6 * 24;
    if (r < 4 * 32) { const int kb = r / 32, nb = r % 32; return TDesc{P.in[7] + (unsigned)(l * 256 * 1024), P.in[6] + l * 256, wm + WM_UKV / 2, 256, 1024, kb, 32 * nb, ukv_src(nb)}; } r -= 4 * 32;
    if (r < 8 * 32) { const int kb = r / 32, nb = r % 32; return TDesc{P.in[10] + (unsigned)(l * 512 * 1024), nullptr, wm + WM_PROJ / 2, 512, 1024, kb, 32 * nb, 32 * nb}; } r -= 8 * 32;
    if (r < 8 * 64) { const int kb = r / 64, nb = r % 64; const int pn = nb >> 3, half = (nb >> 2) & 1, q = nb & 3;
        return TDesc{P.in[19] + (unsigned)(l * 512 * 2048), nullptr, wm + WM_GLU / 2, 512, 2048, kb, 32 * nb, half * 1024 + 128 * pn + 32 * q}; } r -= 8 * 64;
    { const int kb = r / 32, nb = r % 32; return TDesc{P.in[20] + (unsigned)(l * 1024 * 1024), nullptr, wm + WM_OUT / 2, 1024, 1024, kb, 32 * nb, 32 * nb}; }
}
constexpr int EXPW_ITEMS = 32 * (256 + 128);
__device__ __forceinline__ TDesc expw_desc(const Params& P, int l, int it) {
    const int e = it / 384; int r = it % 384;
    if (r < 256) { const int kb = r >> 4, nb = r & 15, half = (nb >> 2) & 1, t2 = nb >> 3, q = nb & 3;
        return TDesc{(half ? P.in[25] : P.in[24]) + ((size_t)l * NE + e) * 1024 * 256, P.in[21] + l * 1024, (bf16_t*)(P.ws + WS_WGU) + (size_t)e * 512 * 1024, 1024, 256, kb, 32 * nb, 128 * t2 + 32 * q}; }
    r -= 256;
    { const int kb = r >> 5, nb = r & 31;
        return TDesc{P.in[26] + ((size_t)l * NE + e) * 256 * 1024, nullptr, (bf16_t*)(P.ws + WS_WD) + (size_t)e * 1024 * 256, 256, 1024, kb, 32 * nb, 32 * nb}; }
}
#define TR_LOOP(DESC_EXPR_OF_IT, FIRST, COUNT, STRIDE) do { \
    for (int it0 = (FIRST); it0 < (COUNT); it0 += 4 * (STRIDE)) { f32x4 va[8], vb[8], vc[8], vd[8]; \
        int it = it0; const TDesc da = DESC_EXPR_OF_IT; tr_load(da, va, lane); \
        it = it0 + (STRIDE); const bool h1 = it < (COUNT); if (!h1) it = it0; const TDesc db = DESC_EXPR_OF_IT; tr_load(db, vb, lane); \
        it = it0 + 2 * (STRIDE); const bool h2 = it < (COUNT); if (!h2) it = it0; const TDesc dc = DESC_EXPR_OF_IT; tr_load(dc, vc, lane); \
        it = it0 + 3 * (STRIDE); const bool h3 = it < (COUNT); if (!h3) it = it0; const TDesc dd = DESC_EXPR_OF_IT; tr_load(dd, vd, lane); \
        tr_store(da, va, scr, lane); if (h1) tr_store(db, vb, scr, lane); if (h2) tr_store(dc, vc, scr, lane); if (h3) tr_store(dd, vd, scr, lane); } } while (0)

constexpr int SSM_PARTS = 4, SSM_CH = 16 / SSM_PARTS;
__device__ __forceinline__ void ssm_tables(const Params& P, int l, int g, int r, LAS unsigned char* scr) {
    int tid_ = threadIdx.x; asm volatile("" : "+v"(tid_)); const int tid = tid_;
    LAS f32x2* pw = (LAS f32x2*)scr;
    LAS f32x2* Bb = pw + 33 * 64;
    LAS f32x2* Cc = Bb + 64 * 16;
    LAS float* Kd = (LAS float*)(Cc + SSM_CH * 64);
    LAS float* Dk = Kd + 32 * SSM_CH * 16;
    const int lg = l * SSG + g;
    const float dt = expf(P.in[13][lg]);
    const float* lre = P.in[11] + (size_t)lg * 64; const float* lim = P.in[12] + (size_t)lg * 64;
    for (int idx = tid; idx < 33 * 64; idx += 512) { const int d = idx >> 6, p = idx & 63;
        const float mag = expf(lre[p] * dt * (float)d);
        const double ang = (double)lim[p] * (double)dt * (double)d * 0.15915494309189535; const float fr = (float)(ang - floor(ang));
        pw[idx] = (f32x2){mag * __builtin_amdgcn_cosf(fr), mag * __builtin_amdgcn_sinf(fr)}; }
    if (tid < SSM_CH) Dk[tid] = P.in[18][(size_t)lg * 16 + SSM_CH * r + tid];
    if (tid < SSM_CH * 64) { const int i = SSM_CH * r + (tid >> 6), p = tid & 63; Cc[tid] = (f32x2){P.in[16][((size_t)lg * 16 + i) * 64 + p], P.in[17][((size_t)lg * 16 + i) * 64 + p]}; }
    __syncthreads();
    for (int idx = tid; idx < 1024; idx += 512) { const int p = idx >> 4, j = idx & 15;
        const float ar = pw[64 + p].x - 1.0f, ai = pw[64 + p].y, cr = lre[p], ci = lim[p], den = 1.0f / (cr * cr + ci * ci);
        const float qr = (ar * cr + ai * ci) * den, qi = (ai * cr - ar * ci) * den;
        const float br = P.in[14][((size_t)lg * 64 + p) * 16 + j], bi = P.in[15][((size_t)lg * 64 + p) * 16 + j];
        Bb[idx] = (f32x2){qr * br - qi * bi, qr * bi + qi * br}; }
    __syncthreads();
    for (int idx = tid; idx < 32 * SSM_CH * 16; idx += 512) { const int d = idx / (SSM_CH * 16), ii = (idx >> 4) % SSM_CH, j = idx & 15; float s = 0.f;
        for (int p = 0; p < 64; ++p) { const f32x2 c = Cc[ii * 64 + p], w = pw[d * 64 + p], bq = Bb[p * 16 + j];
            const float tr = c.x * w.x - c.y * w.y, ti = c.x * w.y + c.y * w.x; s += tr * bq.x - ti * bq.y; }
        Kd[idx] = s; }
    __syncthreads();
    bf16_t* tm = (bf16_t*)(P.ws + WS_TMAT) + (size_t)g * 512 * KIN;
    for (int v = tid; v < 32 * SSM_CH * (KIN / 8); v += 512) { const int nn = v / (KIN / 8), k0 = (v % (KIN / 8)) * 8, t = nn / SSM_CH, ii = nn % SSM_CH, i = SSM_CH * r + ii, n = t * 16 + i; float e[8];
#pragma unroll
        for (int q = 0; q < 8; ++q) { const int k = k0 + q; float val;
            if (k < 512) { const int s = k >> 4, j = k & 15; val = (s <= t) ? Kd[((t - s) * SSM_CH + ii) * 16 + j] + ((s == t && i == j) ? Dk[ii] : 0.f) : 0.f; }
            else { const int p = (k - 512) & 63; const f32x2 c = Cc[ii * 64 + p], w = pw[(t + 1) * 64 + p]; val = (k < 576) ? (c.x * w.x - c.y * w.y) : -(c.x * w.y + c.y * w.x); }
            e[q] = val; }
        *(u32x4*)(tm + (size_t)n * KIN + k0) = (u32x4){cvt_pk_bf16(e[0], e[1]), cvt_pk_bf16(e[2], e[3]), cvt_pk_bf16(e[4], e[5]), cvt_pk_bf16(e[6], e[7])}; }
    bf16_t* wst = (bf16_t*)(P.ws + WS_WST) + (size_t)g * 256 * 512;
    for (int v = tid; v < (256 / SSM_PARTS) * 64; v += 512) { const int n = (256 / SSM_PARTS) * r + (v >> 6), k0 = (v & 63) * 8; float e[8];
#pragma unroll
        for (int q = 0; q < 8; ++q) { const int k = k0 + q, s = k >> 4, j = k & 15, p = n & 63; float val = 0.f;
            if (n < 128) { const f32x2 w = pw[(31 - s) * 64 + p], bq = Bb[p * 16 + j]; val = (n < 64) ? (w.x * bq.x - w.y * bq.y) : (w.x * bq.y + w.y * bq.x); }
            e[q] = val; }
        *(u32x4*)(wst + (size_t)n * 512 + k0) = (u32x4){cvt_pk_bf16(e[0], e[1]), cvt_pk_bf16(e[2], e[3]), cvt_pk_bf16(e[4], e[5]), cvt_pk_bf16(e[6], e[7])}; }
    if (r == 0 && tid < 64) { const f32x2 w = pw[32 * 64 + tid]; float* lam = (float*)(P.ws + WS_LAM) + (size_t)(g * 64 + tid) * 2; lam[0] = w.x; lam[1] = w.y; }
    __syncthreads();
}

__device__ __forceinline__ void router_weights(const Params& P, int l, int gtid, int gthreads) {
    bf16_t* wr = (bf16_t*)(P.ws + WS_WMIX + (size_t)l * WMIX_LAYER + WM_R);
    for (int idx = gtid; idx < 48 * 1024; idx += gthreads) { const int n = idx >> 10, k = idx & 1023; float v = 0.f;
        if (n < 4) v = P.in[22][((size_t)l * 1024 + k) * 4 + n]; else if (n < 36) v = P.in[23][((size_t)l * 1024 + k) * 32 + (n - 4)];
        wr[idx] = (bf16_t)f2bf(v * P.in[21][l * 1024 + k]); }
}

__device__ __forceinline__ void ssm_scan_task(const Params& P, int w, int lane) {
    const float* sst = (const float*)(P.ws + WS_SST); bf16_t* inb = (bf16_t*)(P.ws + WS_IN); const float* lam = (const float*)(P.ws + WS_LAM);
    const int g = w >> 4, b = w & 15;
    const float lr = lam[(g * 64 + lane) * 2], li = lam[(g * 64 + lane) * 2 + 1];
    const size_t r0 = (size_t)g * 1024 + b * 64;
    float sr[NCH], si[NCH];
#pragma unroll
    for (int c = 0; c < NCH; ++c) { sr[c] = sst[(r0 + c) * 128 + lane]; si[c] = sst[(r0 + c) * 128 + 64 + lane]; }
    float xr = 0.f, xi = 0.f;
#pragma unroll
    for (int c = 0; c < NCH; ++c) {
        inb[(r0 + c) * KIN + 512 + lane] = (bf16_t)f2bf(xr); inb[(r0 + c) * KIN + 576 + lane] = (bf16_t)f2bf(xi);
        const float nr = lr * xr - li * xi + sr[c], ni = lr * xi + li * xr + si[c]; xr = nr; xi = ni; }
}

__device__ __forceinline__ void router_phase(const Params& P, int l, LAS unsigned char* lds, int G, int c) {
    int tid_ = threadIdx.x; asm volatile("" : "+v"(tid_));
    const int tid = tid_, wid = tid >> 6, lane = tid & 63;
    const bf16_t* xb = (const bf16_t*)(P.ws + WS_XB); const bf16_t* wr = (const bf16_t*)(P.ws + WS_WMIX + (size_t)l * WMIX_LAYER + WM_R);
    const float* ssx = (const float*)(P.ws + WS_SSX);
    int* te = (int*)(P.ws + WS_TE); float* tw = (float*)(P.ws + WS_TW); float* trs = (float*)(P.ws + WS_TRS); int* cnt = (int*)(P.ws + WS_CNT);
    LAS float* lg = (LAS float*)lds + wid * (16 * 48); LAS int* lcnt = (LAS int*)(lds + 8 * 16 * 48 * 4);
    constexpr int WRP = 2064; LAS unsigned char* wl = lds + 32768;
    for (int q = tid; q < 48 * 128; q += 512) { const int row = q >> 7, ch = q & 127; *(LAS u32x4*)(wl + row * WRP + ch * 16) = *(const u32x4*)(wr + (size_t)row * 1024 + ch * 8); }
    for (int blk = c; blk < MT / 128; blk += G) {
        if (tid < 64) lcnt[tid] = 0;
        __syncthreads();
        const int t0 = blk * 128 + wid * 16;
        f32x4 a0 = {0.f, 0.f, 0.f, 0.f}, a1 = a0, a2 = a0;
        const bf16_t* ap = xb + (size_t)(t0 + (lane & 15)) * 1024 + 8 * (lane >> 4);
        const LAS unsigned char* bl = wl + (lane & 15) * WRP + 16 * (lane >> 4);
        bf16x8 af[32];
#pragma unroll
        for (int kk = 0; kk < 32; ++kk) af[kk] = *(const bf16x8*)(ap + kk * 32);
#pragma unroll
        for (int kk = 0; kk < 32; ++kk) { const bf16x8 b0 = *(const LAS bf16x8*)(bl + kk * 64), b1 = *(const LAS bf16x8*)(bl + 16 * WRP + kk * 64), b2 = *(const LAS bf16x8*)(bl + 32 * WRP + kk * 64);
            a0 = __builtin_amdgcn_mfma_f32_16x16x32_bf16(af[kk], b0, a0, 0, 0, 0); a1 = __builtin_amdgcn_mfma_f32_16x16x32_bf16(af[kk], b1, a1, 0, 0, 0); a2 = __builtin_amdgcn_mfma_f32_16x16x32_bf16(af[kk], b2, a2, 0, 0, 0); }
#pragma unroll
        for (int r = 0; r < 4; ++r) { const int trow = (lane >> 4) * 4 + r, col = lane & 15; lg[trow * 48 + col] = a0[r]; lg[trow * 48 + 16 + col] = a1[r]; lg[trow * 48 + 32 + col] = a2[r]; }
        asm volatile("s_waitcnt lgkmcnt(0)" ::: "memory");
        if (lane < 16) { const int tok = t0 + lane; const f32x4* sp = (const f32x4*)(ssx + (size_t)tok * 16); const f32x4 s0 = sp[0], s1 = sp[1], s2 = sp[2], s3 = sp[3];
            const float s = (((s0[0] + s0[1]) + (s0[2] + s0[3])) + ((s1[0] + s1[1]) + (s1[2] + s1[3]))) + (((s2[0] + s2[1]) + (s2[2] + s2[3])) + ((s3[0] + s3[1]) + (s3[2] + s3[3])));
            const float rs = __builtin_amdgcn_rsqf(s * (1.0f / 1024.0f) + EPS);
            float gl[4]; int gi = 0; float gm;
#pragma unroll
            for (int q = 0; q < 4; ++q) gl[q] = lg[lane * 48 + q] * rs;
            gm = gl[0];
#pragma unroll
            for (int q = 1; q < 4; ++q) if (gl[q] > gm) { gm = gl[q]; gi = q; }
            float gs = 0.f;
#pragma unroll
            for (int q = 0; q < 4; ++q) gs += expf(gl[q] - gm);
            const float gwt = 1.0f / gs;
            float el[8];
#pragma unroll
            for (int q = 0; q < 8; ++q) el[q] = lg[lane * 48 + 4 + gi * 8 + q] * rs;
            int i0 = 0; float m0 = el[0];
#pragma unroll
            for (int q = 1; q < 8; ++q) if (el[q] > m0) { m0 = el[q]; i0 = q; }
            int i1 = -1; float m1 = -3.0e38f;
#pragma unroll
            for (int q = 0; q < 8; ++q) if (q != i0 && el[q] > m1) { m1 = el[q]; i1 = q; }
            const float e1 = expf(m1 - m0), w0 = gwt / (1.0f + e1), w1 = gwt * e1 / (1.0f + e1);
            const int e0i = gi * 8 + i0, e1i = gi * 8 + i1;
            te[tok * 2] = e0i; te[tok * 2 + 1] = e1i; tw[tok * 2] = w0; tw[tok * 2 + 1] = w1; trs[tok] = rs;
            atomicAdd((int*)&lcnt[e0i], 1); atomicAdd((int*)&lcnt[32 + e1i], 1); }
        __syncthreads();
        if (tid < 64) cnt[blk * 64 + tid] = lcnt[tid];
        __syncthreads();
    }
}

__device__ __forceinline__ void scatter_phase(const Params& P, LAS unsigned char* lds, int G, int c) {
    int tid_ = threadIdx.x; asm volatile("" : "+v"(tid_)); const int tid = tid_;
    const int* te = (const int*)(P.ws + WS_TE); const float* tw = (const float*)(P.ws + WS_TW); const float* trs = (const float*)(P.ws + WS_TRS); const int* cnt = (const int*)(P.ws + WS_CNT);
    int* atok = (int*)(P.ws + WS_ATOK); float* aw = (float*)(P.ws + WS_AW); float* ars = (float*)(P.ws + WS_ARS); int* tseg = (int*)(P.ws + WS_TSEG);
    LAS int* tot = (LAS int*)lds; LAS int* bef = tot + 64; LAS int* base = bef + 64; LAS int* le = base + 65; LAS int* ptot = le + 256; LAS int* pbef = ptot + 512;
    for (int blk = c; blk < MT / 128; blk += G) {
        { const int sg = tid & 63, part = tid >> 6; int t = 0, b = 0;
#pragma unroll 8
          for (int q = part * 32; q < part * 32 + 32; ++q) { const int v = cnt[q * 64 + sg]; t += v; b += (q < blk) ? v : 0; }
          ptot[part * 64 + sg] = t; pbef[part * 64 + sg] = b; }
        if (tid < 256) le[tid] = te[blk * 256 + tid];
        __syncthreads();
        if (tid < 64) { int t = 0, b = 0;
#pragma unroll
            for (int q = 0; q < 8; ++q) { t += ptot[q * 64 + tid]; b += pbef[q * 64 + tid]; }
            tot[tid] = t; bef[tid] = b; }
        __syncthreads();
        if (tid == 0) { int s = 0; for (int q = 0; q < 64; ++q) { base[q] = s; s += (tot[q] + 255) & ~255; } base[64] = s; }
        __syncthreads();
        if (tid < 256) {
            const int i = tid >> 1, k = tid & 1, sg = k * 32 + le[tid]; int rank = 0;
            for (int a = 0; a < tid; ++a) rank += ((a & 1) * 32 + le[a] == sg) ? 1 : 0;
            const int tok = blk * 128 + i, pos = base[sg] + bef[sg] + rank;
            atok[pos] = tok; aw[pos] = tw[tok * 2 + k]; ars[pos] = trs[tok]; }
        if (blk < 64) {
            int neg1 = -1; asm volatile("" : "+v"(neg1));
            for (int r = base[blk] + tot[blk] + tid; r < base[blk + 1]; r += 512) { atok[r] = neg1; aw[r] = 0.f; ars[r] = 0.f; }
            for (int t = (base[blk] >> 8) + tid; t < (base[blk + 1] >> 8); t += 512) tseg[t] = blk;
            if (blk == 0 && tid == 0) { tseg[512] = base[32] >> 8; tseg[513] = base[64] >> 8; } }
        __syncthreads();
    }
}
__constant__ double ROPE_INVF[16] = {1.0, 0.5623413251903491, 0.31622776601683794, 0.1778279410038923, 0.1, 0.05623413251903491, 0.03162277660168379, 0.01778279410038923, 0.01,
                                     0.005623413251903491, 0.0031622776601683794, 0.0017782794100389228, 0.001, 0.0005623413251903491, 0.00031622776601683794, 0.00017782794100389227};
constexpr int PH_PER_LAYER = 11, NPH = 1 + PH_PER_LAYER * DEPTH;

__global__ void __launch_bounds__(512, 2) mk_fwd(Params P_) {
    extern __shared__ __attribute__((aligned(16))) unsigned char lds_raw[];
    LAS unsigned char* lds = (LAS unsigned char*)lds_raw;
    const int G = gridDim.x;
#define WSFENCE const Params P = load_params(); unsigned char* ws = P.ws; int tid_f = threadIdx.x, c_f = blockIdx.x; asm volatile("" : "+v"(tid_f), "+s"(c_f)); \
    const int tid = tid_f, lane = tid & 63, wid = __builtin_amdgcn_readfirstlane(tid >> 6), c = c_f, gw = c * 8 + wid, ngw = G * 8; (void)ws; (void)tid; (void)lane; (void)wid; (void)gw; (void)ngw
    volatile LAS unsigned* MISC = (volatile LAS unsigned*)(lds + MISC_OFF);
    if (threadIdx.x < 64) MISC[threadIdx.x] = 0u;
    __syncthreads();
    XcdBarrier bar; bar.bar = (unsigned*)(P_.ws + WS_CTL); bar.x = 0; bar.st = nullptr;
    const bool multi = (P_.ph_hi - P_.ph_lo) > 1;
    if (multi) bar = xcd_barrier_post((unsigned*)(P_.ws + WS_CTL), MISC + 8);
    LAS int* idxlds = (LAS int*)(lds + IDX_OFF);
    const int lo = P_.ph_lo, hi = P_.ph_hi;
#ifndef PHMASK
#define PHMASK 0x7fff
#endif
#define IN(k) (lo <= (k) && (k) < hi)
#define EN(i) ((PHMASK >> (i)) & 1)
#ifndef REPMASK
#define REPMASK 0
#endif
#define REPS(i) (((REPMASK >> (i)) & 1) ? 2 : 1)
#define SEAM(k) do { if (IN(k) && IN((k) + 1)) xcd_barrier(bar); } while (0)

    if (EN(0) && IN(0)) { WSFENCE;
        LAS float* scr = (LAS float*)(lds + wid * 8448);
        if (!(P.variant & 128)) TR_LOOP(mixw_desc(P, it), gw, 2 * MIXW_ITEMS, ngw);
        router_weights(P, 0, c * 512 + tid, G * 512); router_weights(P, 1, c * 512 + tid, G * 512);
        {
            const int* pos = (const int*)P.in[1]; float* rope = (float*)(ws + WS_ROPE);
            for (int idx = c * 512 + tid; idx < MT * 16; idx += G * 512) { const int tok = idx >> 4, i = idx & 15;
                const double t = (double)pos[tok] * ROPE_INVF[i] * 0.15915494309189535; const float fr = (float)(t - floor(t));
                const float cs = __builtin_amdgcn_cosf(fr), sn = __builtin_amdgcn_sinf(fr); bf16_t* ropeb = (bf16_t*)(ws + WS_ROPEB);
                rope[(size_t)tok * 32 + i] = cs; rope[(size_t)tok * 32 + 16 + i] = sn; ropeb[(size_t)tok * 32 + i] = (bf16_t)f2bf(cs); ropeb[(size_t)tok * 32 + 16 + i] = (bf16_t)f2bf(sn); }
        }
        {
            const float* x = P.in[0]; bf16_t* xb = (bf16_t*)(ws + WS_XB); float* ssx = (float*)(ws + WS_SSX);
            if (!(P.variant & 256)) for (int m = gw; m < MT; m += ngw) { const f32x4* xr = (const f32x4*)(x + (size_t)m * DM) + lane; f32x4 v[4]; float s = 0.f;
#pragma unroll
                for (int j = 0; j < 4; ++j) { v[j] = __builtin_nontemporal_load(xr + 64 * j); s += (v[j][0] * v[j][0] + v[j][1] * v[j][1]) + (v[j][2] * v[j][2] + v[j][3] * v[j][3]); }
                s = wave_sum(s);
                u32x2* o = (u32x2*)(xb + (size_t)m * DM) + lane;
#pragma unroll
                for (int j = 0; j < 4; ++j) { u32x2 w; w.x = cvt_pk_bf16(v[j][0], v[j][1]); w.y = cvt_pk_bf16(v[j][2], v[j][3]); o[64 * j] = w; }
                if (lane < 16) ssx[(size_t)m * 16 + lane] = lane == 0 ? s : 0.f; }
        }
    }
    SEAM(0);

    for (int l = 0; l < DEPTH; ++l) {
        const int pb = 1 + PH_PER_LAYER * l;
        if (EN(1) && IN(pb + 0)) { WSFENCE;
            pg8::Gemm g{(const bf16_t*)(ws + WS_XB), (const bf16_t*)(ws + WS_WMIX + (size_t)l * WMIX_LAYER + WM_IN), 1024, 1024, (P.variant >> 4) & 1}; pg8::StaticOrder S; S.init(MT, NIN, G, c);
            { const int nu = (MT / 256) * (NIN / 256), nshort = G - nu % G, first = nu % G;
              if (nu % G == 0) { for (int t = c; t < SSG * SSM_PARTS; t += G) ssm_tables(P, l, t / SSM_PARTS, t % SSM_PARTS, lds); }
              else if (c >= first) { for (int t = c - first; t < SSG * SSM_PARTS; t += nshort) ssm_tables(P, l, t / SSM_PARTS, t % SSM_PARTS, lds); } }
            EpiIn E{ws};
            pg8::gemm_phase<EpiIn, pg8::StaticOrder>(lds, idxlds, g, S, E);
        }
        SEAM(pb + 0);
        if (EN(2) && IN(pb + 1)) { WSFENCE;
            { pg8::Gemm g{(const bf16_t*)(ws + WS_QC), (const bf16_t*)(ws + WS_WMIX + (size_t)l * WMIX_LAYER + WM_UQ), 384, 384, (P.variant >> 10) & 1}; pg8::StaticOrder S; S.init(MT, 768, G, c);
              EpiPlain E{ws, WS_TQ, 768}; pg8::gemm_phase<EpiPlain, pg8::StaticOrder>(lds, idxlds, g, S, E); }
            { pg8::Gemm g{(const bf16_t*)(ws + WS_KVC), (const bf16_t*)(ws + WS_WMIX + (size_t)l * WMIX_LAYER + WM_UKV), 256, 256, (P.variant >> 11) & 1}; pg8::StaticOrder S; S.init(MT, 1024, G, c);
              LAS float* gkl = (LAS float*)(lds + MISC_OFF + 256);
              if (tid < 96) gkl[tid] = P.in[9][l * 96 + tid];
              __syncthreads();
              EpiKV E{ws, gkl};
              pg8::gemm_phase<EpiKV, pg8::StaticOrder>(lds, idxlds, g, S, E); }
            { pg8::Gemm g{(const bf16_t*)(ws + WS_IN), (const bf16_t*)(ws + WS_WST), 512, KIN, (P.variant >> 12) & 1}; SsmSOrder S{G, c};
              EpiS E{ws}; pg8::gemm_phase<EpiS, SsmSOrder>(lds, idxlds, g, S, E); }
        }
        SEAM(pb + 1);
        if (EN(3) && IN(pb + 2)) { WSFENCE;
            if (wid < 2) for (int t = c * 2 + wid; t < SSG * NB; t += G * 2) ssm_scan_task(P, t, lane);
            const float* gk = P.in[9] + l * 96;
            float gmx = fmaxf(fabsf(gk[lane]), lane < 32 ? fabsf(gk[64 + lane]) : 0.f); gmx = wave_max(gmx);
            const float kbound = 9.797958971132712f * gmx;
            __syncthreads();
            for (int L = c; L < NB * NH * 8; L += G) { const int p = L & 127, k = L >> 7, b = p >> 3, h = p & 7;
                const int qb = (k == 0) ? 7 : (k == 1) ? 6 : (k == 2) ? 0 : (k == 3) ? 1 : (k == 4) ? 5 : (k == 5) ? 4 : (k == 6) ? 2 : 3;
                att::attn_unit((char*)lds_raw, b, h, qb, (const bf16_t*)(ws + WS_TQ), (const float*)(ws + WS_QSS), (const float*)(ws + WS_ROPE), P.in[8] + l * 96, kbound,
                               (const bf16_t*)(ws + WS_KB), (const bf16_t*)(ws + WS_VB), (bf16_t*)(ws + WS_OB), P.variant);
                __syncthreads(); }
        }
        SEAM(pb + 2);
        if (EN(4) && IN(pb + 3)) { WSFENCE;
            { pg8::Gemm g{(const bf16_t*)(ws + WS_IN), (const bf16_t*)(ws + WS_TMAT), KIN, KIN}; SsmYOrder S{G, c};
              EpiY E{ws}; pg8::gemm_phase<EpiY, SsmYOrder>(lds, idxlds, g, S, E); }
            { pg8::Gemm g{(const bf16_t*)(ws + WS_OB), (const bf16_t*)(ws + WS_WMIX + (size_t)l * WMIX_LAYER + WM_PROJ), 512, 512}; pg8::StaticOrder S; S.init(MT, 1024, G, c);
              EpiProj E{ws}; pg8::gemm_phase<EpiProj, pg8::StaticOrder>(lds, idxlds, g, S, E); }
        }
        SEAM(pb + 3);
        if (EN(5) && IN(pb + 4)) { WSFENCE;
            pg8::Gemm g{(const bf16_t*)(ws + WS_YB), (const bf16_t*)(ws + WS_WMIX + (size_t)l * WMIX_LAYER + WM_GLU), 512, 512, (P.variant >> 4) & 1}; pg8::StaticOrder S; S.init(MT, 2048, G, c);
            EpiGlu E{ws}; pg8::gemm_phase<EpiGlu, pg8::StaticOrder>(lds, idxlds, g, S, E);
        }
        SEAM(pb + 4);
        if (EN(6) && IN(pb + 5)) { WSFENCE;
            pg8::Gemm g{(const bf16_t*)(ws + WS_MG), (const bf16_t*)(ws + WS_WMIX + (size_t)l * WMIX_LAYER + WM_OUT), 1024, 1024}; pg8::StaticOrder S; S.init(MT, 1024, G, c);
            EpiOut E{ws}; pg8::gemm_phase<EpiOut, pg8::StaticOrder>(lds, idxlds, g, S, E);
        }
        SEAM(pb + 5);
        if (EN(7) && IN(pb + 6)) { WSFENCE;
            if (!(P.variant & 64)) router_phase(P, l, lds, G, c);
            LAS float* scr = (LAS float*)(lds + 32768 + wid * 8448);
            if (!(P.variant & 32)) TR_LOOP(expw_desc(P, l, it), gw, EXPW_ITEMS, ngw);
        }
        SEAM(pb + 6);
        if (EN(8) && IN(pb + 7)) { WSFENCE; scatter_phase(P, lds, G, c); }
        SEAM(pb + 7);
        if (EN(9) && IN(pb + 8)) { WSFENCE;
            const int* tseg = (const int*)(ws + WS_TSEG); const int ntT = tseg[513];
            pg8::Gemm g{(const bf16_t*)(ws + WS_XB), (const bf16_t*)(ws + WS_WGU), 1024, 1024};
            MoeGatherOrder S; S.tseg = tseg; S.tile0 = 0; S.ntile = ntT; S.NC = 2; S.G = G; S.c = c; S.gidx = (const int*)(ws + WS_ATOK); S.lmax = 2 * G;
            EpiGU E{ws}; pg8::gemm_phase<EpiGU, MoeGatherOrder>(lds, idxlds, g, S, E);
        }
        SEAM(pb + 8);
        if (EN(10) && IN(pb + 9)) { WSFENCE;
            const int* tseg = (const int*)(ws + WS_TSEG); const int ntA = tseg[512], ntT = tseg[513];
            const int nleft = (2 * ntT > 2 * G) ? 2 * ntT - 2 * G : 0;
            if (nleft > 0) { pg8::Gemm g{(const bf16_t*)(ws + WS_XB), (const bf16_t*)(ws + WS_WGU), 1024, 1024};
                MoeGatherOrder S; S.tseg = tseg; S.tile0 = 0; S.ntile = ntT; S.NC = 2; S.G = G; S.c = c; S.gidx = (const int*)(ws + WS_ATOK); S.loff = 2 * G;
                EpiGU E{ws}; pg8::gemm_phase<EpiGU, MoeGatherOrder>(lds, idxlds, g, S, E); }
            pg8::Gemm g{(const bf16_t*)(ws + WS_HH), (const bf16_t*)(ws + WS_WD), 256, 256};
            MoeDownAOrder S; S.tseg = tseg; S.tile0 = 0; S.ntile = ntA; S.NC = 4; S.G = G; S.c = c; S.nbusy = nleft < G ? nleft : G - 1;
            EpiDown<false> E{ws, nullptr}; pg8::gemm_phase<EpiDown<false>, MoeDownAOrder>(lds, idxlds, g, S, E);
        }
        SEAM(pb + 9);
        if (EN(11) && IN(pb + 10)) { WSFENCE;
            const int* tseg = (const int*)(ws + WS_TSEG); const int ntA = tseg[512], ntT = tseg[513];
            pg8::Gemm g{(const bf16_t*)(ws + WS_HH), (const bf16_t*)(ws + WS_WD), 256, 256};
            MoeOrder S; S.tseg = tseg; S.tile0 = ntA; S.ntile = ntT - ntA; S.NC = 4; S.G = G; S.c = c;
            EpiDown<true> E{ws, l + 1 == DEPTH ? P.out : nullptr}; pg8::gemm_phase<EpiDown<true>, MoeOrder>(lds, idxlds, g, S, E);
        }
        SEAM(pb + 10);
    }
#undef IN
#undef SEAM
}

#ifndef MK_PER_PHASE
#define MK_PER_PHASE 0
#endif
extern "C" void kernel_launch(void* const* d_in, const int* in_sizes, int n_in, void* d_out, int out_size, void* d_ws, size_t ws_size, hipStream_t stream) {
    static int grid = 0;
    if (grid == 0) {
        if (n_in != 27 || in_sizes[0] != MT * DM || out_size != MT * DM || ws_size < WS_END) {
            fprintf(stderr, "kernel_launch: unexpected shapes: n_in %d in0 %d out %d ws %zu (need %zu)\n", n_in, n_in > 0 ? in_sizes[0] : -1, out_size, ws_size, (size_t)WS_END); grid = -1; return; }
        int dev = 0, cus = 0, per_cu = 0;
        if (hipGetDevice(&dev) != hipSuccess || hipDeviceGetAttribute(&cus, hipDeviceAttributeMultiprocessorCount, dev) != hipSuccess) { grid = -1; return; }
        if (hipFuncSetAttribute((const void*)mk_fwd, hipFuncAttributeMaxDynamicSharedMemorySize, LDS_BYTES) != hipSuccess) { fprintf(stderr, "kernel_launch: hipFuncSetAttribute failed\n"); grid = -1; return; }
        if (hipOccupancyMaxActiveBlocksPerMultiprocessor(&per_cu, (const void*)mk_fwd, 512, LDS_BYTES) != hipSuccess || per_cu < 1)
            fprintf(stderr, "kernel_launch: occupancy query reports %d workgroups per CU\n", per_cu);
        (void)hipGetLastError();
        grid = cus;
    }
    if (grid < 0) return;
    if (hipMemsetAsync((char*)d_ws + WS_CTL, 0, CTL_ZERO_BYTES, stream) != hipSuccess) return;
    Params p{};
    for (int i = 0; i < 27; ++i) p.in[i] = (const float*)d_in[i];
    p.out = (float*)d_out; p.ws = (unsigned char*)d_ws;
#if MK_PER_PHASE
    for (int ph = 0; ph < NPH; ++ph) { p.ph_lo = ph; p.ph_hi = ph + 1; hipLaunchKernelGGL(mk_fwd, dim3(grid), dim3(512), LDS_BYTES, stream, p); }
#else
    p.ph_lo = 0; p.ph_hi = NPH; hipLaunchKernelGGL(mk_fwd, dim3(grid), dim3(512), LDS_BYTES, stream, p);
#endif
#ifdef PROBE_PHASES
    p.out = (float*)((unsigned char*)d_ws + WS_S5G);
#ifdef PROBE_VARIANT
    p.variant = PROBE_VARIANT;
#endif
    for (int l = 0; l < DEPTH; ++l) for (int k = 0; k < PH_PER_LAYER; ++k) if ((PROBE_PHASES >> k) & 1) { p.ph_lo = 1 + PH_PER_LAYER * l + k; p.ph_hi = p.ph_lo + 1; hipLaunchKernelGGL(mk_fwd, dim3(grid), dim3(512), LDS_BYTES, stream, p); }
    if ((PROBE_PHASES >> 14) & 1) { p.ph_lo = 0; p.ph_hi = 1; hipLaunchKernelGGL(mk_fwd, dim3(grid), dim3(512), LDS_BYTES, stream, p); }
#endif
    const hipError_t le = hipPeekAtLastError();
    if (le != hipSuccess) fprintf(stderr, "kernel_launch: launch failed: %s\n", hipGetErrorName(le));
}
```

```cpp
#include <hip/hip_runtime.h>
#include <cstdio>
#include <cstdint>

#define GAS __attribute__((address_space(1)))
#define LAS __attribute__((address_space(3)))
typedef unsigned short bf16_t;
typedef short bf16x8 __attribute__((ext_vector_type(8)));
typedef short s16x4 __attribute__((ext_vector_type(4)));
typedef float f32x4 __attribute__((ext_vector_type(4)));
typedef float f32x2 __attribute__((ext_vector_type(2)));
typedef float f32x16 __attribute__((ext_vector_type(16)));
typedef unsigned u32x4 __attribute__((ext_vector_type(4)));
typedef unsigned u32x2 __attribute__((ext_vector_type(2)));

constexpr int NB = 16, SEQ = 2048, DM = 1024, MT = NB * SEQ, DEPTH = 2;
constexpr int NH = 8, DQK = 96, DV = 64, QL = 384, KVL = 256, DR = 32;
constexpr int SSW = 512, SSG = 32, SSP = 64;
constexpr int LC = 32, NCH = SEQ / LC, KIN = LC * 16 + 128;
constexpr int NIN = 3328;
constexpr int NE = 32, DE = 256;
constexpr float EPS = 1e-6f;
constexpr int MAXTILES = 320, MAXROWS = MAXTILES * 256;

__device__ __forceinline__ unsigned f2bf(float f) { unsigned u = __builtin_bit_cast(unsigned, f); return (u + 0x7fffu + ((u >> 16) & 1u)) >> 16; }
__device__ __forceinline__ unsigned pk2(float lo, float hi) { return f2bf(lo) | (f2bf(hi) << 16); }
__device__ __forceinline__ float bf2f(unsigned short h) { return __builtin_bit_cast(float, (unsigned)h << 16); }
__device__ __forceinline__ float bflo(unsigned w) { return __builtin_bit_cast(float, w << 16); }
__device__ __forceinline__ float bfhi(unsigned w) { return __builtin_bit_cast(float, w & 0xffff0000u); }
__device__ __forceinline__ unsigned cvt_pk_bf16(float lo, float hi) { unsigned r; asm volatile("v_cvt_pk_bf16_f32 %0, %1, %2" : "=v"(r) : "v"(lo), "v"(hi)); return r; }
__device__ __forceinline__ float fast_sigmoid(float v) { return __builtin_amdgcn_rcpf(1.0f + __builtin_amdgcn_exp2f(-1.4426950408889634f * v)); }


__device__ __forceinline__ void swap16(float v, float& a, float& b) { const unsigned u = __builtin_bit_cast(unsigned, v); auto r = __builtin_amdgcn_permlane16_swap(u, u, false, false); const unsigned x = r[0], y = r[1]; a = __builtin_bit_cast(float, x); b = __builtin_bit_cast(float, y); }
__device__ __forceinline__ void swap32(float v, float& a, float& b) { const unsigned u = __builtin_bit_cast(unsigned, v); auto r = __builtin_amdgcn_permlane32_swap(u, u, false, false); const unsigned x = r[0], y = r[1]; a = __builtin_bit_cast(float, x); b = __builtin_bit_cast(float, y); }
__device__ __forceinline__ float sum_x16(float v) { float a, b; swap16(v, a, b); return a + b; }
__device__ __forceinline__ float sum_x32(float v) { float a, b; swap32(v, a, b); return a + b; }
__device__ __forceinline__ float max_x16(float v) { float a, b; swap16(v, a, b); return fmaxf(a, b); }
__device__ __forceinline__ float max_x32(float v) { float a, b; swap32(v, a, b); return fmaxf(a, b); }
__device__ __forceinline__ float from_x32(float v, int lane_hi) { float a, b; swap32(v, a, b); return lane_hi ? a : b; }
template <int CTRL> __device__ __forceinline__ float dpp_f(float v) { const int u = __builtin_bit_cast(int, v); return __builtin_bit_cast(float, __builtin_amdgcn_update_dpp(u, u, CTRL, 0xf, 0xf, false)); }
__device__ __forceinline__ float row_sum16(float v) { v += dpp_f<0xB1>(v); v += dpp_f<0x4E>(v); v += dpp_f<0x124>(v); v += dpp_f<0x128>(v); return v; }
__device__ __forceinline__ float row_max16(float v) { v = fmaxf(v, dpp_f<0xB1>(v)); v = fmaxf(v, dpp_f<0x4E>(v)); v = fmaxf(v, dpp_f<0x124>(v)); v = fmaxf(v, dpp_f<0x128>(v)); return v; }

namespace pg8 {
constexpr int BM = 256, BK = 64, HALF = 128, HTB = HALF * BK * 2, STAGE_BYTES = 8 * HTB, NXCD = 8, WGM = 8;
__host__ __device__ __forceinline__ int lds_byte(int r, int c) { const int st = (r >> 4) * 2 + (c >> 5), rr = r & 15, cc = c & 31, ob = rr * 64 + cc * 2; return st * 1024 + (ob ^ (((ob >> 9) & 1) << 5)); }
__host__ __device__ __forceinline__ void stage_rc(int b, int& R, int& C) { const int st = b / 1024, sb = b % 1024, swz = sb ^ (((sb >> 9) & 1) << 5); R = (st >> 1) * 16 + swz / 64; C = (st & 1) * 32 + (swz % 64) / 2; }
__host__ __device__ __forceinline__ int perm32(int rho) { const int n = rho >> 4, i = rho & 15; return 8 * (i >> 2) + 4 * n + (i & 3); }

struct Unit { int pm, pn; };
struct Gemm { const bf16_t* A; const bf16_t* Bt; int K; int lda; int flags = 0; };

struct StaticOrder {
    static constexpr bool GATHER = false;
    int nM, nN, nwg, G, c;
    __device__ void init(int M, int N, int G_, int c_) { nM = M / BM; nN = N / BM; nwg = nM * nN; G = G_; c = c_; }
    __device__ bool next(int i, Unit& u) const {
        const long L = (long)i * G + c; if (L >= nwg) return false;
        int wgid = (int)L; { const int q = nwg / NXCD, r = nwg % NXCD, xcd = wgid % NXCD, off = wgid / NXCD; wgid = (xcd < r ? xcd * (q + 1) : r * (q + 1) + (xcd - r) * q) + off; }
        const int nig = WGM * nN, gid = wgid / nig, fm = gid * WGM, gsz = (nM - fm) < WGM ? (nM - fm) : WGM;
        u.pm = fm + ((wgid % nig) % gsz); u.pn = (wgid % nig) / gsz; return true;
    }
};

template <class Epi, class Sched>
__device__ __forceinline__ void gemm_phase(LAS unsigned char* lds, LAS int* idxlds, const Gemm g, const Sched& S, const Epi& E) {
    int tid_ = threadIdx.x; asm volatile("" : "+v"(tid_));
    const int tid = tid_, wid = __builtin_amdgcn_readfirstlane(tid >> 6), lane = tid & 63, wr = wid >> 2, wc = wid & 3, fr = lane & 15, fq = lane >> 4;
    const int K = g.K, nt = K / BK, lda = g.lda;
    unsigned voffB[2], vA[2][2], vAn[2][2];
#pragma unroll
    for (int i = 0; i < 2; ++i) { int R, C; stage_rc(tid * 16 + i * 8192, R, C);
        const int Rb = Epi::PERM ? (64 * (R >> 5) + perm32(R & 31)) : R; voffB[i] = (unsigned)(Rb * K + C) * 2u;
        vA[0][i] = (unsigned)(R * lda + C) * 2u; vA[1][i] = vA[0][i]; vAn[0][i] = vA[0][i]; vAn[1][i] = vA[0][i]; }
    const unsigned kstep = (unsigned)(BK * 2);
    const unsigned hstepB = (unsigned)(Epi::PERM ? 32 : HALF) * K * 2, tstepB = (unsigned)(2 * HALF) * K * 2;
    const unsigned hstepA = Sched::GATHER ? 0u : (unsigned)HALF * lda * 2, tstepA = Sched::GATHER ? 0u : (unsigned)BM * lda * 2;
    const unsigned ldsw = (unsigned)wid * 1024u;
    const int aoff = lds_byte(wr * 64 + fr, fq * 8), boff = lds_byte(wc * 32 + fr, fq * 8);
#define PG8_SA(b, h) (((b) * 2 + (h)) * HTB)
#define PG8_SB(b, h) ((4 + (b) * 2 + (h)) * HTB)
#define PG8_STAGE(bufoff, gbase, voff) do { const char* gb_ = (const char*)(gbase); asm volatile("" : "+s"(gb_));   \
        _Pragma("unroll") for (int _i = 0; _i < 2; ++_i) \
        __builtin_amdgcn_global_load_lds((const unsigned*)(gb_ + (voff)[_i]), (LAS unsigned*)(lds + (bufoff) + ldsw + _i * 8192), 16, 0, 0); } while (0)
#define PG8_STAGE_A(bufoff, gbase, h, NXT) do { if constexpr (Sched::GATHER) { if (NXT) PG8_STAGE(bufoff, gbase, vAn[h]); else PG8_STAGE(bufoff, gbase, vA[h]); } \
        else PG8_STAGE(bufoff, (gbase) + (h) * hstepA, vA[0]); } while (0)
#define PG8_LDA(dst, b, h) do { _Pragma("unroll") for (int m = 0; m < 4; ++m) _Pragma("unroll") for (int k = 0; k < 2; ++k) dst[m][k] = *(const LAS bf16x8*)(lds + PG8_SA(b, h) + aoff + m * 2048 + k * 1024); } while (0)
#define PG8_LDB(dst, b, h) do { _Pragma("unroll") for (int n = 0; n < 2; ++n) _Pragma("unroll") for (int k = 0; k < 2; ++k) dst[n][k] = *(const LAS bf16x8*)(lds + PG8_SB(b, h) + boff + n * 2048 + k * 1024); } while (0)
#define PG8_MMA(ai, bj, At, Bt) do { __builtin_amdgcn_s_setprio(1); _Pragma("unroll") for (int m = 0; m < 4; ++m) _Pragma("unroll") for (int n = 0; n < 2; ++n) _Pragma("unroll") for (int k = 0; k < 2; ++k) \
        acc[ai][bj][m][n] = __builtin_amdgcn_mfma_f32_16x16x32_bf16(Bt[n][k], At[m][k], acc[ai][bj][m][n], 0, 0, 0); __builtin_amdgcn_s_setprio(0); } while (0)
#define PG8_WAIT_V(n) asm volatile("s_waitcnt vmcnt(" #n ")" ::: "memory")
#define PG8_WAIT_L(n) asm volatile("s_waitcnt lgkmcnt(" #n ")" ::: "memory")
#define PG8_BAR __builtin_amdgcn_s_barrier()
#define PG8_SCHED __builtin_amdgcn_sched_barrier(0)
#define PG8_GOFF(dst, ui_) do { _Pragma("unroll") for (int _i = 0; _i < 2; ++_i) { int _R, _C; stage_rc(tid * 16 + _i * 8192, _R, _C); _Pragma("unroll") for (int _h = 0; _h < 2; ++_h) \
        dst[_h][_i] = (unsigned)(idxlds[(ui_) * 256 + _h * 128 + _R] * lda + _C) * 2u; } } while (0)
    Unit cur, nxt; int ui = 0;
    if (!S.next(0, cur)) return;
    if constexpr (Sched::GATHER) {
        for (int i = 0; i < 4; ++i) { Unit u; if (!S.next(i, u)) break; if (tid < 256) { const int t = S.gidx[u.pm * 256 + tid]; idxlds[i * 256 + tid] = t < 0 ? 0 : t; } }
        asm volatile("s_waitcnt vmcnt(0) lgkmcnt(0)" ::: "memory"); __builtin_amdgcn_s_barrier(); asm volatile("" ::: "memory");
        PG8_GOFF(vA, 0);
    }
    f32x4 acc[2][2][4][2];
#pragma unroll
    for (int a = 0; a < 2; ++a)
#pragma unroll
        for (int b = 0; b < 2; ++b)
#pragma unroll
            for (int m = 0; m < 4; ++m)
#pragma unroll
                for (int n = 0; n < 2; ++n) acc[a][b][m][n] = (f32x4){0.f, 0.f, 0.f, 0.f};
    bf16x8 At[4][2], B0[2][2], B1[2][2];
    const char* cA = (const char*)g.A + (size_t)cur.pm * (size_t)tstepA; const char* cB = (const char*)g.Bt + (size_t)cur.pn * (size_t)tstepB;
    PG8_STAGE(PG8_SB(0, 0), cB, voffB); PG8_STAGE(PG8_SB(0, 1), cB + hstepB, voffB); PG8_STAGE_A(PG8_SA(0, 0), cA, 0, false); PG8_STAGE_A(PG8_SA(0, 1), cA, 1, false);
    if (wr == 1) PG8_BAR;
    PG8_WAIT_V(2); PG8_BAR;
    PG8_STAGE(PG8_SB(1, 0), cB + kstep, voffB); PG8_STAGE_A(PG8_SA(1, 0), cA + kstep, 0, false); PG8_STAGE(PG8_SB(1, 1), cB + hstepB + kstep, voffB);
    PG8_WAIT_V(6); PG8_BAR;
    for (;;) {
        const bool has_next = S.next(ui + 1, nxt);
        const char* nA = has_next ? (const char*)g.A + (size_t)nxt.pm * (size_t)tstepA : cA; const char* nB = has_next ? (const char*)g.Bt + (size_t)nxt.pn * (size_t)tstepB : cB;
        for (int t = 0; t < nt; t += 2) {
            const bool last = (t == nt - 2);
            const char* a1 = cA + (size_t)(t + 1) * kstep;
            const char* a2 = last ? nA : cA + (size_t)(t + 2) * kstep; const char* b2 = last ? nB : cB + (size_t)(t + 2) * kstep;
            const char* a3 = a2 + kstep; const char* b3 = b2 + kstep;
            if constexpr (Sched::GATHER) { if (last) { if (has_next) PG8_GOFF(vAn, ui + 1); else {
#pragma unroll
                for (int h = 0; h < 2; ++h) { vAn[h][0] = vA[h][0]; vAn[h][1] = vA[h][1]; } } } }
            PG8_LDB(B0, 0, 0); PG8_LDB(B1, 0, 1); PG8_SCHED; PG8_LDA(At, 0, 0); PG8_STAGE_A(PG8_SA(1, 1), a1, 1, false);
            PG8_WAIT_V(8); PG8_WAIT_L(0); PG8_BAR; PG8_MMA(0, 0, At, B0); PG8_MMA(0, 1, At, B1); PG8_BAR; PG8_SCHED;
            PG8_LDA(At, 0, 1); PG8_STAGE(PG8_SB(0, 0), b2, voffB); PG8_STAGE(PG8_SB(0, 1), b2 + hstepB, voffB); PG8_STAGE_A(PG8_SA(0, 0), a2, 0, last);
            PG8_WAIT_V(8); PG8_WAIT_L(0); PG8_BAR; PG8_MMA(1, 0, At, B0); PG8_MMA(1, 1, At, B1); PG8_BAR; PG8_SCHED;
            PG8_LDB(B0, 1, 0); PG8_LDB(B1, 1, 1); PG8_SCHED; PG8_LDA(At, 1, 0); PG8_STAGE_A(PG8_SA(0, 1), a2, 1, last);
            PG8_WAIT_V(8); PG8_WAIT_L(0); PG8_BAR; PG8_MMA(0, 0, At, B0); PG8_MMA(0, 1, At, B1); PG8_BAR; PG8_SCHED;
            PG8_LDA(At, 1, 1); PG8_STAGE(PG8_SB(1, 0), b3, voffB); PG8_STAGE(PG8_SB(1, 1), b3 + hstepB, voffB); PG8_STAGE_A(PG8_SA(1, 0), a3, 0, last);
            PG8_WAIT_V(8); PG8_WAIT_L(0); PG8_BAR; PG8_MMA(1, 0, At, B0); PG8_MMA(1, 1, At, B1); PG8_BAR; PG8_SCHED;
        }
        if (wr == 0) PG8_BAR;
        if (!(g.flags & 1)) { int te = threadIdx.x; asm volatile("" : "+v"(te)); const int le = te & 63; E(acc, cur, wr, wc, le & 15, le >> 4); }
        if (!has_next) break;
#pragma unroll
        for (int a = 0; a < 2; ++a)
#pragma unroll
            for (int b = 0; b < 2; ++b)
#pragma unroll
                for (int m = 0; m < 4; ++m)
#pragma unroll
                    for (int n = 0; n < 2; ++n) acc[a][b][m][n] = (f32x4){0.f, 0.f, 0.f, 0.f};
        cur = nxt; cA = nA; cB = nB; ++ui;
        if constexpr (Sched::GATHER) {
#pragma unroll
            for (int h = 0; h < 2; ++h) { vA[h][0] = vAn[h][0]; vA[h][1] = vAn[h][1]; } }
        if (wr == 1) PG8_BAR;
    }
    PG8_WAIT_V(0);
    PG8_BAR;
#undef PG8_SA
#undef PG8_SB
#undef PG8_STAGE
#undef PG8_STAGE_A
#undef PG8_LDA
#undef PG8_LDB
#undef PG8_MMA
#undef PG8_WAIT_V
#undef PG8_WAIT_L
#undef PG8_BAR
#undef PG8_SCHED
#undef PG8_GOFF
}
}

#define XB_TMO      128
#define XB_XCNT(j)  (256  + 64 * (j))
#define XB_XSUB(j)  (1280 + 64 * (j))
#define XB_XGEN(j)  (2304 + 64 * (j))
#define XB_TOP      3328
#define XB_TOPGEN   3392
#define XCD_BAR_WORDS 3456
#define XB_SPIN_CAP (1u << 18)
__device__ __forceinline__ unsigned xb_ld(unsigned* p)              { return __hip_atomic_load(p, __ATOMIC_RELAXED, __HIP_MEMORY_SCOPE_AGENT); }
__device__ __forceinline__ unsigned xb_add(unsigned* p, unsigned v) { return __hip_atomic_fetch_add(p, v, __ATOMIC_RELAXED, __HIP_MEMORY_SCOPE_AGENT); }
__device__ __forceinline__ unsigned xb_xcc_id() { return (unsigned)__builtin_amdgcn_s_getreg((3 << 11) | 20) & 0xFu; }
#define XB_SPIN(cond, bar) do { unsigned _sp = 0; while (cond) { __builtin_amdgcn_s_sleep(1); \
    if ((++_sp & 255u) == 0u) { if (xb_ld(&(bar)[XB_TMO])) break; if (_sp > XB_SPIN_CAP) { atomicAdd(&(bar)[XB_TMO], 1u); break; } } } } while (0)
struct XcdBarrier { unsigned* bar; unsigned x; volatile LAS unsigned* st; };
__device__ __forceinline__ XcdBarrier xcd_barrier_post(unsigned* bar, volatile LAS unsigned* st) {
    XcdBarrier b; b.bar = bar; b.x = xb_xcc_id(); b.st = st;
    if (threadIdx.x == 0) (void)xb_add(&bar[XB_XCNT(b.x)], 1u);
    return b;
}
__device__ __forceinline__ void xcd_barrier_complete(unsigned* bar, unsigned x, unsigned& nloc, unsigned& nx) {
    const unsigned G = gridDim.x * gridDim.y * gridDim.z;
    unsigned sum, cnt, mine, sp = 0u;
    for (;;) {
        sum = 0u; cnt = 0u; mine = 0u;
#pragma unroll
        for (unsigned j = 0; j < 16; ++j) { const unsigned c = xb_ld(&bar[XB_XCNT(j)]); sum += c; cnt += (c > 0u) ? 1u : 0u; mine = (j == x) ? c : mine; }
        if (sum == G) break;
        __builtin_amdgcn_s_sleep(1);
        if ((++sp & 255u) == 0u) { if (xb_ld(&bar[XB_TMO])) break; if (sp > XB_SPIN_CAP) { atomicAdd(&bar[XB_TMO], 1u); break; } }
    }
    nloc = mine > 0u ? mine : 1u; nx = cnt > 0u ? cnt : 1u;
}
__device__ __forceinline__ void xcd_barrier(const XcdBarrier& b) {
    asm volatile("s_waitcnt vmcnt(0)" ::: "memory");
    __syncthreads();
    if (threadIdx.x == 0) {
        unsigned* bar = b.bar; unsigned bx = b.x;
        asm volatile("" : "+s"(bar), "+s"(bx));
        __builtin_amdgcn_s_waitcnt(0);
        unsigned nloc = b.st[0], nx = b.st[1];
        if (nloc == 0u) { xcd_barrier_complete(bar, bx, nloc, nx); b.st[0] = nloc; b.st[1] = nx; }
        const unsigned old = xb_add(&bar[XB_XSUB(bx)], 1u);
        const unsigned gen = old / nloc;
        if (old + 1u == (gen + 1u) * nloc) {
            __builtin_amdgcn_fence(__ATOMIC_RELEASE, "agent");
            asm volatile("s_waitcnt vmcnt(0)" ::: "memory");
            const unsigned og = xb_add(&bar[XB_TOP], 1u);
            const unsigned tg = og / nx;
            if (og + 1u == (tg + 1u) * nx) xb_add(&bar[XB_TOPGEN], 1u);
            else XB_SPIN(xb_ld(&bar[XB_TOPGEN]) == tg, bar);
            __builtin_amdgcn_fence(__ATOMIC_ACQUIRE, "agent");
            xb_add(&bar[XB_XGEN(bx)], 1u);
            asm volatile("s_waitcnt vmcnt(0)" ::: "memory");
        } else {
            XB_SPIN(xb_ld(&bar[XB_XGEN(bx)]) == gen, bar);
            __builtin_amdgcn_fence(__ATOMIC_ACQUIRE, "agent");
            asm volatile("s_waitcnt vmcnt(0)" ::: "memory");
        }
    }
    __syncthreads();
}
constexpr size_t MiB = 1u << 20;
constexpr size_t WS_CTL = 0, CTL_ZERO_BYTES = 64 * 1024;
constexpr size_t WS_SSX  = 1 * MiB;
constexpr size_t WS_KVSS = 3 * MiB;
constexpr size_t WS_QSS  = WS_KVSS + 512 * 1024;
constexpr size_t WS_KRSS = WS_QSS + 1 * MiB;
constexpr size_t WS_TE   = WS_KRSS + 128 * 1024;
constexpr size_t WS_TW   = WS_TE + 256 * 1024;
constexpr size_t WS_TRS  = WS_TW + 256 * 1024;
constexpr size_t WS_CNT  = WS_TRS + 128 * 1024;
constexpr size_t WS_ATOK = WS_CNT + 64 * 1024;
constexpr size_t WS_AW   = WS_ATOK + 320 * 1024;
constexpr size_t WS_ARS  = WS_AW + 320 * 1024;
constexpr size_t WS_TSEG = WS_ARS + 320 * 1024;
constexpr size_t WS_LAM  = WS_TSEG + 4096;
constexpr size_t WS_ROPE = 8 * MiB;
constexpr size_t WS_ROPEB = 12 * MiB;
constexpr size_t WS_WMIX = 16 * MiB, WMIX_LAYER = 13 * MiB;
constexpr size_t WM_IN = 0, WM_UQ = WM_IN + (size_t)NIN * 1024 * 2, WM_UKV = WM_UQ + 768 * 384 * 2, WM_PROJ = WM_UKV + 1024 * 256 * 2, WM_GLU = WM_PROJ + 1024 * 512 * 2,
                 WM_OUT = WM_GLU + 2048 * 512 * 2, WM_R = WM_OUT + 1024 * 1024 * 2, WM_END = WM_R + 48 * 1024 * 2;
static_assert(WM_END <= WMIX_LAYER, "mixer weights");
constexpr size_t WS_TMAT = 42 * MiB;
constexpr size_t WS_WST  = 62 * MiB;
constexpr size_t WS_XB   = 70 * MiB;
constexpr size_t WS_IN   = 134 * MiB;
constexpr size_t WS_OB   = 174 * MiB;
constexpr size_t WS_YB   = 206 * MiB;
constexpr size_t WS_SST  = 222 * MiB;
constexpr size_t WS_KVC  = 174 * MiB, WS_QC = 190 * MiB, WS_KR = 214 * MiB;
constexpr size_t WS_HH   = 174 * MiB;
constexpr size_t WS_TQ   = 238 * MiB, WS_KB = 286 * MiB, WS_VB = 334 * MiB;
constexpr size_t WS_S5G  = 238 * MiB, WS_MG = 302 * MiB;
constexpr size_t WS_GT   = 366 * MiB;
constexpr size_t WS_WGU  = 366 * MiB, WS_WD = 398 * MiB;
constexpr size_t WS_END  = 494 * MiB;

constexpr int RING_BYTES = 131072, IDX_OFF = RING_BYTES, MISC_OFF = IDX_OFF + 4096, LDS_BYTES = 147456;
static_assert(MISC_OFF + 256 <= LDS_BYTES, "LDS map");

struct Params {
    const float* in[27];
    float* out; unsigned char* ws;
    int ph_lo, ph_hi, variant, pad_;
};
__device__ __forceinline__ Params load_params() {
    typedef const __attribute__((address_space(4))) Params* KP;
    KP ka = (KP)__builtin_amdgcn_kernarg_segment_ptr();
    asm volatile("" : "+s"(ka));
    Params p;
#pragma unroll
    for (int i = 0; i < 27; ++i) p.in[i] = ka->in[i];
    p.out = ka->out; p.ws = ka->ws; p.ph_lo = ka->ph_lo; p.ph_hi = ka->ph_hi; p.variant = ka->variant; p.pad_ = 0;
    return p;
}

__device__ __forceinline__ float row_rstd16(const GAS float* ss, int row, int fq, float inv_n) {
    const f32x4 v = *(const GAS f32x4*)(ss + (size_t)row * 16 + 4 * fq);
    float s = (v[0] + v[1]) + (v[2] + v[3]);
    s = sum_x16(s); s = sum_x32(s);
    return __builtin_amdgcn_rsqf(s * inv_n + EPS);
}
__device__ __forceinline__ float sumsq16(const f32x4& a, const f32x4& b, const f32x4& c, const f32x4& d) {
    return ((a[0]*a[0] + a[1]*a[1]) + (a[2]*a[2] + a[3]*a[3])) + ((b[0]*b[0] + b[1]*b[1]) + (b[2]*b[2] + b[3]*b[3])) + ((c[0]*c[0] + c[1]*c[1]) + (c[2]*c[2] + c[3]*c[3])) + ((d[0]*d[0] + d[1]*d[1]) + (d[2]*d[2] + d[3]*d[3]));
}
__device__ __forceinline__ u32x4 pack8(const f32x4& a, const f32x4& b) { u32x4 w; w.x = cvt_pk_bf16(a[0], a[1]); w.y = cvt_pk_bf16(a[2], a[3]); w.z = cvt_pk_bf16(b[0], b[1]); w.w = cvt_pk_bf16(b[2], b[3]); return w; }

__device__ __forceinline__ unsigned pack4_u8(const f32x4& v) {
    const unsigned a = (unsigned)(v[0] * 255.0f + 0.5f), b = (unsigned)(v[1] * 255.0f + 0.5f), c = (unsigned)(v[2] * 255.0f + 0.5f), d = (unsigned)(v[3] * 255.0f + 0.5f);
    return a | (b << 8) | (c << 16) | (d << 24);
}
__device__ __forceinline__ f32x4 unpack4_u8(unsigned w) { return (f32x4){(float)(w & 0xffu), (float)((w >> 8) & 0xffu), (float)((w >> 16) & 0xffu), (float)(w >> 24)} * (1.0f / 255.0f); }

using pg8::Unit;
typedef f32x4 Acc[2][2][4][2];

#define ROWS8(ai, m) _Pragma("unroll") for (int ai = 0; ai < 2; ++ai) _Pragma("unroll") for (int m = 0; m < 4; ++m)
#define EPI_ROW(u, ai, m) ((u).pm * 256 + (ai) * 128 + wr * 64 + (m) * 16 + fr)

struct EpiIn {
    static constexpr bool PERM = true;
    unsigned char* ws;
    __device__ __forceinline__ void operator()(const Acc& acc, const Unit& u, int wr, int wc, int fr, int fq) const {
        GAS unsigned char* w = (GAS unsigned char*)ws; asm volatile("" : "+s"(w));
        const GAS float* ssx = (const GAS float*)(w + WS_SSX); GAS unsigned char* gt = (GAS unsigned char*)(w + WS_GT); GAS bf16_t* inb = (GAS bf16_t*)(w + WS_IN); GAS bf16_t* kvc = (GAS bf16_t*)(w + WS_KVC); GAS bf16_t* qc = (GAS bf16_t*)(w + WS_QC);
        GAS bf16_t* kr = (GAS bf16_t*)(w + WS_KR); GAS float* kvss = (GAS float*)(w + WS_KVSS); GAS float* qss = (GAS float*)(w + WS_QSS); GAS float* krss = (GAS float*)(w + WS_KRSS);
        const int pn = u.pn;
        f32x4 sv[2][4];
        ROWS8(ai, m) sv[ai][m] = *(const GAS f32x4*)(ssx + (size_t)EPI_ROW(u, ai, m) * 16 + 4 * fq);
        ROWS8(ai, m) {
                const int row = EPI_ROW(u, ai, m);
                float st = (sv[ai][m][0] + sv[ai][m][1]) + (sv[ai][m][2] + sv[ai][m][3]); st = sum_x16(st); st = sum_x32(st);
                const float rs = __builtin_amdgcn_rsqf(st * (1.0f / 1024.0f) + EPS);
                f32x4 v00 = acc[ai][0][m][0] * rs, v01 = acc[ai][0][m][1] * rs, v10 = acc[ai][1][m][0] * rs, v11 = acc[ai][1][m][1] * rs;
                if (pn < 8) {
#pragma unroll
                    for (int j = 0; j < 4; ++j) { v00[j] = fast_sigmoid(v00[j]); v01[j] = fast_sigmoid(v01[j]); v10[j] = fast_sigmoid(v10[j]); v11[j] = fast_sigmoid(v11[j]); }
                    GAS unsigned char* p = gt + (size_t)row * 2048 + pn * 256 + wc * 64 + 8 * fq;
                    *(GAS u32x2*)p = (u32x2){pack4_u8(v00), pack4_u8(v01)}; *(GAS u32x2*)(p + 32) = (u32x2){pack4_u8(v10), pack4_u8(v11)};
                } else if (pn < 10) {
                    const int b = row >> 11, ts = row & 2047, c = ts >> 5, s = ts & 31;
#pragma unroll
                    for (int bj = 0; bj < 2; ++bj) { const int cu = (pn - 8) * 256 + wc * 64 + bj * 32 + 8 * fq, g = cu >> 4, j0 = cu & 15;
                        GAS bf16_t* p = inb + ((size_t)(g * 1024 + b * 64 + c) * KIN + s * 16 + j0);
                        *(GAS u32x4*)p = bj ? pack8(v10, v11) : pack8(v00, v01); }
                } else if (pn == 10) {
                    GAS bf16_t* p = kvc + (size_t)row * 256 + wc * 64 + 8 * fq;
                    *(GAS u32x4*)p = pack8(v00, v01); *(GAS u32x4*)(p + 32) = pack8(v10, v11);
                    float s = sumsq16(v00, v01, v10, v11); s = sum_x16(s); s = sum_x32(s);
                    if (fq == 0) kvss[(size_t)row * 4 + wc] = s;
                } else if (pn == 11) {
                    GAS bf16_t* p = qc + (size_t)row * 384 + wc * 64 + 8 * fq;
                    *(GAS u32x4*)p = pack8(v00, v01); *(GAS u32x4*)(p + 32) = pack8(v10, v11);
                    float s = sumsq16(v00, v01, v10, v11); s = sum_x16(s); s = sum_x32(s);
                    if (fq == 0) qss[(size_t)row * 8 + wc] = s;
                } else {
                    const f32x4 z = (f32x4){0.f, 0.f, 0.f, 0.f};
                    if (wc < 2) {
                        GAS bf16_t* p = qc + (size_t)row * 384 + 256 + wc * 64 + 8 * fq;
                        *(GAS u32x4*)p = pack8(v00, v01); *(GAS u32x4*)(p + 32) = pack8(v10, v11);
                        float s = sumsq16(v00, v01, v10, v11); s = sum_x16(s); s = sum_x32(s);
                        if (fq == 0) qss[(size_t)row * 8 + 4 + wc] = s;
                    } else {
                        if (fq == 0) qss[(size_t)row * 8 + 4 + wc] = 0.f;
                        if (wc == 2) { float s2 = sumsq16(v00, v01, z, z); s2 = sum_x16(s2); s2 = sum_x32(s2);
                            *(GAS u32x4*)(kr + (size_t)row * 32 + 8 * fq) = pack8(v00, v01); if (fq == 0) krss[row] = s2; }
                    }
                }
                asm volatile("" ::: "memory");
            }
    }
};

struct EpiPlain {
    static constexpr bool PERM = true;
    unsigned char* ws; size_t off; int ldc;
    __device__ __forceinline__ void operator()(const Acc& acc, const Unit& u, int wr, int wc, int fr, int fq) const {
        GAS unsigned char* w = (GAS unsigned char*)ws; asm volatile("" : "+s"(w)); GAS bf16_t* o = (GAS bf16_t*)(w + off);
        ROWS8(ai, m) {
                const int row = EPI_ROW(u, ai, m);
                GAS bf16_t* p = o + (size_t)row * ldc + u.pn * 256 + wc * 64 + 8 * fq;
                *(GAS u32x4*)p = pack8(acc[ai][0][m][0], acc[ai][0][m][1]); *(GAS u32x4*)(p + 32) = pack8(acc[ai][1][m][0], acc[ai][1][m][1]);
                asm volatile("" ::: "memory");
            }
    }
};

struct EpiKV {
    static constexpr bool PERM = true;
    unsigned char* ws; LAS const float* gkl;
    __device__ __forceinline__ void operator()(const Acc& acc, const Unit& u, int wr, int wc, int fr, int fq) const {
        GAS unsigned char* w = (GAS unsigned char*)ws; asm volatile("" : "+s"(w));
        const GAS float* kvss = (const GAS float*)(w + WS_KVSS); const GAS float* krss = (const GAS float*)(w + WS_KRSS); const GAS bf16_t* kr = (const GAS bf16_t*)(w + WS_KR); const GAS bf16_t* ropeb = (const GAS bf16_t*)(w + WS_ROPEB);
        GAS bf16_t* kb = (GAS bf16_t*)(w + WS_KB); GAS bf16_t* vb = (GAS bf16_t*)(w + WS_VB);
        const int pn = u.pn;
        if (pn < 2) {
            const int h = pn * 4 + wc, i0 = 8 * (fq & 1);
#pragma unroll
            for (int ai = 0; ai < 2; ++ai) {
                float kq[4], krs[4]; u32x4 kA[4], kB[4], cw4[4], sw4[4];
#pragma unroll
                for (int m = 0; m < 4; ++m) { const int row = EPI_ROW(u, ai, m); kq[m] = kvss[(size_t)row * 4 + fq]; krs[m] = krss[row];
                    const GAS bf16_t* kp0 = kr + (size_t)row * 32 + i0; kA[m] = *(const GAS u32x4*)kp0; kB[m] = *(const GAS u32x4*)(kp0 + 16);
                    const GAS bf16_t* rp = ropeb + (size_t)row * 32 + i0; cw4[m] = *(const GAS u32x4*)rp; sw4[m] = *(const GAS u32x4*)(rp + 16); }
#pragma unroll
                for (int m = 0; m < 4; ++m) {
                    const int row = EPI_ROW(u, ai, m);
                    float ks = kq[m]; ks = sum_x16(ks); ks = sum_x32(ks);
                    const float rkv = __builtin_amdgcn_rsqf(ks * (1.0f / 256.0f) + EPS);
                    f32x4 v00 = acc[ai][0][m][0] * rkv, v01 = acc[ai][0][m][1] * rkv, v10 = acc[ai][1][m][0] * rkv, v11 = acc[ai][1][m][1] * rkv;
                    float s = sumsq16(v00, v01, v10, v11); s = sum_x16(s); s = sum_x32(s);
                    const float rk = __builtin_amdgcn_rsqf((s + krs[m]) * (1.0f / 96.0f) + EPS);
                    const int b = row >> 11, sq = row & 2047;
                    GAS bf16_t* kp = kb + ((size_t)((b * NH + h) * SEQ + sq)) * 96;
                    { const f32x4 g0a = *(LAS const f32x4*)(gkl + 8 * fq), g0b = *(LAS const f32x4*)(gkl + 8 * fq + 4);
                      *(GAS u32x4*)(kp + 8 * fq) = pack8(v00 * g0a * rk, v01 * g0b * rk); }
                    { const f32x4 g1a = *(LAS const f32x4*)(gkl + 32 + 8 * fq), g1b = *(LAS const f32x4*)(gkl + 32 + 8 * fq + 4);
                      *(GAS u32x4*)(kp + 32 + 8 * fq) = pack8(v10 * g1a * rk, v11 * g1b * rk); }
                    asm volatile("" ::: "memory");
                    const f32x4 gAa = *(LAS const f32x4*)(gkl + 64 + i0), gAb = *(LAS const f32x4*)(gkl + 64 + i0 + 4), gBa = *(LAS const f32x4*)(gkl + 80 + i0), gBb = *(LAS const f32x4*)(gkl + 80 + i0 + 4);
                    const u32x4 a4 = kA[m], b4 = kB[m], cq = cw4[m], sq4 = sw4[m];
                    const f32x4 xAa = (f32x4){bflo(a4.x), bfhi(a4.x), bflo(a4.y), bfhi(a4.y)} * gAa * rk, xAb = (f32x4){bflo(a4.z), bfhi(a4.z), bflo(a4.w), bfhi(a4.w)} * gAb * rk;
                    const f32x4 xBa = (f32x4){bflo(b4.x), bfhi(b4.x), bflo(b4.y), bfhi(b4.y)} * gBa * rk, xBb = (f32x4){bflo(b4.z), bfhi(b4.z), bflo(b4.w), bfhi(b4.w)} * gBb * rk;
                    const f32x4 ca = (f32x4){bflo(cq.x), bfhi(cq.x), bflo(cq.y), bfhi(cq.y)}, cb = (f32x4){bflo(cq.z), bfhi(cq.z), bflo(cq.w), bfhi(cq.w)};
                    const f32x4 sa = (f32x4){bflo(sq4.x), bfhi(sq4.x), bflo(sq4.y), bfhi(sq4.y)}, sb = (f32x4){bflo(sq4.z), bfhi(sq4.z), bflo(sq4.w), bfhi(sq4.w)};
                    f32x4 oa, ob;
                    if (fq < 2) { oa = xAa * ca - xBa * sa; ob = xAb * cb - xBb * sb; } else { oa = xBa * ca + xAa * sa; ob = xBb * cb + xAb * sb; }
                    *(GAS u32x4*)(kp + 64 + 8 * fq) = pack8(oa, ob);
                    asm volatile("" ::: "memory");
                }
            }
        } else {
            const int h = (pn - 2) * 4 + wc;
            float kq[2][4];
            ROWS8(ai, m) kq[ai][m] = kvss[(size_t)EPI_ROW(u, ai, m) * 4 + fq];
            ROWS8(ai, m) {
                    const int row = EPI_ROW(u, ai, m);
                    float ks = kq[ai][m]; ks = sum_x16(ks); ks = sum_x32(ks);
                    const float rkv = __builtin_amdgcn_rsqf(ks * (1.0f / 256.0f) + EPS);
                    const int b = row >> 11, sq = row & 2047;
                    GAS bf16_t* vp = vb + ((size_t)((b * NH + h) * SEQ + sq)) * 64;
                    *(GAS u32x4*)(vp + 8 * fq) = pack8(acc[ai][0][m][0] * rkv, acc[ai][0][m][1] * rkv);
                    *(GAS u32x4*)(vp + 32 + 8 * fq) = pack8(acc[ai][1][m][0] * rkv, acc[ai][1][m][1] * rkv);
                    asm volatile("" ::: "memory");
                }
        }
    }
};

struct EpiS {
    static constexpr bool PERM = false;
    unsigned char* ws;
    __device__ __forceinline__ void operator()(const Acc& acc, const Unit& u, int wr, int wc, int fr, int fq) const {
        GAS unsigned char* w = (GAS unsigned char*)ws; asm volatile("" : "+s"(w)); GAS float* sst = (GAS float*)(w + WS_SST);
        ROWS8(ai, m) {
                const int row = EPI_ROW(u, ai, m);
                GAS float* p = sst + (size_t)row * 128 + wc * 32 + 4 * fq;
                *(GAS f32x4*)p = acc[ai][0][m][0]; *(GAS f32x4*)(p + 16) = acc[ai][0][m][1];
            }
    }
};

__device__ __forceinline__ float gelu_tanh(float x) {
    const float z = 0.7978845608028654f * (x + 0.044715f * x * x * x);
    return x * __builtin_amdgcn_rcpf(1.0f + __builtin_amdgcn_exp2f(-2.8853900817779268f * z));
}
struct EpiY {
    static constexpr bool PERM = true;
    unsigned char* ws;
    __device__ __forceinline__ void operator()(const Acc& acc, const Unit& u, int wr, int wc, int fr, int fq) const {
        GAS unsigned char* w = (GAS unsigned char*)ws; asm volatile("" : "+s"(w)); GAS bf16_t* yb = (GAS bf16_t*)(w + WS_YB);
        const int g = u.pm >> 2, pnl = u.pn & 1;
        ROWS8(ai, m) {
                const int rg = (u.pm & 3) * 256 + ai * 128 + wr * 64 + m * 16 + fr, b = rg >> 6, c = rg & 63;
#pragma unroll
                for (int bj = 0; bj < 2; ++bj) {
                    const int nl = pnl * 256 + wc * 64 + bj * 32 + 8 * fq, t = nl >> 4, i0 = nl & 15;
                    f32x4 a = acc[ai][bj][m][0], bq = acc[ai][bj][m][1];
#pragma unroll
                    for (int j = 0; j < 4; ++j) { a[j] = gelu_tanh(a[j]); bq[j] = gelu_tanh(bq[j]); }
                    GAS bf16_t* p = yb + (size_t)(b * SEQ + c * LC + t) * 512 + g * 16 + i0;
                    *(GAS u32x4*)p = pack8(a, bq);
                }
                asm volatile("" ::: "memory");
            }
    }
};

struct EpiProj {
    static constexpr bool PERM = true;
    unsigned char* ws;
    __device__ __forceinline__ void operator()(const Acc& acc, const Unit& u, int wr, int wc, int fr, int fq) const {
        GAS unsigned char* w = (GAS unsigned char*)ws; asm volatile("" : "+s"(w)); const GAS unsigned char* gt = (const GAS unsigned char*)(w + WS_GT); GAS bf16_t* mg = (GAS bf16_t*)(w + WS_MG);
        u32x2 gw[2][4][2];
        ROWS8(ai, m) { const GAS unsigned char* gp = gt + (size_t)EPI_ROW(u, ai, m) * 2048 + u.pn * 256 + wc * 64 + 8 * fq; gw[ai][m][0] = *(const GAS u32x2*)gp; gw[ai][m][1] = *(const GAS u32x2*)(gp + 32); }
        ROWS8(ai, m) {
                const int row = EPI_ROW(u, ai, m);
#pragma unroll
                for (int bj = 0; bj < 2; ++bj) {
                    const int col = u.pn * 256 + wc * 64 + bj * 32 + 8 * fq; const u32x2 g = gw[ai][m][bj];
                    const f32x4 a = acc[ai][bj][m][0] * unpack4_u8(g.x), b = acc[ai][bj][m][1] * unpack4_u8(g.y);
                    *(GAS u32x4*)(mg + (size_t)row * 1024 + col) = pack8(a, b);
                }
                asm volatile("" ::: "memory");
            }
    }
};

struct EpiGlu {
    static constexpr bool PERM = true;
    unsigned char* ws;
    __device__ __forceinline__ void operator()(const Acc& acc, const Unit& u, int wr, int wc, int fr, int fq) const {
        GAS unsigned char* w = (GAS unsigned char*)ws; asm volatile("" : "+s"(w)); const GAS unsigned char* gt = (const GAS unsigned char*)(w + WS_GT); GAS bf16_t* mg = (GAS bf16_t*)(w + WS_MG);
        u32x2 gw[2][4]; u32x4 mw[2][4];
        ROWS8(ai, m) { const size_t row = (size_t)EPI_ROW(u, ai, m); const int col = u.pn * 128 + wc * 32 + 8 * fq; gw[ai][m] = *(const GAS u32x2*)(gt + row * 2048 + 1024 + col); mw[ai][m] = *(const GAS u32x4*)(mg + row * 1024 + col); }
        ROWS8(ai, m) {
                const int row = EPI_ROW(u, ai, m), col = u.pn * 128 + wc * 32 + 8 * fq;
                const u32x2 g = gw[ai][m]; const u32x4 mo = mw[ai][m];
                const f32x4 g1a = unpack4_u8(g.x), g1b = unpack4_u8(g.y);
                f32x4 va = acc[ai][0][m][0], vb = acc[ai][0][m][1]; const f32x4 ga = acc[ai][1][m][0], gb = acc[ai][1][m][1];
                const f32x4 ma = (f32x4){bflo(mo.x), bfhi(mo.x), bflo(mo.y), bfhi(mo.y)}, mb = (f32x4){bflo(mo.z), bfhi(mo.z), bflo(mo.w), bfhi(mo.w)};
#pragma unroll
                for (int j = 0; j < 4; ++j) { va[j] = ma[j] + va[j] * fast_sigmoid(ga[j]) * g1a[j]; vb[j] = mb[j] + vb[j] * fast_sigmoid(gb[j]) * g1b[j]; }
                *(GAS u32x4*)(mg + (size_t)row * 1024 + col) = pack8(va, vb);
                asm volatile("" ::: "memory");
            }
    }
};

struct EpiOut {
    static constexpr bool PERM = true;
    unsigned char* ws;
    __device__ __forceinline__ void operator()(const Acc& acc, const Unit& u, int wr, int wc, int fr, int fq) const {
        GAS unsigned char* w = (GAS unsigned char*)ws; asm volatile("" : "+s"(w)); GAS bf16_t* xb = (GAS bf16_t*)(w + WS_XB); GAS float* ssx = (GAS float*)(w + WS_SSX);
        u32x4 xw[2][4][2];
        ROWS8(ai, m) { const GAS bf16_t* p = xb + (size_t)EPI_ROW(u, ai, m) * 1024 + u.pn * 256 + wc * 64 + 8 * fq; xw[ai][m][0] = *(const GAS u32x4*)p; xw[ai][m][1] = *(const GAS u32x4*)(p + 32); }
        ROWS8(ai, m) {
                const int row = EPI_ROW(u, ai, m);
                float s = 0.f;
#pragma unroll
                for (int bj = 0; bj < 2; ++bj) {
                    GAS bf16_t* p = xb + (size_t)row * 1024 + u.pn * 256 + wc * 64 + bj * 32 + 8 * fq; const u32x4 x4 = xw[ai][m][bj];
                    const f32x4 a = (f32x4){bflo(x4.x), bfhi(x4.x), bflo(x4.y), bfhi(x4.y)} + acc[ai][bj][m][0], b = (f32x4){bflo(x4.z), bfhi(x4.z), bflo(x4.w), bfhi(x4.w)} + acc[ai][bj][m][1];
                    *(GAS u32x4*)p = pack8(a, b);
                    s += ((a[0] * a[0] + a[1] * a[1]) + (a[2] * a[2] + a[3] * a[3])) + ((b[0] * b[0] + b[1] * b[1]) + (b[2] * b[2] + b[3] * b[3]));
                }
                s = sum_x16(s); s = sum_x32(s);
                if (fq == 0) ssx[(size_t)row * 16 + u.pn * 4 + wc] = s;
                asm volatile("" ::: "memory");
            }
    }
};

struct MoeOrder {
    static constexpr bool GATHER = false;
    const int* tseg; int tile0, ntile, NC, G, c;
    int loff = 0, lmax = 0x7fffffff;
    __device__ int vcu() const { return (G % 8 == 0) ? (c % 8) * (G / 8) + c / 8 : c; }
    __device__ bool unit(int L, Unit& u) const { const int pm = tile0 + L / NC, pnl = L % NC; u.pm = pm; u.pn = (tseg[pm] & 31) * NC + pnl; return true; }
    __device__ bool next(int i, Unit& u) const {
        const int L = i * G + vcu() + loff; if (L >= ntile * NC || L >= lmax) return false;
        return unit(L, u);
    }
};
struct MoeGatherOrder : MoeOrder { static constexpr bool GATHER = true; const int* gidx; };
struct MoeDownAOrder : MoeOrder {
    int nbusy;
    __device__ bool next(int i, Unit& u) const {
        const int vc = vcu(), F = G - nbusy; int L;
        if (vc >= nbusy) { const int j = vc - nbusy; L = (i < 2) ? i * F + j : 2 * F + (i - 2) * G + vc; }
        else L = 2 * F + i * G + vc;
        if (L >= ntile * NC) return false;
        return unit(L, u);
    }
};

struct EpiGU {
    static constexpr bool PERM = true;
    unsigned char* ws;
    __device__ __forceinline__ void operator()(const Acc& acc, const Unit& u, int wr, int wc, int fr, int fq) const {
        GAS unsigned char* w = (GAS unsigned char*)ws; asm volatile("" : "+s"(w)); const GAS float* ars = (const GAS float*)(w + WS_ARS); GAS bf16_t* hh = (GAS bf16_t*)(w + WS_HH);
        const int pnl = u.pn & 1;
        float rsv[2][4];
        ROWS8(ai, m) rsv[ai][m] = ars[EPI_ROW(u, ai, m)];
        ROWS8(ai, m) {
                const int row = EPI_ROW(u, ai, m);
                const float rs = rsv[ai][m];
                f32x4 ga = acc[ai][0][m][0] * rs, gb = acc[ai][0][m][1] * rs, ua = acc[ai][1][m][0] * rs, ub = acc[ai][1][m][1] * rs;
#pragma unroll
                for (int j = 0; j < 4; ++j) { ga[j] = ga[j] * fast_sigmoid(ga[j]) * ua[j]; gb[j] = gb[j] * fast_sigmoid(gb[j]) * ub[j]; }
                *(GAS u32x4*)(hh + (size_t)row * 256 + pnl * 128 + wc * 32 + 8 * fq) = pack8(ga, gb);
                asm volatile("" ::: "memory");
            }
    }
};

template <bool PASS_B> struct EpiDown {
    static constexpr bool PERM = true;
    unsigned char* ws; float* out;
    __device__ __forceinline__ void operator()(const Acc& acc, const Unit& u, int wr, int wc, int fr, int fq) const {
        GAS unsigned char* w = (GAS unsigned char*)ws; asm volatile("" : "+s"(w)); const GAS int* atok = (const GAS int*)(w + WS_ATOK); const GAS float* aw = (const GAS float*)(w + WS_AW); GAS bf16_t* xb = (GAS bf16_t*)(w + WS_XB); GAS float* ssx = (GAS float*)(w + WS_SSX);
        GAS float* og = (GAS float*)out;
        const int pnl = u.pn & 3;
        int tk[2][4]; float wg[2][4]; u32x4 xw[2][4][2];
        ROWS8(ai, m) { const int row = EPI_ROW(u, ai, m); tk[ai][m] = atok[row]; wg[ai][m] = aw[row]; }
        ROWS8(ai, m) { const int t0 = tk[ai][m] < 0 ? 0 : tk[ai][m]; const GAS bf16_t* p = xb + (size_t)t0 * 1024 + pnl * 256 + wc * 64 + 8 * fq; xw[ai][m][0] = *(const GAS u32x4*)p; xw[ai][m][1] = *(const GAS u32x4*)(p + 32); }
        ROWS8(ai, m) {
                const int tok = tk[ai][m]; const float wgt = wg[ai][m];
                const int t0 = tok < 0 ? 0 : tok;
                float s = 0.f;
#pragma unroll
                for (int bj = 0; bj < 2; ++bj) {
                    const size_t o = (size_t)t0 * 1024 + pnl * 256 + wc * 64 + bj * 32 + 8 * fq; const u32x4 x4 = xw[ai][m][bj];
                    const f32x4 a = (f32x4){bflo(x4.x), bfhi(x4.x), bflo(x4.y), bfhi(x4.y)} + acc[ai][bj][m][0] * wgt, b = (f32x4){bflo(x4.z), bfhi(x4.z), bflo(x4.w), bfhi(x4.w)} + acc[ai][bj][m][1] * wgt;
                    if (tok >= 0) { *(GAS u32x4*)(xb + o) = pack8(a, b);
                        if (PASS_B && og) { *(GAS f32x4*)(og + o) = a; *(GAS f32x4*)(og + o + 4) = b; } }
                    s += ((a[0] * a[0] + a[1] * a[1]) + (a[2] * a[2] + a[3] * a[3])) + ((b[0] * b[0] + b[1] * b[1]) + (b[2] * b[2] + b[3] * b[3]));
                }
                if (PASS_B) { s = sum_x16(s); s = sum_x32(s); if (fq == 0 && tok >= 0) ssx[(size_t)tok * 16 + pnl * 4 + wc] = s; }
                asm volatile("" ::: "memory");
            }
    }
};

struct SsmSOrder {
    static constexpr bool GATHER = false; int G, c;
    __device__ bool next(int i, Unit& u) const { const int cc = (c + G / 2) % G; const int L = i * G + cc; if (L >= 128) return false; u.pm = L; u.pn = L >> 2; return true; }
};
struct SsmYOrder {
    static constexpr bool GATHER = false; int G, c;
    __device__ bool next(int i, Unit& u) const { const int vc = (G % 8 == 0) ? (c % 8) * (G / 8) + c / 8 : c; const int L = i * G + vc; if (L >= 256) return false; u.pm = L >> 1; u.pn = (L >> 3) * 2 + (L & 1); return true; }
};
namespace att {
#define KSWZ(row, colB) ((row) * 256 + ((colB) ^ (((row) & 15) << 4)))
#define SBAR() __builtin_amdgcn_sched_barrier(0)
constexpr int SHM_K = 32768, SHM_V = 16384, OFF_V = 2 * SHM_K, OFF_WS = 2 * SHM_K + 2 * SHM_V;
__device__ __forceinline__ int crow(int r, int hi) { return (r & 3) + 8 * (r >> 2) + 4 * hi; }
__device__ __forceinline__ int v_st(int k, int c) { const int kk = (k & ~0xC) | ((k & 4) << 1) | ((k & 8) >> 1); return ((kk >> 3) * 2 + (c >> 5)) * 512 + ((kk & 7) * 32 + (c & 31)) * 2; }
__device__ __forceinline__ int v_rd_base(int lane) { return ((lane & 3) << 3) | (((lane >> 2) & 3) << 6) | (((lane >> 4) & 1) << 5) | (((lane >> 5) & 1) << 8); }
constexpr int v_rd_off(int d0, int ks, int half) { return d0 * 512 + ks * 2048 + half * 1024; }
template <int OFF> __device__ __forceinline__ s16x4 tr_read(int vb) {
    s16x4 r; asm volatile("ds_read_b64_tr_b16 %0, %1 offset:%2" : "=&v"(r) : "v"(vb), "i"(OFF) : "memory"); return r;
}
template <int D0> __device__ __forceinline__ void pv_one(f32x16& od, int vb, bf16x8 pa0, bf16x8 pa1, bf16x8 pa2, bf16x8 pa3) {
    const s16x4 l0 = tr_read<v_rd_off(D0, 0, 0)>(vb), h0 = tr_read<v_rd_off(D0, 0, 1)>(vb), l1 = tr_read<v_rd_off(D0, 1, 0)>(vb), h1 = tr_read<v_rd_off(D0, 1, 1)>(vb);
    const s16x4 l2 = tr_read<v_rd_off(D0, 2, 0)>(vb), h2 = tr_read<v_rd_off(D0, 2, 1)>(vb), l3 = tr_read<v_rd_off(D0, 3, 0)>(vb), h3 = tr_read<v_rd_off(D0, 3, 1)>(vb);
    asm volatile("s_waitcnt lgkmcnt(0)" ::: "memory"); SBAR();
#define PK(L, H) (bf16x8){L[0], L[1], L[2], L[3], H[0], H[1], H[2], H[3]}
    od = __builtin_amdgcn_mfma_f32_32x32x16_bf16(pa0, PK(l0, h0), od, 0, 0, 0);
    od = __builtin_amdgcn_mfma_f32_32x32x16_bf16(pa1, PK(l1, h1), od, 0, 0, 0);
    od = __builtin_amdgcn_mfma_f32_32x32x16_bf16(pa2, PK(l2, h2), od, 0, 0, 0);
    od = __builtin_amdgcn_mfma_f32_32x32x16_bf16(pa3, PK(l3, h3), od, 0, 0, 0);
#undef PK
}
__device__ __forceinline__ void attn_unit(char* lds, int b, int h, int qb, const bf16_t* TQ, const float* qss, const float* rope, const float* gq, float kbound,
                                          const bf16_t* KB, const bf16_t* VB, bf16_t* OB, int variant = 0) {
    int tid_ = threadIdx.x; asm volatile("" : "+v"(tid_));
    const int tid = tid_, wid = tid >> 6, lane = tid & 63, r32 = lane & 31, hi = lane >> 5;
    char* K_lds = lds; char* V_lds = lds + OFF_V; float* li_l = (float*)(lds + OFF_WS) + wid * 64;
    constexpr float C = 0.10206207261596575f * 1.4426950408889634f;
    const int row = b * SEQ + qb * 256 + wid * 32 + r32;
    bf16x8 qr[6]; float mb;
    {
        const bf16_t* tq = TQ + (size_t)row * 768 + h * 96 + hi * 8;
        float qf[6][8]; float ss = 0.f;
#pragma unroll
        for (int d0 = 0; d0 < 6; ++d0) { const u32x4 w = *(const u32x4*)(tq + d0 * 16);
            qf[d0][0] = bflo(w.x); qf[d0][1] = bfhi(w.x); qf[d0][2] = bflo(w.y); qf[d0][3] = bfhi(w.y); qf[d0][4] = bflo(w.z); qf[d0][5] = bfhi(w.z); qf[d0][6] = bflo(w.w); qf[d0][7] = bfhi(w.w);
#pragma unroll
            for (int j = 0; j < 8; ++j) ss += qf[d0][j] * qf[d0][j]; }
        ss = sum_x32(ss);
        const f32x4 qa = *(const f32x4*)(qss + (size_t)row * 8), qb4 = *(const f32x4*)(qss + (size_t)row * 8 + 4);
        const float a = __builtin_amdgcn_rsqf((((qa[0] + qa[1]) + (qa[2] + qa[3])) + ((qb4[0] + qb4[1]) + (qb4[2] + qb4[3]))) * (1.0f / 384.0f) + EPS);
        const float f = a * __builtin_amdgcn_rsqf(a * a * ss * (1.0f / 96.0f) + EPS);
#pragma unroll
        for (int d0 = 0; d0 < 6; ++d0) { const f32x4 g0 = *(const f32x4*)(gq + d0 * 16 + hi * 8), g1 = *(const f32x4*)(gq + d0 * 16 + hi * 8 + 4);
#pragma unroll
            for (int j = 0; j < 4; ++j) { qf[d0][j] *= f * g0[j]; qf[d0][4 + j] *= f * g1[j]; } }
        const float* rp = rope + (size_t)row * 32 + hi * 8;
        const f32x4 c0 = *(const f32x4*)rp, c1 = *(const f32x4*)(rp + 4), s0 = *(const f32x4*)(rp + 16), s1 = *(const f32x4*)(rp + 20);
#pragma unroll
        for (int j = 0; j < 8; ++j) { const float cs = j < 4 ? c0[j & 3] : c1[j & 3], sn = j < 4 ? s0[j & 3] : s1[j & 3]; const float x1 = qf[4][j], x2 = qf[5][j];
            qf[4][j] = x1 * cs - x2 * sn; qf[5][j] = x2 * cs + x1 * sn; }
        float qn = 0.f;
#pragma unroll
        for (int d0 = 0; d0 < 6; ++d0)
#pragma unroll
            for (int j = 0; j < 8; ++j) qn += qf[d0][j] * qf[d0][j];
        qn = sum_x32(qn);
        mb = sqrtf(qn) * kbound * C;
#pragma unroll
        for (int d0 = 0; d0 < 6; ++d0) { u32x4 w; w.x = cvt_pk_bf16(qf[d0][0] * C, qf[d0][1] * C); w.y = cvt_pk_bf16(qf[d0][2] * C, qf[d0][3] * C); w.z = cvt_pk_bf16(qf[d0][4] * C, qf[d0][5] * C); w.w = cvt_pk_bf16(qf[d0][6] * C, qf[d0][7] * C);
            qr[d0] = *reinterpret_cast<bf16x8*>(&w); }
    }
    const bf16_t* Kh = KB + (size_t)(b * NH + h) * SEQ * 96; const bf16_t* Vh = VB + (size_t)(b * NH + h) * SEQ * 64;
    const int sr = tid >> 2, sc = tid & 3;
    const int vb0 = (int)(uintptr_t)V_lds + v_rd_base(lane);
    const int NS = 2 * qb + 2, cw = 4 * qb + (wid >> 1);
    float l_reg = 0.f; f32x16 o0 = {}, o1 = {};
    bf16x8 k0r, k1r, k2r, v0r, v1r;
#define SLOAD(key0) do { const bf16_t* kp_ = Kh + (size_t)((key0) + sr) * 96 + sc * 8; k0r = *(const bf16x8*)kp_; k1r = *(const bf16x8*)(kp_ + 32); k2r = *(const bf16x8*)(kp_ + 64); \
        const bf16_t* vp_ = Vh + (size_t)((key0) + sr) * 64 + sc * 8; v0r = *(const bf16x8*)vp_; v1r = *(const bf16x8*)(vp_ + 32); } while (0)
#define SWRITE(bf) do { int t_ = threadIdx.x; asm volatile("" : "+v"(t_)); const int sr_ = t_ >> 2, sc_ = t_ & 3; \
        char* kd_ = K_lds + (bf) * SHM_K; *(bf16x8*)(kd_ + KSWZ(sr_, sc_ * 16)) = k0r; *(bf16x8*)(kd_ + KSWZ(sr_, (sc_ + 4) * 16)) = k1r; *(bf16x8*)(kd_ + KSWZ(sr_, (sc_ + 8) * 16)) = k2r; \
        char* vd_ = V_lds + (bf) * SHM_V + (sr_ >> 6) * 8192; *(bf16x8*)(vd_ + v_st(sr_ & 63, sc_ * 8)) = v0r; *(bf16x8*)(vd_ + v_st(sr_ & 63, (sc_ + 4) * 8)) = v1r; } while (0)
#define QKT(P0, P1, KS) do { const char* Ks_ = (KS); _Pragma("unroll") for (int r = 0; r < 16; ++r) { P0[r] = -mb; P1[r] = -mb; } \
        bf16x8 kf0[6], kf1[6]; \
        _Pragma("unroll") for (int d0 = 0; d0 < 6; ++d0) { const int cb = (d0 * 16 + hi * 8) * 2; \
            kf0[d0] = *reinterpret_cast<const bf16x8*>(Ks_ + KSWZ(r32, cb)); kf1[d0] = *reinterpret_cast<const bf16x8*>(Ks_ + KSWZ(32 + r32, cb)); } \
        SBAR();   \
        _Pragma("unroll") for (int d0 = 0; d0 < 6; ++d0) { \
            P0 = __builtin_amdgcn_mfma_f32_32x32x16_bf16(kf0[d0], qr[d0], P0, 0, 0, 0); P1 = __builtin_amdgcn_mfma_f32_32x32x16_bf16(kf1[d0], qr[d0], P1, 0, 0, 0); } } while (0)
#define PK4(P, BASE, OUT) do { unsigned a0 = cvt_pk_bf16(P[BASE + 0], P[BASE + 1]), a1 = cvt_pk_bf16(P[BASE + 2], P[BASE + 3]);   \
    unsigned b0_ = cvt_pk_bf16(P[BASE + 4], P[BASE + 5]), b1_ = cvt_pk_bf16(P[BASE + 6], P[BASE + 7]);                              \
    auto r0 = __builtin_amdgcn_permlane32_swap(a0, b0_, false, false); auto r1 = __builtin_amdgcn_permlane32_swap(a1, b1_, false, false); \
    u32x4 w = {r0[0], r1[0], r0[1], r1[1]}; OUT = *reinterpret_cast<bf16x8*>(&w); } while (0)
#define SMX(P0, P1) do { float ps = 0.f; _Pragma("unroll") for (int r = 0; r < 16; ++r) { P0[r] = __builtin_amdgcn_exp2f(P0[r]); P1[r] = __builtin_amdgcn_exp2f(P1[r]); ps += P0[r] + P1[r]; } \
        ps = sum_x32(ps); l_reg += ps; PK4(P0, 0, pa0); PK4(P0, 8, pa1); PK4(P1, 0, pa2); PK4(P1, 8, pa3); } while (0)
#define PV(VB_) do { const int vb_ = (VB_); pv_one<0>(o0, vb_, pa0, pa1, pa2, pa3); pv_one<1>(o1, vb_, pa0, pa1, pa2, pa3); } while (0)
#define PKV(L, H) (bf16x8){L[0], L[1], L[2], L[3], H[0], H[1], H[2], H[3]}
#define GAP_EXP4(P, B) do { P[B] = __builtin_amdgcn_exp2f(P[B]); P[B + 1] = __builtin_amdgcn_exp2f(P[B + 1]); P[B + 2] = __builtin_amdgcn_exp2f(P[B + 2]); P[B + 3] = __builtin_amdgcn_exp2f(P[B + 3]); asm volatile("" : "+v"(P)); SBAR(); } while (0)
#define GAP_SUM8(P, B) do { psum_ += ((P[B] + P[B + 1]) + (P[B + 2] + P[B + 3])) + ((P[B + 4] + P[B + 5]) + (P[B + 6] + P[B + 7])); asm volatile("" : "+v"(psum_)); SBAR(); } while (0)
#define GAP_PK(P, BASE, OUT) do { PK4(P, BASE, OUT); asm volatile("" : "+v"(OUT)); SBAR(); } while (0)
#define EXPALL(P0, P1) do { _Pragma("unroll") for (int r = 0; r < 16; ++r) { P0[r] = __builtin_amdgcn_exp2f(P0[r]); P1[r] = __builtin_amdgcn_exp2f(P1[r]); } } while (0)
#define SUMPACK(P0, P1) do { float ps = 0.f; _Pragma("unroll") for (int r = 0; r < 16; ++r) ps += P0[r] + P1[r]; ps = sum_x32(ps); l_reg += ps; PK4(P0, 0, pa0); PK4(P0, 8, pa1); PK4(P1, 0, pa2); PK4(P1, 8, pa3); } while (0)
#define BLK_QK(P0, P1, KS, S0, S1) do { const char* Ks_ = (KS); bf16x8 kf0[6], kf1[6]; \
        _Pragma("unroll") for (int d0 = 0; d0 < 6; ++d0) { const int cb = (d0 * 16 + hi * 8) * 2; kf0[d0] = *reinterpret_cast<const bf16x8*>(Ks_ + KSWZ(r32, cb)); kf1[d0] = *reinterpret_cast<const bf16x8*>(Ks_ + KSWZ(32 + r32, cb)); } \
        SBAR(); _Pragma("unroll") for (int r = 0; r < 16; ++r) { P0[r] = -mb; P1[r] = -mb; } float psum_ = 0.f; \
        P0 = __builtin_amdgcn_mfma_f32_32x32x16_bf16(kf0[0], qr[0], P0, 0, 0, 0); GAP_SUM8(S0, 0); \
        P1 = __builtin_amdgcn_mfma_f32_32x32x16_bf16(kf1[0], qr[0], P1, 0, 0, 0); GAP_SUM8(S0, 8); \
        P0 = __builtin_amdgcn_mfma_f32_32x32x16_bf16(kf0[1], qr[1], P0, 0, 0, 0); GAP_SUM8(S1, 0); \
        P1 = __builtin_amdgcn_mfma_f32_32x32x16_bf16(kf1[1], qr[1], P1, 0, 0, 0); GAP_SUM8(S1, 8); \
        P0 = __builtin_amdgcn_mfma_f32_32x32x16_bf16(kf0[2], qr[2], P0, 0, 0, 0); GAP_PK(S0, 0, pa0); \
        P1 = __builtin_amdgcn_mfma_f32_32x32x16_bf16(kf1[2], qr[2], P1, 0, 0, 0); GAP_PK(S0, 8, pa1); \
        P0 = __builtin_amdgcn_mfma_f32_32x32x16_bf16(kf0[3], qr[3], P0, 0, 0, 0); GAP_PK(S1, 0, pa2); \
        P1 = __builtin_amdgcn_mfma_f32_32x32x16_bf16(kf1[3], qr[3], P1, 0, 0, 0); GAP_PK(S1, 8, pa3); \
        P0 = __builtin_amdgcn_mfma_f32_32x32x16_bf16(kf0[4], qr[4], P0, 0, 0, 0); P1 = __builtin_amdgcn_mfma_f32_32x32x16_bf16(kf1[4], qr[4], P1, 0, 0, 0); \
        P0 = __builtin_amdgcn_mfma_f32_32x32x16_bf16(kf0[5], qr[5], P0, 0, 0, 0); P1 = __builtin_amdgcn_mfma_f32_32x32x16_bf16(kf1[5], qr[5], P1, 0, 0, 0); \
        psum_ = sum_x32(psum_); l_reg += psum_; SBAR(); } while (0)
#define BLK_PV(VB_, X0, X1) do { const int vb_ = (VB_); \
        const s16x4 a0l = tr_read<v_rd_off(0, 0, 0)>(vb_), a0h = tr_read<v_rd_off(0, 0, 1)>(vb_), b0l = tr_read<v_rd_off(1, 0, 0)>(vb_), b0h = tr_read<v_rd_off(1, 0, 1)>(vb_); \
        const s16x4 a1l = tr_read<v_rd_off(0, 1, 0)>(vb_), a1h = tr_read<v_rd_off(0, 1, 1)>(vb_), b1l = tr_read<v_rd_off(1, 1, 0)>(vb_), b1h = tr_read<v_rd_off(1, 1, 1)>(vb_); \
        const s16x4 a2l = tr_read<v_rd_off(0, 2, 0)>(vb_), a2h = tr_read<v_rd_off(0, 2, 1)>(vb_), b2l = tr_read<v_rd_off(1, 2, 0)>(vb_), b2h = tr_read<v_rd_off(1, 2, 1)>(vb_); \
        const s16x4 a3l = tr_read<v_rd_off(0, 3, 0)>(vb_), a3h = tr_read<v_rd_off(0, 3, 1)>(vb_), b3l = tr_read<v_rd_off(1, 3, 0)>(vb_), b3h = tr_read<v_rd_off(1, 3, 1)>(vb_); \
        asm volatile("s_waitcnt lgkmcnt(0)" ::: "memory"); SBAR(); \
        o0 = __builtin_amdgcn_mfma_f32_32x32x16_bf16(pa0, PKV(a0l, a0h), o0, 0, 0, 0); GAP_EXP4(X0, 0); \
        o1 = __builtin_amdgcn_mfma_f32_32x32x16_bf16(pa0, PKV(b0l, b0h), o1, 0, 0, 0); GAP_EXP4(X0, 4); \
        o0 = __builtin_amdgcn_mfma_f32_32x32x16_bf16(pa1, PKV(a1l, a1h), o0, 0, 0, 0); GAP_EXP4(X0, 8); \
        o1 = __builtin_amdgcn_mfma_f32_32x32x16_bf16(pa1, PKV(b1l, b1h), o1, 0, 0, 0); GAP_EXP4(X0, 12); \
        o0 = __builtin_amdgcn_mfma_f32_32x32x16_bf16(pa2, PKV(a2l, a2h), o0, 0, 0, 0); GAP_EXP4(X1, 0); \
        o1 = __builtin_amdgcn_mfma_f32_32x32x16_bf16(pa2, PKV(b2l, b2h), o1, 0, 0, 0); GAP_EXP4(X1, 4); \
        o0 = __builtin_amdgcn_mfma_f32_32x32x16_bf16(pa3, PKV(a3l, a3h), o0, 0, 0, 0); GAP_EXP4(X1, 8); \
        o1 = __builtin_amdgcn_mfma_f32_32x32x16_bf16(pa3, PKV(b3l, b3h), o1, 0, 0, 0); GAP_EXP4(X1, 12); } while (0)
    bool pend = false;
    if (wid < 4) __builtin_amdgcn_s_setprio(1);
    f32x16 pA0 = {}, pA1 = {}, pB0 = {}, pB1 = {}; bf16x8 pa0 = {}, pa1 = {}, pa2 = {}, pa3 = {};
    SLOAD(0);
    for (int s = 0; s < NS; ++s) {
        const int bf = s & 1;
        asm volatile("s_waitcnt vmcnt(0)" ::: "memory");
        SWRITE(bf);
        if (s + 1 < NS) SLOAD((s + 1) * 128);
        __syncthreads();
        const bool va = 2 * s <= cw, vb2 = 2 * s + 1 <= cw;
        const char* Kb_ = K_lds + bf * SHM_K; const int vbase = vb0 + bf * SHM_V;
        SBAR();
        if (va && vb2 && pend) {
            const int vprev = vb0 + (bf ^ 1) * SHM_V + 8192;
            BLK_QK(pA0, pA1, Kb_, pB0, pB1);
            BLK_PV(vprev, pA0, pA1);
            BLK_QK(pB0, pB1, Kb_ + 16384, pA0, pA1);
            BLK_PV(vbase, pB0, pB1);
        } else {
            if (pend) { SUMPACK(pB0, pB1); SBAR(); PV(vb0 + (bf ^ 1) * SHM_V + 8192); }
            if (va) { QKT(pA0, pA1, Kb_); EXPALL(pA0, pA1); SUMPACK(pA0, pA1); SBAR(); PV(vbase); }
            if (vb2) { QKT(pB0, pB1, Kb_ + 16384); EXPALL(pB0, pB1); }
        }
        pend = vb2;
    }
    if (pend) { SUMPACK(pB0, pB1); SBAR(); PV(vb0 + ((NS - 1) & 1) * SHM_V + 8192); }
    __builtin_amdgcn_s_setprio(0);
#undef BLK_QK
#undef BLK_PV
#undef SUMPACK
#undef EXPALL
#undef GAP_EXP4
#undef GAP_SUM8
#undef GAP_PK
#undef PKV
#undef SLOAD
#undef SWRITE
#undef QKT
#undef SMX
#undef PK4
#undef PV
    if (hi == 0) li_l[r32] = l_reg; asm volatile("s_waitcnt lgkmcnt(0)" ::: "memory");
    bf16_t* ot = (bf16_t*)(lds + OFF_WS + 2048) + wid * 2048;
#pragma unroll
    for (int r = 0; r < 16; ++r) { const int orow = crow(r, hi); const float rl = __builtin_amdgcn_rcpf(li_l[orow]);
        ot[orow * 64 + r32] = (bf16_t)f2bf(o0[r] * rl); ot[orow * 64 + 32 + r32] = (bf16_t)f2bf(o1[r] * rl); }
    asm volatile("s_waitcnt lgkmcnt(0)" ::: "memory");
    bf16_t* Ow = OB + (size_t)(b * SEQ + qb * 256 + wid * 32) * 512 + h * 64;
#pragma unroll
    for (int i = 0; i < 4; ++i) { const int ch = i * 64 + lane, orow = ch >> 3, oc = (ch & 7) * 8;
        *(u32x4*)(Ow + (size_t)orow * 512 + oc) = *(const u32x4*)(ot + orow * 64 + oc); }
    asm volatile("s_waitcnt lgkmcnt(0)" ::: "memory");
}
#undef KSWZ
}

__device__ __forceinline__ float wave_sum(float v) {
    return sum_x32(sum_x16(row_sum16(v)));
}
__device__ __forceinline__ float wave_max(float v) {
    return max_x32(max_x16(row_max16(v)));
}

struct TDesc { const float* W; const float* gain; bf16_t* WT; int K, N, kb, dr0, sc0; };
__device__ __forceinline__ void tr_load(const TDesc& d, f32x4 (&v)[8], int lane) {
    if (d.sc0 < 0) { float z = 0.f; asm volatile("" : "+v"(z));
#pragma unroll
        for (int i = 0; i < 8; ++i) v[i] = (f32x4){z, z, z, z};
        return; }
    const float* src = d.W + (size_t)(64 * d.kb + (lane >> 3)) * d.N + d.sc0 + 4 * (lane & 7);
#pragma unroll
    for (int i = 0; i < 8; ++i) v[i] = __builtin_nontemporal_load((const f32x4*)(src + (size_t)(8 * i) * d.N));
}
__device__ __forceinline__ void tr_store(const TDesc& d, const f32x4 (&v)[8], LAS float* scr, int lane) {
    const int k0 = 64 * d.kb, K = d.K;
    if (d.sc0 < 0) {
#pragma unroll
        for (int j = 0; j < 4; ++j) { const int n = (lane >> 3) + 8 * j; *(u32x4*)(d.WT + (size_t)(d.dr0 + n) * K + k0 + 8 * (lane & 7)) = (u32x4){0u, 0u, 0u, 0u}; }
        return;
    }
#pragma unroll
    for (int i = 0; i < 8; ++i) { const int kk = 8 * i + (lane >> 3); const float g = d.gain ? d.gain[k0 + kk] : 1.0f; LAS float* s = scr + kk * 33 + 4 * (lane & 7);
        s[0] = v[i][0] * g; s[1] = v[i][1] * g; s[2] = v[i][2] * g; s[3] = v[i][3] * g; }
    asm volatile("s_waitcnt lgkmcnt(0)" ::: "memory");
    const int c = lane & 7;
#pragma unroll
    for (int j = 0; j < 4; ++j) { const int n = (lane >> 3) + 8 * j; const LAS float* s = scr + (8 * c) * 33 + n;
        u32x4 o; o.x = cvt_pk_bf16(s[0 * 33], s[1 * 33]); o.y = cvt_pk_bf16(s[2 * 33], s[3 * 33]); o.z = cvt_pk_bf16(s[4 * 33], s[5 * 33]); o.w = cvt_pk_bf16(s[6 * 33], s[7 * 33]);
        *(u32x4*)(d.WT + (size_t)(d.dr0 + n) * K + k0 + 8 * c) = o; }
    asm volatile("s_waitcnt lgkmcnt(0)" ::: "memory");
}
__device__ __forceinline__ int win_src(int nb) {
    if (nb < 64) return 1184 + 32 * nb;
    if (nb < 80) return 672 + 32 * (nb - 64);
    if (nb < 88) return 384 + 32 * (nb - 80);
    if (nb < 96) return 32 * (nb - 88);
    if (nb < 100) return 256 + 32 * (nb - 96);
    if (nb == 100) return 640;
    return -1;
}
__device__ __forceinline__ int ukv_src(int nb) { const int pn = nb >> 3, wc = (nb >> 1) & 3, bj = nb & 1; return pn < 2 ? 128 * (4 * pn + wc) + 32 * bj : 128 * (4 * (pn - 2) + wc) + 64 + 32 * bj; }

constexpr int MIXW_ITEMS = 16 * 104 + 6 * 24 + 4 * 32 + 8 * 32 + 8 * 64 + 16 * 32;
__device__ __forceinline__ TDesc mixw_desc(const Params& P, int it2) {
    const int l = it2 / MIXW_ITEMS; int r = it2 % MIXW_ITEMS;
    bf16_t* wm = (bf16_t*)(P.ws + WS_WMIX + (unsigned)(l * (int)WMIX_LAYER));
    if (r < 16 * 104) { const int kb = r / 104, nb = r % 104; return TDesc{P.in[3] + (unsigned)(l * 1024 * 3232), P.in[2] + l * 1024, wm + WM_IN / 2, 1024, 3232, kb, 32 * nb, win_src(nb)}; } r -= 16 * 104;
    if (r < 6 * 24) { const int kb = r / 24, nb = r % 24; return TDesc{P.in[5] + (unsigned)(l * 384 * 768), P.in[4] + l * 384, wm + WM_UQ / 2, 384, 768, kb, 32 * nb, 32 * nb}; } r -= 6 * 24;
    if (r < 4 * 32) { const int kb = r / 32, nb = r % 32; return TDesc{P.in[7] + (unsigned)(l * 256 * 1024), P.in[6] + l * 256, wm + WM_UKV / 2, 256, 1024, kb, 32 * nb, ukv_src(nb)}; } r -= 4 * 32;
    if (r < 8 * 32) { const int kb = r / 32, nb = r % 32; return TDesc{P.in[10] + (unsigned)(l * 512 * 1024), nullptr, wm + WM_PROJ / 2, 512, 1024, kb, 32 * nb, 32 * nb}; } r -= 8 * 32;
    if (r < 8 * 64) { const int kb = r / 64, nb = r % 64; const int pn = nb >> 3, q = (nb >> 1) & 3, half = nb & 1;
        return TDesc{P.in[19] + (unsigned)(l * 512 * 2048), nullptr, wm + WM_GLU / 2, 512, 2048, kb, 32 * nb, half * 1024 + 128 * pn + 32 * q}; } r -= 8 * 64;
    { const int kb = r / 32, nb = r % 32; return TDesc{P.in[20] + (unsigned)(l * 1024 * 1024), nullptr, wm + WM_OUT / 2, 1024, 1024, kb, 32 * nb, 32 * nb}; }
}
constexpr int EXPW_ITEMS = 32 * (256 + 128);
__device__ __forceinline__ TDesc expw_desc(const Params& P, int l, int it) {
    const int e = it / 384; int r = it % 384;
    if (r < 256) { const int kb = r >> 4, nb = r & 15, t2 = nb >> 3, q = (nb >> 1) & 3, half = nb & 1;
        return TDesc{(half ? P.in[25] : P.in[24]) + ((size_t)l * NE + e) * 1024 * 256, P.in[21] + l * 1024, (bf16_t*)(P.ws + WS_WGU) + (size_t)e * 512 * 1024, 1024, 256, kb, 32 * nb, 128 * t2 + 32 * q}; }
    r -= 256;
    { const int kb = r >> 5, nb = r & 31;
        return TDesc{P.in[26] + ((size_t)l * NE + e) * 256 * 1024, nullptr, (bf16_t*)(P.ws + WS_WD) + (size_t)e * 1024 * 256, 256, 1024, kb, 32 * nb, 32 * nb}; }
}
#define TR_LOOP(DESC_EXPR_OF_IT, FIRST, COUNT, STRIDE) do { \
    for (int it0 = (FIRST); it0 < (COUNT); it0 += 4 * (STRIDE)) { f32x4 va[8], vb[8], vc[8], vd[8]; \
        int it = it0; const TDesc da = DESC_EXPR_OF_IT; tr_load(da, va, lane); \
        it = it0 + (STRIDE); const bool h1 = it < (COUNT); if (!h1) it = it0; const TDesc db = DESC_EXPR_OF_IT; tr_load(db, vb, lane); \
        it = it0 + 2 * (STRIDE); const bool h2 = it < (COUNT); if (!h2) it = it0; const TDesc dc = DESC_EXPR_OF_IT; tr_load(dc, vc, lane); \
        it = it0 + 3 * (STRIDE); const bool h3 = it < (COUNT); if (!h3) it = it0; const TDesc dd = DESC_EXPR_OF_IT; tr_load(dd, vd, lane); \
        tr_store(da, va, scr, lane); if (h1) tr_store(db, vb, scr, lane); if (h2) tr_store(dc, vc, scr, lane); if (h3) tr_store(dd, vd, scr, lane); } } while (0)

constexpr int SSM_PARTS = 4, SSM_CH = 16 / SSM_PARTS;
__device__ __forceinline__ void ssm_tables(const Params& P, int l, int g, int r, LAS unsigned char* scr) {
    int tid_ = threadIdx.x; asm volatile("" : "+v"(tid_)); const int tid = tid_;
    LAS f32x2* pw = (LAS f32x2*)scr;
    LAS f32x2* Bb = pw + 33 * 64;
    LAS f32x2* Cc = Bb + 64 * 16;
    LAS float* Kd = (LAS float*)(Cc + SSM_CH * 64);
    LAS float* Dk = Kd + 32 * SSM_CH * 16;
    const int lg = l * SSG + g;
    const float dt = expf(P.in[13][lg]);
    const float* lre = P.in[11] + (size_t)lg * 64; const float* lim = P.in[12] + (size_t)lg * 64;
    for (int idx = tid; idx < 33 * 64; idx += 512) { const int d = idx >> 6, p = idx & 63;
        const float mag = expf(lre[p] * dt * (float)d);
        const double ang = (double)lim[p] * (double)dt * (double)d * 0.15915494309189535; const float fr = (float)(ang - floor(ang));
        pw[idx] = (f32x2){mag * __builtin_amdgcn_cosf(fr), mag * __builtin_amdgcn_sinf(fr)}; }
    if (tid < SSM_CH) Dk[tid] = P.in[18][(size_t)lg * 16 + SSM_CH * r + tid];
    if (tid < SSM_CH * 64) { const int i = SSM_CH * r + (tid >> 6), p = tid & 63; Cc[tid] = (f32x2){P.in[16][((size_t)lg * 16 + i) * 64 + p], P.in[17][((size_t)lg * 16 + i) * 64 + p]}; }
    __syncthreads();
    for (int idx = tid; idx < 1024; idx += 512) { const int p = idx >> 4, j = idx & 15;
        const float ar = pw[64 + p].x - 1.0f, ai = pw[64 + p].y, cr = lre[p], ci = lim[p], den = 1.0f / (cr * cr + ci * ci);
        const float qr = (ar * cr + ai * ci) * den, qi = (ai * cr - ar * ci) * den;
        const float br = P.in[14][((size_t)lg * 64 + p) * 16 + j], bi = P.in[15][((size_t)lg * 64 + p) * 16 + j];
        Bb[idx] = (f32x2){qr * br - qi * bi, qr * bi + qi * br}; }
    __syncthreads();
    for (int idx = tid; idx < 32 * SSM_CH * 16; idx += 512) { const int d = idx / (SSM_CH * 16), ii = (idx >> 4) % SSM_CH, j = idx & 15; float s = 0.f;
        for (int p = 0; p < 64; ++p) { const f32x2 c = Cc[ii * 64 + p], w = pw[d * 64 + p], bq = Bb[p * 16 + j];
            const float tr = c.x * w.x - c.y * w.y, ti = c.x * w.y + c.y * w.x; s += tr * bq.x - ti * bq.y; }
        Kd[idx] = s; }
    __syncthreads();
    bf16_t* tm = (bf16_t*)(P.ws + WS_TMAT) + (size_t)g * 512 * KIN;
    for (int v = tid; v < 32 * SSM_CH * (KIN / 8); v += 512) { const int nn = v / (KIN / 8), k0 = (v % (KIN / 8)) * 8, t = nn / SSM_CH, ii = nn % SSM_CH, i = SSM_CH * r + ii, n = t * 16 + i; float e[8];
#pragma unroll
        for (int q = 0; q < 8; ++q) { const int k = k0 + q; float val;
            if (k < 512) { const int s = k >> 4, j = k & 15; val = (s <= t) ? Kd[((t - s) * SSM_CH + ii) * 16 + j] + ((s == t && i == j) ? Dk[ii] : 0.f) : 0.f; }
            else { const int p = (k - 512) & 63; const f32x2 c = Cc[ii * 64 + p], w = pw[(t + 1) * 64 + p]; val = (k < 576) ? (c.x * w.x - c.y * w.y) : -(c.x * w.y + c.y * w.x); }
            e[q] = val; }
        *(u32x4*)(tm + (size_t)n * KIN + k0) = (u32x4){cvt_pk_bf16(e[0], e[1]), cvt_pk_bf16(e[2], e[3]), cvt_pk_bf16(e[4], e[5]), cvt_pk_bf16(e[6], e[7])}; }
    bf16_t* wst = (bf16_t*)(P.ws + WS_WST) + (size_t)g * 256 * 512;
    for (int v = tid; v < (256 / SSM_PARTS) * 64; v += 512) { const int n = (256 / SSM_PARTS) * r + (v >> 6), k0 = (v & 63) * 8; float e[8];
#pragma unroll
        for (int q = 0; q < 8; ++q) { const int k = k0 + q, s = k >> 4, j = k & 15, p = n & 63; float val = 0.f;
            if (n < 128) { const f32x2 w = pw[(31 - s) * 64 + p], bq = Bb[p * 16 + j]; val = (n < 64) ? (w.x * bq.x - w.y * bq.y) : (w.x * bq.y + w.y * bq.x); }
            e[q] = val; }
        *(u32x4*)(wst + (size_t)n * 512 + k0) = (u32x4){cvt_pk_bf16(e[0], e[1]), cvt_pk_bf16(e[2], e[3]), cvt_pk_bf16(e[4], e[5]), cvt_pk_bf16(e[6], e[7])}; }
    if (r == 0 && tid < 64) { const f32x2 w = pw[32 * 64 + tid]; float* lam = (float*)(P.ws + WS_LAM) + (size_t)(g * 64 + tid) * 2; lam[0] = w.x; lam[1] = w.y; }
    __syncthreads();
}

__device__ __forceinline__ void router_weights(const Params& P, int l, int gtid, int gthreads) {
    bf16_t* wr = (bf16_t*)(P.ws + WS_WMIX + (size_t)l * WMIX_LAYER + WM_R);
    for (int idx = gtid; idx < 48 * 1024; idx += gthreads) { const int n = idx >> 10, k = idx & 1023; float v = 0.f;
        if (n < 4) v = P.in[22][((size_t)l * 1024 + k) * 4 + n]; else if (n < 36) v = P.in[23][((size_t)l * 1024 + k) * 32 + (n - 4)];
        wr[idx] = (bf16_t)f2bf(v * P.in[21][l * 1024 + k]); }
}

__device__ __forceinline__ void ssm_scan_task(const Params& P, int w, int lane) {
    const float* sst = (const float*)(P.ws + WS_SST); bf16_t* inb = (bf16_t*)(P.ws + WS_IN); const float* lam = (const float*)(P.ws + WS_LAM);
    const int g = w >> 4, b = w & 15;
    const float lr = lam[(g * 64 + lane) * 2], li = lam[(g * 64 + lane) * 2 + 1];
    const size_t r0 = (size_t)g * 1024 + b * 64;
    float sr[NCH], si[NCH];
#pragma unroll
    for (int c = 0; c < NCH; ++c) { sr[c] = sst[(r0 + c) * 128 + lane]; si[c] = sst[(r0 + c) * 128 + 64 + lane]; }
    float xr = 0.f, xi = 0.f;
#pragma unroll
    for (int c = 0; c < NCH; ++c) {
        inb[(r0 + c) * KIN + 512 + lane] = (bf16_t)f2bf(xr); inb[(r0 + c) * KIN + 576 + lane] = (bf16_t)f2bf(xi);
        const float nr = lr * xr - li * xi + sr[c], ni = lr * xi + li * xr + si[c]; xr = nr; xi = ni; }
}

__device__ __forceinline__ void router_phase(const Params& P, int l, LAS unsigned char* lds, int G, int c) {
    int tid_ = threadIdx.x; asm volatile("" : "+v"(tid_));
    const int tid = tid_, wid = tid >> 6, lane = tid & 63;
    const bf16_t* xb = (const bf16_t*)(P.ws + WS_XB); const bf16_t* wr = (const bf16_t*)(P.ws + WS_WMIX + (size_t)l * WMIX_LAYER + WM_R);
    const float* ssx = (const float*)(P.ws + WS_SSX);
    int* te = (int*)(P.ws + WS_TE); float* tw = (float*)(P.ws + WS_TW); float* trs = (float*)(P.ws + WS_TRS); int* cnt = (int*)(P.ws + WS_CNT);
    LAS float* lg = (LAS float*)lds + wid * (16 * 48); LAS int* lcnt = (LAS int*)(lds + 8 * 16 * 48 * 4);
    constexpr int WRP = 2064; LAS unsigned char* wl = lds + 32768;
    for (int q = tid; q < 48 * 128; q += 512) { const int row = q >> 7, ch = q & 127; *(LAS u32x4*)(wl + row * WRP + ch * 16) = *(const u32x4*)(wr + (size_t)row * 1024 + ch * 8); }
    for (int blk = c; blk < MT / 128; blk += G) {
        if (tid < 64) lcnt[tid] = 0;
        __syncthreads();
        const int t0 = blk * 128 + wid * 16;
        f32x4 a0 = {0.f, 0.f, 0.f, 0.f}, a1 = a0, a2 = a0;
        const bf16_t* ap = xb + (size_t)(t0 + (lane & 15)) * 1024 + 8 * (lane >> 4);
        const LAS unsigned char* bl = wl + (lane & 15) * WRP + 16 * (lane >> 4);
        bf16x8 af[32];
#pragma unroll
        for (int kk = 0; kk < 32; ++kk) af[kk] = *(const bf16x8*)(ap + kk * 32);
#pragma unroll
        for (int kk = 0; kk < 32; ++kk) { const bf16x8 b0 = *(const LAS bf16x8*)(bl + kk * 64), b1 = *(const LAS bf16x8*)(bl + 16 * WRP + kk * 64), b2 = *(const LAS bf16x8*)(bl + 32 * WRP + kk * 64);
            a0 = __builtin_amdgcn_mfma_f32_16x16x32_bf16(af[kk], b0, a0, 0, 0, 0); a1 = __builtin_amdgcn_mfma_f32_16x16x32_bf16(af[kk], b1, a1, 0, 0, 0); a2 = __builtin_amdgcn_mfma_f32_16x16x32_bf16(af[kk], b2, a2, 0, 0, 0); }
#pragma unroll
        for (int r = 0; r < 4; ++r) { const int trow = (lane >> 4) * 4 + r, col = lane & 15; lg[trow * 48 + col] = a0[r]; lg[trow * 48 + 16 + col] = a1[r]; lg[trow * 48 + 32 + col] = a2[r]; }
        asm volatile("s_waitcnt lgkmcnt(0)" ::: "memory");
        if (lane < 16) { const int tok = t0 + lane; const f32x4* sp = (const f32x4*)(ssx + (size_t)tok * 16); const f32x4 s0 = sp[0], s1 = sp[1], s2 = sp[2], s3 = sp[3];
            const float s = (((s0[0] + s0[1]) + (s0[2] + s0[3])) + ((s1[0] + s1[1]) + (s1[2] + s1[3]))) + (((s2[0] + s2[1]) + (s2[2] + s2[3])) + ((s3[0] + s3[1]) + (s3[2] + s3[3])));
            const float rs = __builtin_amdgcn_rsqf(s * (1.0f / 1024.0f) + EPS);
            float gl[4]; int gi = 0; float gm;
#pragma unroll
            for (int q = 0; q < 4; ++q) gl[q] = lg[lane * 48 + q] * rs;
            gm = gl[0];
#pragma unroll
            for (int q = 1; q < 4; ++q) if (gl[q] > gm) { gm = gl[q]; gi = q; }
            float gs = 0.f;
#pragma unroll
            for (int q = 0; q < 4; ++q) gs += expf(gl[q] - gm);
            const float gwt = 1.0f / gs;
            float el[8];
#pragma unroll
            for (int q = 0; q < 8; ++q) el[q] = lg[lane * 48 + 4 + gi * 8 + q] * rs;
            int i0 = 0; float m0 = el[0];
#pragma unroll
            for (int q = 1; q < 8; ++q) if (el[q] > m0) { m0 = el[q]; i0 = q; }
            int i1 = -1; float m1 = -3.0e38f;
#pragma unroll
            for (int q = 0; q < 8; ++q) if (q != i0 && el[q] > m1) { m1 = el[q]; i1 = q; }
            const float e1 = expf(m1 - m0), w0 = gwt / (1.0f + e1), w1 = gwt * e1 / (1.0f + e1);
            const int e0i = gi * 8 + i0, e1i = gi * 8 + i1;
            te[tok * 2] = e0i; te[tok * 2 + 1] = e1i; tw[tok * 2] = w0; tw[tok * 2 + 1] = w1; trs[tok] = rs;
            atomicAdd((int*)&lcnt[e0i], 1); atomicAdd((int*)&lcnt[32 + e1i], 1); }
        __syncthreads();
        if (tid < 64) cnt[blk * 64 + tid] = lcnt[tid];
        __syncthreads();
    }
}

__device__ __forceinline__ void scatter_phase(const Params& P, LAS unsigned char* lds, int G, int c) {
    int tid_ = threadIdx.x; asm volatile("" : "+v"(tid_)); const int tid = tid_;
    const int* te = (const int*)(P.ws + WS_TE); const float* tw = (const float*)(P.ws + WS_TW); const float* trs = (const float*)(P.ws + WS_TRS); const int* cnt = (const int*)(P.ws + WS_CNT);
    int* atok = (int*)(P.ws + WS_ATOK); float* aw = (float*)(P.ws + WS_AW); float* ars = (float*)(P.ws + WS_ARS); int* tseg = (int*)(P.ws + WS_TSEG);
    LAS int* tot = (LAS int*)lds; LAS int* bef = tot + 64; LAS int* base = bef + 64; LAS int* le = base + 65; LAS int* ptot = le + 256; LAS int* pbef = ptot + 512;
    for (int blk = c; blk < MT / 128; blk += G) {
        { const int sg = tid & 63, part = tid >> 6; int t = 0, b = 0;
#pragma unroll 8
          for (int q = part * 32; q < part * 32 + 32; ++q) { const int v = cnt[q * 64 + sg]; t += v; b += (q < blk) ? v : 0; }
          ptot[part * 64 + sg] = t; pbef[part * 64 + sg] = b; }
        if (tid < 256) le[tid] = te[blk * 256 + tid];
        __syncthreads();
        if (tid < 64) { int t = 0, b = 0;
#pragma unroll
            for (int q = 0; q < 8; ++q) { t += ptot[q * 64 + tid]; b += pbef[q * 64 + tid]; }
            tot[tid] = t; bef[tid] = b; }
        __syncthreads();
        if (tid == 0) { int s = 0; for (int q = 0; q < 64; ++q) { base[q] = s; s += (tot[q] + 255) & ~255; } base[64] = s; }
        __syncthreads();
        if (tid < 256) {
            const int i = tid >> 1, k = tid & 1, sg = k * 32 + le[tid]; int rank = 0;
            for (int a = 0; a < tid; ++a) rank += ((a & 1) * 32 + le[a] == sg) ? 1 : 0;
            const int tok = blk * 128 + i, pos = base[sg] + bef[sg] + rank;
            atok[pos] = tok; aw[pos] = tw[tok * 2 + k]; ars[pos] = trs[tok]; }
        if (blk < 64) {
            int neg1 = -1; asm volatile("" : "+v"(neg1));
            for (int r = base[blk] + tot[blk] + tid; r < base[blk + 1]; r += 512) { atok[r] = neg1; aw[r] = 0.f; ars[r] = 0.f; }
            for (int t = (base[blk] >> 8) + tid; t < (base[blk + 1] >> 8); t += 512) tseg[t] = blk;
            if (blk == 0 && tid == 0) { tseg[512] = base[32] >> 8; tseg[513] = base[64] >> 8; } }
        __syncthreads();
    }
}
__constant__ double ROPE_INVF[16] = {1.0, 0.5623413251903491, 0.31622776601683794, 0.1778279410038923, 0.1, 0.05623413251903491, 0.03162277660168379, 0.01778279410038923, 0.01,
                                     0.005623413251903491, 0.0031622776601683794, 0.0017782794100389228, 0.001, 0.0005623413251903491, 0.00031622776601683794, 0.00017782794100389227};
constexpr int PH_PER_LAYER = 11, NPH = 1 + PH_PER_LAYER * DEPTH;

__global__ void __launch_bounds__(512, 2) mk_fwd(Params P_) {
    extern __shared__ __attribute__((aligned(16))) unsigned char lds_raw[];
    LAS unsigned char* lds = (LAS unsigned char*)lds_raw;
    const int G = gridDim.x;
#define WSFENCE const Params P = load_params(); unsigned char* ws = P.ws; int tid_f = threadIdx.x, c_f = blockIdx.x; asm volatile("" : "+v"(tid_f), "+s"(c_f)); \
    const int tid = tid_f, lane = tid & 63, wid = __builtin_amdgcn_readfirstlane(tid >> 6), c = c_f, gw = c * 8 + wid, ngw = G * 8; (void)ws; (void)tid; (void)lane; (void)wid; (void)gw; (void)ngw
    volatile LAS unsigned* MISC = (volatile LAS unsigned*)(lds + MISC_OFF);
    if (threadIdx.x < 64) MISC[threadIdx.x] = 0u;
    __syncthreads();
    XcdBarrier bar; bar.bar = (unsigned*)(P_.ws + WS_CTL); bar.x = 0; bar.st = nullptr;
    const bool multi = (P_.ph_hi - P_.ph_lo) > 1;
    if (multi) bar = xcd_barrier_post((unsigned*)(P_.ws + WS_CTL), MISC + 8);
    LAS int* idxlds = (LAS int*)(lds + IDX_OFF);
    const int lo = P_.ph_lo, hi = P_.ph_hi;
#ifndef PHMASK
#define PHMASK 0x7fff
#endif
#define IN(k) (lo <= (k) && (k) < hi)
#define EN(i) ((PHMASK >> (i)) & 1)
#ifndef REPMASK
#define REPMASK 0
#endif
#define REPS(i) (((REPMASK >> (i)) & 1) ? 2 : 1)
#define SEAM(k) do { if (IN(k) && IN((k) + 1)) xcd_barrier(bar); } while (0)

    if (EN(0) && IN(0)) { WSFENCE;
        LAS float* scr = (LAS float*)(lds + wid * 8448);
        if (!(P.variant & 128)) TR_LOOP(mixw_desc(P, it), gw, 2 * MIXW_ITEMS, ngw);
        router_weights(P, 0, c * 512 + tid, G * 512); router_weights(P, 1, c * 512 + tid, G * 512);
        {
            const int* pos = (const int*)P.in[1]; float* rope = (float*)(ws + WS_ROPE);
            for (int idx = c * 512 + tid; idx < MT * 16; idx += G * 512) { const int tok = idx >> 4, i = idx & 15;
                const double t = (double)pos[tok] * ROPE_INVF[i] * 0.15915494309189535; const float fr = (float)(t - floor(t));
                const float cs = __builtin_amdgcn_cosf(fr), sn = __builtin_amdgcn_sinf(fr); bf16_t* ropeb = (bf16_t*)(ws + WS_ROPEB);
                rope[(size_t)tok * 32 + i] = cs; rope[(size_t)tok * 32 + 16 + i] = sn; ropeb[(size_t)tok * 32 + i] = (bf16_t)f2bf(cs); ropeb[(size_t)tok * 32 + 16 + i] = (bf16_t)f2bf(sn); }
        }
        {
            const float* x = P.in[0]; bf16_t* xb = (bf16_t*)(ws + WS_XB); float* ssx = (float*)(ws + WS_SSX);
            if (!(P.variant & 256)) for (int m = gw; m < MT; m += ngw) { const f32x4* xr = (const f32x4*)(x + (size_t)m * DM) + lane; f32x4 v[4]; float s = 0.f;
#pragma unroll
                for (int j = 0; j < 4; ++j) { v[j] = __builtin_nontemporal_load(xr + 64 * j); s += (v[j][0] * v[j][0] + v[j][1] * v[j][1]) + (v[j][2] * v[j][2] + v[j][3] * v[j][3]); }
                s = wave_sum(s);
                u32x2* o = (u32x2*)(xb + (size_t)m * DM) + lane;
#pragma unroll
                for (int j = 0; j < 4; ++j) { u32x2 w; w.x = cvt_pk_bf16(v[j][0], v[j][1]); w.y = cvt_pk_bf16(v[j][2], v[j][3]); o[64 * j] = w; }
                if (lane < 16) ssx[(size_t)m * 16 + lane] = lane == 0 ? s : 0.f; }
        }
    }
    SEAM(0);

    for (int l = 0; l < DEPTH; ++l) {
        const int pb = 1 + PH_PER_LAYER * l;
        if (EN(1) && IN(pb + 0)) { WSFENCE;
            pg8::Gemm g{(const bf16_t*)(ws + WS_XB), (const bf16_t*)(ws + WS_WMIX + (size_t)l * WMIX_LAYER + WM_IN), 1024, 1024, (P.variant >> 4) & 1}; pg8::StaticOrder S; S.init(MT, NIN, G, c);
            { const int nu = (MT / 256) * (NIN / 256), nshort = G - nu % G, first = nu % G;
              if (nu % G == 0) { for (int t = c; t < SSG * SSM_PARTS; t += G) ssm_tables(P, l, t / SSM_PARTS, t % SSM_PARTS, lds); }
              else if (c >= first) { for (int t = c - first; t < SSG * SSM_PARTS; t += nshort) ssm_tables(P, l, t / SSM_PARTS, t % SSM_PARTS, lds); } }
            EpiIn E{ws};
            pg8::gemm_phase<EpiIn, pg8::StaticOrder>(lds, idxlds, g, S, E);
        }
        SEAM(pb + 0);
        if (EN(2) && IN(pb + 1)) { WSFENCE;
            { pg8::Gemm g{(const bf16_t*)(ws + WS_QC), (const bf16_t*)(ws + WS_WMIX + (size_t)l * WMIX_LAYER + WM_UQ), 384, 384, (P.variant >> 10) & 1}; pg8::StaticOrder S; S.init(MT, 768, G, c);
              EpiPlain E{ws, WS_TQ, 768}; pg8::gemm_phase<EpiPlain, pg8::StaticOrder>(lds, idxlds, g, S, E); }
            { pg8::Gemm g{(const bf16_t*)(ws + WS_KVC), (const bf16_t*)(ws + WS_WMIX + (size_t)l * WMIX_LAYER + WM_UKV), 256, 256, (P.variant >> 11) & 1}; pg8::StaticOrder S; S.init(MT, 1024, G, c);
              LAS float* gkl = (LAS float*)(lds + MISC_OFF + 256);
              if (tid < 96) gkl[tid] = P.in[9][l * 96 + tid];
              __syncthreads();
              EpiKV E{ws, gkl};
              pg8::gemm_phase<EpiKV, pg8::StaticOrder>(lds, idxlds, g, S, E); }
            { pg8::Gemm g{(const bf16_t*)(ws + WS_IN), (const bf16_t*)(ws + WS_WST), 512, KIN, (P.variant >> 12) & 1}; SsmSOrder S{G, c};
              EpiS E{ws}; pg8::gemm_phase<EpiS, SsmSOrder>(lds, idxlds, g, S, E); }
        }
        SEAM(pb + 1);
        if (EN(3) && IN(pb + 2)) { WSFENCE;
            if (wid < 2) for (int t = c * 2 + wid; t < SSG * NB; t += G * 2) ssm_scan_task(P, t, lane);
            const float* gk = P.in[9] + l * 96;
            float gmx = fmaxf(fabsf(gk[lane]), lane < 32 ? fabsf(gk[64 + lane]) : 0.f); gmx = wave_max(gmx);
            const float kbound = 9.797958971132712f * gmx;
            __syncthreads();
            for (int L = c; L < NB * NH * 8; L += G) { const int p = L & 127, k = L >> 7, b = p >> 3, h = p & 7;
                const int qb = (k == 0) ? 7 : (k == 1) ? 6 : (k == 2) ? 0 : (k == 3) ? 1 : (k == 4) ? 5 : (k == 5) ? 4 : (k == 6) ? 2 : 3;
                att::attn_unit((char*)lds_raw, b, h, qb, (const bf16_t*)(ws + WS_TQ), (const float*)(ws + WS_QSS), (const float*)(ws + WS_ROPE), P.in[8] + l * 96, kbound,
                               (const bf16_t*)(ws + WS_KB), (const bf16_t*)(ws + WS_VB), (bf16_t*)(ws + WS_OB), P.variant);
                __syncthreads(); }
        }
        SEAM(pb + 2);
        if (EN(4) && IN(pb + 3)) { WSFENCE;
            { pg8::Gemm g{(const bf16_t*)(ws + WS_IN), (const bf16_t*)(ws + WS_TMAT), KIN, KIN}; SsmYOrder S{G, c};
              EpiY E{ws}; pg8::gemm_phase<EpiY, SsmYOrder>(lds, idxlds, g, S, E); }
            { pg8::Gemm g{(const bf16_t*)(ws + WS_OB), (const bf16_t*)(ws + WS_WMIX + (size_t)l * WMIX_LAYER + WM_PROJ), 512, 512}; pg8::StaticOrder S; S.init(MT, 1024, G, c);
              EpiProj E{ws}; pg8::gemm_phase<EpiProj, pg8::StaticOrder>(lds, idxlds, g, S, E); }
        }
        SEAM(pb + 3);
        if (EN(5) && IN(pb + 4)) { WSFENCE;
            pg8::Gemm g{(const bf16_t*)(ws + WS_YB), (const bf16_t*)(ws + WS_WMIX + (size_t)l * WMIX_LAYER + WM_GLU), 512, 512, (P.variant >> 4) & 1}; pg8::StaticOrder S; S.init(MT, 2048, G, c);
            EpiGlu E{ws}; pg8::gemm_phase<EpiGlu, pg8::StaticOrder>(lds, idxlds, g, S, E);
        }
        SEAM(pb + 4);
        if (EN(6) && IN(pb + 5)) { WSFENCE;
            pg8::Gemm g{(const bf16_t*)(ws + WS_MG), (const bf16_t*)(ws + WS_WMIX + (size_t)l * WMIX_LAYER + WM_OUT), 1024, 1024}; pg8::StaticOrder S; S.init(MT, 1024, G, c);
            EpiOut E{ws}; pg8::gemm_phase<EpiOut, pg8::StaticOrder>(lds, idxlds, g, S, E);
        }
        SEAM(pb + 5);
        if (EN(7) && IN(pb + 6)) { WSFENCE;
            if (!(P.variant & 64)) router_phase(P, l, lds, G, c);
            LAS float* scr = (LAS float*)(lds + 32768 + wid * 8448);
            if (!(P.variant & 32)) TR_LOOP(expw_desc(P, l, it), gw, EXPW_ITEMS, ngw);
        }
        SEAM(pb + 6);
        if (EN(8) && IN(pb + 7)) { WSFENCE; scatter_phase(P, lds, G, c); }
        SEAM(pb + 7);
        if (EN(9) && IN(pb + 8)) { WSFENCE;
            const int* tseg = (const int*)(ws + WS_TSEG); const int ntT = tseg[513];
            pg8::Gemm g{(const bf16_t*)(ws + WS_XB), (const bf16_t*)(ws + WS_WGU), 1024, 1024};
            MoeGatherOrder S; S.tseg = tseg; S.tile0 = 0; S.ntile = ntT; S.NC = 2; S.G = G; S.c = c; S.gidx = (const int*)(ws + WS_ATOK); S.lmax = 2 * G;
            EpiGU E{ws}; pg8::gemm_phase<EpiGU, MoeGatherOrder>(lds, idxlds, g, S, E);
        }
        SEAM(pb + 8);
        if (EN(10) && IN(pb + 9)) { WSFENCE;
            const int* tseg = (const int*)(ws + WS_TSEG); const int ntA = tseg[512], ntT = tseg[513];
            const int nleft = (2 * ntT > 2 * G) ? 2 * ntT - 2 * G : 0;
            if (nleft > 0) { pg8::Gemm g{(const bf16_t*)(ws + WS_XB), (const bf16_t*)(ws + WS_WGU), 1024, 1024};
                MoeGatherOrder S; S.tseg = tseg; S.tile0 = 0; S.ntile = ntT; S.NC = 2; S.G = G; S.c = c; S.gidx = (const int*)(ws + WS_ATOK); S.loff = 2 * G;
                EpiGU E{ws}; pg8::gemm_phase<EpiGU, MoeGatherOrder>(lds, idxlds, g, S, E); }
            pg8::Gemm g{(const bf16_t*)(ws + WS_HH), (const bf16_t*)(ws + WS_WD), 256, 256};
            MoeDownAOrder S; S.tseg = tseg; S.tile0 = 0; S.ntile = ntA; S.NC = 4; S.G = G; S.c = c; S.nbusy = nleft < G ? nleft : G - 1;
            EpiDown<false> E{ws, nullptr}; pg8::gemm_phase<EpiDown<false>, MoeDownAOrder>(lds, idxlds, g, S, E);
        }
        SEAM(pb + 9);
        if (EN(11) && IN(pb + 10)) { WSFENCE;
            const int* tseg = (const int*)(ws + WS_TSEG); const int ntA = tseg[512], ntT = tseg[513];
            pg8::Gemm g{(const bf16_t*)(ws + WS_HH), (const bf16_t*)(ws + WS_WD), 256, 256, (P.variant >> 13) & 1};
            MoeOrder S; S.tseg = tseg; S.tile0 = ntA; S.ntile = ntT - ntA; S.NC = 4; S.G = G; S.c = c;
            EpiDown<true> E{ws, l + 1 == DEPTH ? P.out : nullptr}; pg8::gemm_phase<EpiDown<true>, MoeOrder>(lds, idxlds, g, S, E);
        }
        SEAM(pb + 10);
    }
#undef IN
#undef SEAM
}

#ifndef MK_PER_PHASE
#define MK_PER_PHASE 0
#endif
extern "C" void kernel_launch(void* const* d_in, const int* in_sizes, int n_in, void* d_out, int out_size, void* d_ws, size_t ws_size, hipStream_t stream) {
    static int grid = 0;
    if (grid == 0) {
        if (n_in != 27 || in_sizes[0] != MT * DM || out_size != MT * DM || ws_size < WS_END) {
            fprintf(stderr, "kernel_launch: unexpected shapes: n_in %d in0 %d out %d ws %zu (need %zu)\n", n_in, n_in > 0 ? in_sizes[0] : -1, out_size, ws_size, (size_t)WS_END); grid = -1; return; }
        int dev = 0, cus = 0, per_cu = 0;
        if (hipGetDevice(&dev) != hipSuccess || hipDeviceGetAttribute(&cus, hipDeviceAttributeMultiprocessorCount, dev) != hipSuccess) { grid = -1; return; }
        if (hipFuncSetAttribute((const void*)mk_fwd, hipFuncAttributeMaxDynamicSharedMemorySize, LDS_BYTES) != hipSuccess) { fprintf(stderr, "kernel_launch: hipFuncSetAttribute failed\n"); grid = -1; return; }
        if (hipOccupancyMaxActiveBlocksPerMultiprocessor(&per_cu, (const void*)mk_fwd, 512, LDS_BYTES) != hipSuccess || per_cu < 1)
            fprintf(stderr, "kernel_launch: occupancy query reports %d workgroups per CU\n", per_cu);
        (void)hipGetLastError();
        grid = cus;
    }
    if (grid < 0) return;
    if (hipMemsetAsync((char*)d_ws + WS_CTL, 0, CTL_ZERO_BYTES, stream) != hipSuccess) return;
    Params p{};
    for (int i = 0; i < 27; ++i) p.in[i] = (const float*)d_in[i];
    p.out = (float*)d_out; p.ws = (unsigned char*)d_ws;
#if MK_PER_PHASE
    for (int ph = 0; ph < NPH; ++ph) { p.ph_lo = ph; p.ph_hi = ph + 1; hipLaunchKernelGGL(mk_fwd, dim3(grid), dim3(512), LDS_BYTES, stream, p); }
#else
    p.ph_lo = 0; p.ph_hi = NPH; hipLaunchKernelGGL(mk_fwd, dim3(grid), dim3(512), LDS_BYTES, stream, p);
#endif
#ifdef PROBE_PHASES
    p.out = (float*)((unsigned char*)d_ws + WS_S5G);
#ifdef PROBE_VARIANT
    p.variant = PROBE_VARIANT;
#endif
    for (int l = 0; l < DEPTH; ++l) for (int k = 0; k < PH_PER_LAYER; ++k) if ((PROBE_PHASES >> k) & 1) { p.ph_lo = 1 + PH_PER_LAYER * l + k; p.ph_hi = p.ph_lo + 1; hipLaunchKernelGGL(mk_fwd, dim3(grid), dim3(512), LDS_BYTES, stream, p); }
    if ((PROBE_PHASES >> 14) & 1) { p.ph_lo = 0; p.ph_hi = 1; hipLaunchKernelGGL(mk_fwd, dim3(grid), dim3(512), LDS_BYTES, stream, p); }
#endif
    const hipError_t le = hipPeekAtLastError();
    if (le != hipSuccess) fprintf(stderr, "kernel_launch: launch failed: %s\n", hipGetErrorName(le));
}
```

```cpp
#include <hip/hip_runtime.h>
#include <cstdio>
#include <cstdint>

#define GAS __attribute__((address_space(1)))
#define LAS __attribute__((address_space(3)))
typedef unsigned short bf16_t;
typedef short bf16x8 __attribute__((ext_vector_type(8)));
typedef short s16x4 __attribute__((ext_vector_type(4)));
typedef float f32x4 __attribute__((ext_vector_type(4)));
typedef float f32x2 __attribute__((ext_vector_type(2)));
typedef float f32x16 __attribute__((ext_vector_type(16)));
typedef unsigned u32x4 __attribute__((ext_vector_type(4)));
typedef unsigned u32x2 __attribute__((ext_vector_type(2)));

constexpr int NB = 16, SEQ = 2048, DM = 1024, MT = NB * SEQ, DEPTH = 2;
constexpr int NH = 8, DQK = 96, DV = 64, QL = 384, KVL = 256, DR = 32;
constexpr int SSW = 512, SSG = 32, SSP = 64;
constexpr int LC = 32, NCH = SEQ / LC, KIN = LC * 16 + 128;
constexpr int NIN = 3328;
constexpr int NE = 32, DE = 256;
constexpr float EPS = 1e-6f;
constexpr int MAXTILES = 320, MAXROWS = MAXTILES * 256;

__device__ __forceinline__ unsigned f2bf(float f) { unsigned u = __builtin_bit_cast(unsigned, f); return (u + 0x7fffu + ((u >> 16) & 1u)) >> 16; }
__device__ __forceinline__ unsigned pk2(float lo, float hi) { return f2bf(lo) | (f2bf(hi) << 16); }
__device__ __forceinline__ float bf2f(unsigned short h) { return __builtin_bit_cast(float, (unsigned)h << 16); }
__device__ __forceinline__ float bflo(unsigned w) { return __builtin_bit_cast(float, w << 16); }
__device__ __forceinline__ float bfhi(unsigned w) { return __builtin_bit_cast(float, w & 0xffff0000u); }
__device__ __forceinline__ unsigned cvt_pk_bf16(float lo, float hi) { unsigned r; asm volatile("v_cvt_pk_bf16_f32 %0, %1, %2" : "=v"(r) : "v"(lo), "v"(hi)); return r; }
__device__ __forceinline__ float fast_sigmoid(float v) { return __builtin_amdgcn_rcpf(1.0f + __builtin_amdgcn_exp2f(-1.4426950408889634f * v)); }


__device__ __forceinline__ void swap16(float v, float& a, float& b) { const unsigned u = __builtin_bit_cast(unsigned, v); auto r = __builtin_amdgcn_permlane16_swap(u, u, false, false); const unsigned x = r[0], y = r[1]; a = __builtin_bit_cast(float, x); b = __builtin_bit_cast(float, y); }
__device__ __forceinline__ void swap32(float v, float& a, float& b) { const unsigned u = __builtin_bit_cast(unsigned, v); auto r = __builtin_amdgcn_permlane32_swap(u, u, false, false); const unsigned x = r[0], y = r[1]; a = __builtin_bit_cast(float, x); b = __builtin_bit_cast(float, y); }
__device__ __forceinline__ float sum_x16(float v) { float a, b; swap16(v, a, b); return a + b; }
__device__ __forceinline__ float sum_x32(float v) { float a, b; swap32(v, a, b); return a + b; }
__device__ __forceinline__ float max_x16(float v) { float a, b; swap16(v, a, b); return fmaxf(a, b); }
__device__ __forceinline__ float max_x32(float v) { float a, b; swap32(v, a, b); return fmaxf(a, b); }
__device__ __forceinline__ float from_x32(float v, int lane_hi) { float a, b; swap32(v, a, b); return lane_hi ? a : b; }
template <int CTRL> __device__ __forceinline__ float dpp_f(float v) { const int u = __builtin_bit_cast(int, v); return __builtin_bit_cast(float, __builtin_amdgcn_update_dpp(u, u, CTRL, 0xf, 0xf, false)); }
__device__ __forceinline__ float row_sum16(float v) { v += dpp_f<0xB1>(v); v += dpp_f<0x4E>(v); v += dpp_f<0x124>(v); v += dpp_f<0x128>(v); return v; }
__device__ __forceinline__ float row_max16(float v) { v = fmaxf(v, dpp_f<0xB1>(v)); v = fmaxf(v, dpp_f<0x4E>(v)); v = fmaxf(v, dpp_f<0x124>(v)); v = fmaxf(v, dpp_f<0x128>(v)); return v; }

namespace pg8 {
constexpr int BM = 256, BK = 64, HALF = 128, HTB = HALF * BK * 2, STAGE_BYTES = 8 * HTB, NXCD = 8, WGM = 8;
__host__ __device__ __forceinline__ int lds_byte(int r, int c) { const int st = (r >> 4) * 2 + (c >> 5), rr = r & 15, cc = c & 31, ob = rr * 64 + cc * 2; return st * 1024 + (ob ^ (((ob >> 9) & 1) << 5)); }
__host__ __device__ __forceinline__ void stage_rc(int b, int& R, int& C) { const int st = b / 1024, sb = b % 1024, swz = sb ^ (((sb >> 9) & 1) << 5); R = (st >> 1) * 16 + swz / 64; C = (st & 1) * 32 + (swz % 64) / 2; }
__host__ __device__ __forceinline__ int perm32(int rho) { const int n = rho >> 4, i = rho & 15; return 8 * (i >> 2) + 4 * n + (i & 3); }

struct Unit { int pm, pn; };
struct Gemm { const bf16_t* A; const bf16_t* Bt; int K; int lda; int flags = 0; };

struct StaticOrder {
    static constexpr bool GATHER = false;
    int nM, nN, nwg, G, c;
    __device__ void init(int M, int N, int G_, int c_) { nM = M / BM; nN = N / BM; nwg = nM * nN; G = G_; c = c_; }
    __device__ bool next(int i, Unit& u) const {
        const long L = (long)i * G + c; if (L >= nwg) return false;
        int wgid = (int)L; { const int q = nwg / NXCD, r = nwg % NXCD, xcd = wgid % NXCD, off = wgid / NXCD; wgid = (xcd < r ? xcd * (q + 1) : r * (q + 1) + (xcd - r) * q) + off; }
        const int nig = WGM * nN, gid = wgid / nig, fm = gid * WGM, gsz = (nM - fm) < WGM ? (nM - fm) : WGM;
        u.pm = fm + ((wgid % nig) % gsz); u.pn = (wgid % nig) / gsz; return true;
    }
};

#ifdef PROBE_NOEPI
#define PG8_PROBE_SKIP && (*(const int __attribute__((address_space(4)))*)((const char __attribute__((address_space(4)))*)__builtin_amdgcn_kernarg_segment_ptr() + 232) == 0)
#else
#define PG8_PROBE_SKIP
#endif
template <class Epi, class Sched>
__device__ __forceinline__ void gemm_phase(LAS unsigned char* lds, LAS int* idxlds, const Gemm g, const Sched& S, const Epi& E) {
    int tid_ = threadIdx.x; asm volatile("" : "+v"(tid_));
    const int tid = tid_, wid = __builtin_amdgcn_readfirstlane(tid >> 6), lane = tid & 63, wr = wid >> 2, wc = wid & 3, fr = lane & 15, fq = lane >> 4;
    const int K = g.K, nt = K / BK, lda = g.lda;
    unsigned voffB[2], vA[2][2], vAn[2][2];
#pragma unroll
    for (int i = 0; i < 2; ++i) { int R, C; stage_rc(tid * 16 + i * 8192, R, C);
        const int Rb = Epi::PERM ? (64 * (R >> 5) + perm32(R & 31)) : R; voffB[i] = (unsigned)(Rb * K + C) * 2u;
        vA[0][i] = (unsigned)(R * lda + C) * 2u; vA[1][i] = vA[0][i]; vAn[0][i] = vA[0][i]; vAn[1][i] = vA[0][i]; }
    const unsigned kstep = (unsigned)(BK * 2);
    const unsigned hstepB = (unsigned)(Epi::PERM ? 32 : HALF) * K * 2, tstepB = (unsigned)(2 * HALF) * K * 2;
    const unsigned hstepA = Sched::GATHER ? 0u : (unsigned)HALF * lda * 2, tstepA = Sched::GATHER ? 0u : (unsigned)BM * lda * 2;
    const unsigned ldsw = (unsigned)wid * 1024u;
    const int aoff = lds_byte(wr * 64 + fr, fq * 8), boff = lds_byte(wc * 32 + fr, fq * 8);
#define PG8_SA(b, h) (((b) * 2 + (h)) * HTB)
#define PG8_SB(b, h) ((4 + (b) * 2 + (h)) * HTB)
#define PG8_STAGE(bufoff, gbase, voff) do { const char* gb_ = (const char*)(gbase); asm volatile("" : "+s"(gb_));   \
        _Pragma("unroll") for (int _i = 0; _i < 2; ++_i) \
        __builtin_amdgcn_global_load_lds((const unsigned*)(gb_ + (voff)[_i]), (LAS unsigned*)(lds + (bufoff) + ldsw + _i * 8192), 16, 0, 0); } while (0)
#define PG8_STAGE_A(bufoff, gbase, h, NXT) do { if constexpr (Sched::GATHER) { if (NXT) PG8_STAGE(bufoff, gbase, vAn[h]); else PG8_STAGE(bufoff, gbase, vA[h]); } \
        else PG8_STAGE(bufoff, (gbase) + (h) * hstepA, vA[0]); } while (0)
#define PG8_LDA(dst, b, h) do { _Pragma("unroll") for (int m = 0; m < 4; ++m) _Pragma("unroll") for (int k = 0; k < 2; ++k) dst[m][k] = *(const LAS bf16x8*)(lds + PG8_SA(b, h) + aoff + m * 2048 + k * 1024); } while (0)
#define PG8_LDB(dst, b, h) do { _Pragma("unroll") for (int n = 0; n < 2; ++n) _Pragma("unroll") for (int k = 0; k < 2; ++k) dst[n][k] = *(const LAS bf16x8*)(lds + PG8_SB(b, h) + boff + n * 2048 + k * 1024); } while (0)
#define PG8_MMA(ai, bj, At, Bt) do { __builtin_amdgcn_s_setprio(1); _Pragma("unroll") for (int m = 0; m < 4; ++m) _Pragma("unroll") for (int n = 0; n < 2; ++n) _Pragma("unroll") for (int k = 0; k < 2; ++k) \
        acc[ai][bj][m][n] = __builtin_amdgcn_mfma_f32_16x16x32_bf16(Bt[n][k], At[m][k], acc[ai][bj][m][n], 0, 0, 0); __builtin_amdgcn_s_setprio(0); } while (0)
#define PG8_WAIT_V(n) asm volatile("s_waitcnt vmcnt(" #n ")" ::: "memory")
#define PG8_WAIT_L(n) asm volatile("s_waitcnt lgkmcnt(" #n ")" ::: "memory")
#define PG8_BAR __builtin_amdgcn_s_barrier()
#define PG8_SCHED __builtin_amdgcn_sched_barrier(0)
#define PG8_GOFF(dst, ui_) do { _Pragma("unroll") for (int _i = 0; _i < 2; ++_i) { int _R, _C; stage_rc(tid * 16 + _i * 8192, _R, _C); _Pragma("unroll") for (int _h = 0; _h < 2; ++_h) \
        dst[_h][_i] = (unsigned)(idxlds[(ui_) * 256 + _h * 128 + _R] * lda + _C) * 2u; } } while (0)
    Unit cur, nxt; int ui = 0;
    if (!S.next(0, cur)) return;
    if constexpr (Sched::GATHER) {
        for (int i = 0; i < 4; ++i) { Unit u; if (!S.next(i, u)) break; if (tid < 256) { const int t = S.gidx[u.pm * 256 + tid]; idxlds[i * 256 + tid] = t < 0 ? 0 : t; } }
        asm volatile("s_waitcnt vmcnt(0) lgkmcnt(0)" ::: "memory"); __builtin_amdgcn_s_barrier(); asm volatile("" ::: "memory");
        PG8_GOFF(vA, 0);
    }
    f32x4 acc[2][2][4][2];
#pragma unroll
    for (int a = 0; a < 2; ++a)
#pragma unroll
        for (int b = 0; b < 2; ++b)
#pragma unroll
            for (int m = 0; m < 4; ++m)
#pragma unroll
                for (int n = 0; n < 2; ++n) acc[a][b][m][n] = (f32x4){0.f, 0.f, 0.f, 0.f};
    bf16x8 At[4][2], B0[2][2], B1[2][2];
    const char* cA = (const char*)g.A + (size_t)cur.pm * (size_t)tstepA; const char* cB = (const char*)g.Bt + (size_t)cur.pn * (size_t)tstepB;
    PG8_STAGE(PG8_SB(0, 0), cB, voffB); PG8_STAGE(PG8_SB(0, 1), cB + hstepB, voffB); PG8_STAGE_A(PG8_SA(0, 0), cA, 0, false); PG8_STAGE_A(PG8_SA(0, 1), cA, 1, false);
    if (wr == 1) PG8_BAR;
    PG8_WAIT_V(2); PG8_BAR;
    PG8_STAGE(PG8_SB(1, 0), cB + kstep, voffB); PG8_STAGE_A(PG8_SA(1, 0), cA + kstep, 0, false); PG8_STAGE(PG8_SB(1, 1), cB + hstepB + kstep, voffB);
    PG8_WAIT_V(6); PG8_BAR;
    for (;;) {
        const bool has_next = S.next(ui + 1, nxt);
        const char* nA = has_next ? (const char*)g.A + (size_t)nxt.pm * (size_t)tstepA : cA; const char* nB = has_next ? (const char*)g.Bt + (size_t)nxt.pn * (size_t)tstepB : cB;
        for (int t = 0; t < nt; t += 2) {
            const bool last = (t == nt - 2);
            const char* a1 = cA + (size_t)(t + 1) * kstep;
            const char* a2 = last ? nA : cA + (size_t)(t + 2) * kstep; const char* b2 = last ? nB : cB + (size_t)(t + 2) * kstep;
            const char* a3 = a2 + kstep; const char* b3 = b2 + kstep;
            if constexpr (Sched::GATHER) { if (last) { if (has_next) PG8_GOFF(vAn, ui + 1); else {
#pragma unroll
                for (int h = 0; h < 2; ++h) { vAn[h][0] = vA[h][0]; vAn[h][1] = vA[h][1]; } } } }
            PG8_LDB(B0, 0, 0); PG8_LDB(B1, 0, 1); PG8_SCHED; PG8_LDA(At, 0, 0); PG8_STAGE_A(PG8_SA(1, 1), a1, 1, false);
            PG8_WAIT_V(8); PG8_WAIT_L(0); PG8_BAR; PG8_MMA(0, 0, At, B0); PG8_MMA(0, 1, At, B1); PG8_BAR; PG8_SCHED;
            PG8_LDA(At, 0, 1); PG8_STAGE(PG8_SB(0, 0), b2, voffB); PG8_STAGE(PG8_SB(0, 1), b2 + hstepB, voffB); PG8_STAGE_A(PG8_SA(0, 0), a2, 0, last);
            PG8_WAIT_V(8); PG8_WAIT_L(0); PG8_BAR; PG8_MMA(1, 0, At, B0); PG8_MMA(1, 1, At, B1); PG8_BAR; PG8_SCHED;
            PG8_LDB(B0, 1, 0); PG8_LDB(B1, 1, 1); PG8_SCHED; PG8_LDA(At, 1, 0); PG8_STAGE_A(PG8_SA(0, 1), a2, 1, last);
            PG8_WAIT_V(8); PG8_WAIT_L(0); PG8_BAR; PG8_MMA(0, 0, At, B0); PG8_MMA(0, 1, At, B1); PG8_BAR; PG8_SCHED;
            PG8_LDA(At, 1, 1); PG8_STAGE(PG8_SB(1, 0), b3, voffB); PG8_STAGE(PG8_SB(1, 1), b3 + hstepB, voffB); PG8_STAGE_A(PG8_SA(1, 0), a3, 0, last);
            PG8_WAIT_V(8); PG8_WAIT_L(0); PG8_BAR; PG8_MMA(1, 0, At, B0); PG8_MMA(1, 1, At, B1); PG8_BAR; PG8_SCHED;
        }
        if (wr == 0) PG8_BAR;
        if (!(g.flags & 1) PG8_PROBE_SKIP) { int te = threadIdx.x; asm volatile("" : "+v"(te)); const int le = te & 63; E(acc, cur, wr, wc, le & 15, le >> 4); }
        if (!has_next) break;
#pragma unroll
        for (int a = 0; a < 2; ++a)
#pragma unroll
            for (int b = 0; b < 2; ++b)
#pragma unroll
                for (int m = 0; m < 4; ++m)
#pragma unroll
                    for (int n = 0; n < 2; ++n) acc[a][b][m][n] = (f32x4){0.f, 0.f, 0.f, 0.f};
        cur = nxt; cA = nA; cB = nB; ++ui;
        if constexpr (Sched::GATHER) {
#pragma unroll
            for (int h = 0; h < 2; ++h) { vA[h][0] = vAn[h][0]; vA[h][1] = vAn[h][1]; } }
        if (wr == 1) PG8_BAR;
    }
    PG8_WAIT_V(0);
    PG8_BAR;
#undef PG8_SA
#undef PG8_SB
#undef PG8_STAGE
#undef PG8_STAGE_A
#undef PG8_LDA
#undef PG8_LDB
#undef PG8_MMA
#undef PG8_WAIT_V
#undef PG8_WAIT_L
#undef PG8_BAR
#undef PG8_SCHED
#undef PG8_GOFF
}
}

#define XB_TMO      128
#define XB_XCNT(j)  (256  + 64 * (j))
#define XB_XSUB(j)  (1280 + 64 * (j))
#define XB_XGEN(j)  (2304 + 64 * (j))
#define XB_TOP      3328
#define XB_TOPGEN   3392
#define XCD_BAR_WORDS 3456
#define XB_SPIN_CAP (1u << 18)
__device__ __forceinline__ unsigned xb_ld(unsigned* p)              { return __hip_atomic_load(p, __ATOMIC_RELAXED, __HIP_MEMORY_SCOPE_AGENT); }
__device__ __forceinline__ unsigned xb_add(unsigned* p, unsigned v) { return __hip_atomic_fetch_add(p, v, __ATOMIC_RELAXED, __HIP_MEMORY_SCOPE_AGENT); }
__device__ __forceinline__ unsigned xb_xcc_id() { return (unsigned)__builtin_amdgcn_s_getreg((3 << 11) | 20) & 0xFu; }
#define XB_SPIN(cond, bar) do { unsigned _sp = 0; while (cond) { __builtin_amdgcn_s_sleep(1); \
    if ((++_sp & 255u) == 0u) { if (xb_ld(&(bar)[XB_TMO])) break; if (_sp > XB_SPIN_CAP) { atomicAdd(&(bar)[XB_TMO], 1u); break; } } } } while (0)
struct XcdBarrier { unsigned* bar; unsigned x; volatile LAS unsigned* st; };
__device__ __forceinline__ XcdBarrier xcd_barrier_post(unsigned* bar, volatile LAS unsigned* st) {
    XcdBarrier b; b.bar = bar; b.x = xb_xcc_id(); b.st = st;
    if (threadIdx.x == 0) (void)xb_add(&bar[XB_XCNT(b.x)], 1u);
    return b;
}
__device__ __forceinline__ void xcd_barrier_complete(unsigned* bar, unsigned x, unsigned& nloc, unsigned& nx) {
    const unsigned G = gridDim.x * gridDim.y * gridDim.z;
    unsigned sum, cnt, mine, sp = 0u;
    for (;;) {
        sum = 0u; cnt = 0u; mine = 0u;
#pragma unroll
        for (unsigned j = 0; j < 16; ++j) { const unsigned c = xb_ld(&bar[XB_XCNT(j)]); sum += c; cnt += (c > 0u) ? 1u : 0u; mine = (j == x) ? c : mine; }
        if (sum == G) break;
        __builtin_amdgcn_s_sleep(1);
        if ((++sp & 255u) == 0u) { if (xb_ld(&bar[XB_TMO])) break; if (sp > XB_SPIN_CAP) { atomicAdd(&bar[XB_TMO], 1u); break; } }
    }
    nloc = mine > 0u ? mine : 1u; nx = cnt > 0u ? cnt : 1u;
}
__device__ __forceinline__ void xcd_barrier(const XcdBarrier& b) {
    asm volatile("s_waitcnt vmcnt(0)" ::: "memory");
    __syncthreads();
    if (threadIdx.x == 0) {
        unsigned* bar = b.bar; unsigned bx = b.x;
        asm volatile("" : "+s"(bar), "+s"(bx));
        __builtin_amdgcn_s_waitcnt(0);
        unsigned nloc = b.st[0], nx = b.st[1];
        if (nloc == 0u) { xcd_barrier_complete(bar, bx, nloc, nx); b.st[0] = nloc; b.st[1] = nx; }
        const unsigned old = xb_add(&bar[XB_XSUB(bx)], 1u);
        const unsigned gen = old / nloc;
        if (old + 1u == (gen + 1u) * nloc) {
            __builtin_amdgcn_fence(__ATOMIC_RELEASE, "agent");
            asm volatile("s_waitcnt vmcnt(0)" ::: "memory");
            const unsigned og = xb_add(&bar[XB_TOP], 1u);
            const unsigned tg = og / nx;
            if (og + 1u == (tg + 1u) * nx) xb_add(&bar[XB_TOPGEN], 1u);
            else XB_SPIN(xb_ld(&bar[XB_TOPGEN]) == tg, bar);
            __builtin_amdgcn_fence(__ATOMIC_ACQUIRE, "agent");
            xb_add(&bar[XB_XGEN(bx)], 1u);
            asm volatile("s_waitcnt vmcnt(0)" ::: "memory");
        } else {
            XB_SPIN(xb_ld(&bar[XB_XGEN(bx)]) == gen, bar);
            __builtin_amdgcn_fence(__ATOMIC_ACQUIRE, "agent");
            asm volatile("s_waitcnt vmcnt(0)" ::: "memory");
        }
    }
    __syncthreads();
}
constexpr size_t MiB = 1u << 20;
constexpr size_t WS_CTL = 0, CTL_ZERO_BYTES = 64 * 1024;
constexpr size_t WS_SSX  = 1 * MiB;
constexpr size_t WS_KVSS = 3 * MiB;
constexpr size_t WS_QSS  = WS_KVSS + 512 * 1024;
constexpr size_t WS_KRSS = WS_QSS + 1 * MiB;
constexpr size_t WS_TE   = WS_KRSS + 128 * 1024;
constexpr size_t WS_TW   = WS_TE + 256 * 1024;
constexpr size_t WS_TRS  = WS_TW + 256 * 1024;
constexpr size_t WS_CNT  = WS_TRS + 128 * 1024;
constexpr size_t WS_ATOK = WS_CNT + 64 * 1024;
constexpr size_t WS_AW   = WS_ATOK + 320 * 1024;
constexpr size_t WS_ARS  = WS_AW + 320 * 1024;
constexpr size_t WS_TSEG = WS_ARS + 320 * 1024;
constexpr size_t WS_LAM  = WS_TSEG + 4096;
constexpr size_t WS_ROPE = 8 * MiB;
constexpr size_t WS_ROPEB = 12 * MiB;
constexpr size_t WS_WMIX = 16 * MiB, WMIX_LAYER = 13 * MiB;
constexpr size_t WM_IN = 0, WM_UQ = WM_IN + (size_t)NIN * 1024 * 2, WM_UKV = WM_UQ + 768 * 384 * 2, WM_PROJ = WM_UKV + 1024 * 256 * 2, WM_GLU = WM_PROJ + 1024 * 512 * 2,
                 WM_OUT = WM_GLU + 2048 * 512 * 2, WM_R = WM_OUT + 1024 * 1024 * 2, WM_END = WM_R + 48 * 1024 * 2;
static_assert(WM_END <= WMIX_LAYER, "mixer weights");
constexpr size_t WS_TMAT = 42 * MiB;
constexpr size_t WS_WST  = 62 * MiB;
constexpr size_t WS_XB   = 70 * MiB;
constexpr size_t WS_IN   = 134 * MiB;
constexpr size_t WS_OB   = 174 * MiB;
constexpr size_t WS_YB   = 206 * MiB;
constexpr size_t WS_SST  = 222 * MiB;
constexpr size_t WS_KVC  = 174 * MiB, WS_QC = 190 * MiB, WS_KR = 214 * MiB;
constexpr size_t WS_HH   = 174 * MiB;
constexpr size_t WS_TQ   = 238 * MiB, WS_KB = 286 * MiB, WS_VB = 334 * MiB;
constexpr size_t WS_S5G  = 238 * MiB, WS_MG = 302 * MiB;
constexpr size_t WS_GT   = 366 * MiB;
constexpr size_t WS_WGU  = 366 * MiB, WS_WD = 398 * MiB;
constexpr size_t WS_END  = 494 * MiB;

constexpr int RING_BYTES = 131072, IDX_OFF = RING_BYTES, MISC_OFF = IDX_OFF + 4096, LDS_BYTES = 147456;
static_assert(MISC_OFF + 256 <= LDS_BYTES, "LDS map");

struct Params {
    const float* in[27];
    float* out; unsigned char* ws;
    int ph_lo, ph_hi, variant, pad_;
};
__device__ __forceinline__ Params load_params() {
    typedef const __attribute__((address_space(4))) Params* KP;
    KP ka = (KP)__builtin_amdgcn_kernarg_segment_ptr();
    asm volatile("" : "+s"(ka));
    Params p;
#pragma unroll
    for (int i = 0; i < 27; ++i) p.in[i] = ka->in[i];
    p.out = ka->out; p.ws = ka->ws; p.ph_lo = ka->ph_lo; p.ph_hi = ka->ph_hi; p.variant = ka->variant; p.pad_ = 0;
    return p;
}

__device__ __forceinline__ float row_rstd16(const GAS float* ss, int row, int fq, float inv_n) {
    const f32x4 v = *(const GAS f32x4*)(ss + (size_t)row * 16 + 4 * fq);
    float s = (v[0] + v[1]) + (v[2] + v[3]);
    s = sum_x16(s); s = sum_x32(s);
    return __builtin_amdgcn_rsqf(s * inv_n + EPS);
}
__device__ __forceinline__ float sumsq16(const f32x4& a, const f32x4& b, const f32x4& c, const f32x4& d) {
    return ((a[0]*a[0] + a[1]*a[1]) + (a[2]*a[2] + a[3]*a[3])) + ((b[0]*b[0] + b[1]*b[1]) + (b[2]*b[2] + b[3]*b[3])) + ((c[0]*c[0] + c[1]*c[1]) + (c[2]*c[2] + c[3]*c[3])) + ((d[0]*d[0] + d[1]*d[1]) + (d[2]*d[2] + d[3]*d[3]));
}
__device__ __forceinline__ u32x4 pack8(const f32x4& a, const f32x4& b) { u32x4 w; w.x = cvt_pk_bf16(a[0], a[1]); w.y = cvt_pk_bf16(a[2], a[3]); w.z = cvt_pk_bf16(b[0], b[1]); w.w = cvt_pk_bf16(b[2], b[3]); return w; }

__device__ __forceinline__ unsigned pack4_u8(const f32x4& v) {
    const unsigned a = (unsigned)(v[0] * 255.0f + 0.5f), b = (unsigned)(v[1] * 255.0f + 0.5f), c = (unsigned)(v[2] * 255.0f + 0.5f), d = (unsigned)(v[3] * 255.0f + 0.5f);
    return a | (b << 8) | (c << 16) | (d << 24);
}
__device__ __forceinline__ f32x4 unpack4_u8(unsigned w) { return (f32x4){(float)(w & 0xffu), (float)((w >> 8) & 0xffu), (float)((w >> 16) & 0xffu), (float)(w >> 24)} * (1.0f / 255.0f); }

using pg8::Unit;
typedef f32x4 Acc[2][2][4][2];

#define ROWS8(ai, m) _Pragma("unroll") for (int ai = 0; ai < 2; ++ai) _Pragma("unroll") for (int m = 0; m < 4; ++m)
#define EPI_ROW(u, ai, m) ((u).pm * 256 + (ai) * 128 + wr * 64 + (m) * 16 + fr)

struct EpiIn {
    static constexpr bool PERM = true;
    unsigned char* ws;
    __device__ __forceinline__ void operator()(const Acc& acc, const Unit& u, int wr, int wc, int fr, int fq) const {
        GAS unsigned char* w = (GAS unsigned char*)ws; asm volatile("" : "+s"(w));
        const GAS float* ssx = (const GAS float*)(w + WS_SSX); GAS unsigned char* gt = (GAS unsigned char*)(w + WS_GT); GAS bf16_t* inb = (GAS bf16_t*)(w + WS_IN); GAS bf16_t* kvc = (GAS bf16_t*)(w + WS_KVC); GAS bf16_t* qc = (GAS bf16_t*)(w + WS_QC);
        GAS bf16_t* kr = (GAS bf16_t*)(w + WS_KR); GAS float* kvss = (GAS float*)(w + WS_KVSS); GAS float* qss = (GAS float*)(w + WS_QSS); GAS float* krss = (GAS float*)(w + WS_KRSS);
        const int pn = u.pn;
        f32x4 sv[2][4];
        ROWS8(ai, m) sv[ai][m] = *(const GAS f32x4*)(ssx + (size_t)EPI_ROW(u, ai, m) * 16 + 4 * fq);
        ROWS8(ai, m) {
                const int row = EPI_ROW(u, ai, m);
                float st = (sv[ai][m][0] + sv[ai][m][1]) + (sv[ai][m][2] + sv[ai][m][3]); st = sum_x16(st); st = sum_x32(st);
                const float rs = __builtin_amdgcn_rsqf(st * (1.0f / 1024.0f) + EPS);
                f32x4 v00 = acc[ai][0][m][0] * rs, v01 = acc[ai][0][m][1] * rs, v10 = acc[ai][1][m][0] * rs, v11 = acc[ai][1][m][1] * rs;
                if (pn < 8) {
#pragma unroll
                    for (int j = 0; j < 4; ++j) { v00[j] = fast_sigmoid(v00[j]); v01[j] = fast_sigmoid(v01[j]); v10[j] = fast_sigmoid(v10[j]); v11[j] = fast_sigmoid(v11[j]); }
                    GAS unsigned char* p = gt + (size_t)row * 2048 + pn * 256 + wc * 64 + 8 * fq;
                    *(GAS u32x2*)p = (u32x2){pack4_u8(v00), pack4_u8(v01)}; *(GAS u32x2*)(p + 32) = (u32x2){pack4_u8(v10), pack4_u8(v11)};
                } else if (pn < 10) {
                    const int b = row >> 11, ts = row & 2047, c = ts >> 5, s = ts & 31;
#pragma unroll
                    for (int bj = 0; bj < 2; ++bj) { const int cu = (pn - 8) * 256 + wc * 64 + bj * 32 + 8 * fq, g = cu >> 4, j0 = cu & 15;
                        GAS bf16_t* p = inb + ((size_t)(g * 1024 + b * 64 + c) * KIN + s * 16 + j0);
                        *(GAS u32x4*)p = bj ? pack8(v10, v11) : pack8(v00, v01); }
                } else if (pn == 10) {
                    GAS bf16_t* p = kvc + (size_t)row * 256 + wc * 64 + 8 * fq;
                    *(GAS u32x4*)p = pack8(v00, v01); *(GAS u32x4*)(p + 32) = pack8(v10, v11);
                    float s = sumsq16(v00, v01, v10, v11); s = sum_x16(s); s = sum_x32(s);
                    if (fq == 0) kvss[(size_t)row * 4 + wc] = s;
                } else if (pn == 11) {
                    GAS bf16_t* p = qc + (size_t)row * 384 + wc * 64 + 8 * fq;
                    *(GAS u32x4*)p = pack8(v00, v01); *(GAS u32x4*)(p + 32) = pack8(v10, v11);
                    float s = sumsq16(v00, v01, v10, v11); s = sum_x16(s); s = sum_x32(s);
                    if (fq == 0) qss[(size_t)row * 8 + wc] = s;
                } else {
                    const f32x4 z = (f32x4){0.f, 0.f, 0.f, 0.f};
                    if (wc < 2) {
                        GAS bf16_t* p = qc + (size_t)row * 384 + 256 + wc * 64 + 8 * fq;
                        *(GAS u32x4*)p = pack8(v00, v01); *(GAS u32x4*)(p + 32) = pack8(v10, v11);
                        float s = sumsq16(v00, v01, v10, v11); s = sum_x16(s); s = sum_x32(s);
                        if (fq == 0) qss[(size_t)row * 8 + 4 + wc] = s;
                    } else {
                        if (fq == 0) qss[(size_t)row * 8 + 4 + wc] = 0.f;
                        if (wc == 2) { float s2 = sumsq16(v00, v01, z, z); s2 = sum_x16(s2); s2 = sum_x32(s2);
                            *(GAS u32x4*)(kr + (size_t)row * 32 + 8 * fq) = pack8(v00, v01); if (fq == 0) krss[row] = s2; }
                    }
                }
                asm volatile("" ::: "memory");
            }
    }
};

struct EpiPlain {
    static constexpr bool PERM = true;
    unsigned char* ws; size_t off; int ldc;
    __device__ __forceinline__ void operator()(const Acc& acc, const Unit& u, int wr, int wc, int fr, int fq) const {
        GAS unsigned char* w = (GAS unsigned char*)ws; asm volatile("" : "+s"(w)); GAS bf16_t* o = (GAS bf16_t*)(w + off);
        ROWS8(ai, m) {
                const int row = EPI_ROW(u, ai, m);
                GAS bf16_t* p = o + (size_t)row * ldc + u.pn * 256 + wc * 64 + 8 * fq;
                *(GAS u32x4*)p = pack8(acc[ai][0][m][0], acc[ai][0][m][1]); *(GAS u32x4*)(p + 32) = pack8(acc[ai][1][m][0], acc[ai][1][m][1]);
                asm volatile("" ::: "memory");
            }
    }
};

struct EpiKV {
    static constexpr bool PERM = true;
    unsigned char* ws; LAS const float* gkl;
    __device__ __forceinline__ void operator()(const Acc& acc, const Unit& u, int wr, int wc, int fr, int fq) const {
        GAS unsigned char* w = (GAS unsigned char*)ws; asm volatile("" : "+s"(w));
        const GAS float* kvss = (const GAS float*)(w + WS_KVSS); const GAS float* krss = (const GAS float*)(w + WS_KRSS); const GAS bf16_t* kr = (const GAS bf16_t*)(w + WS_KR); const GAS bf16_t* ropeb = (const GAS bf16_t*)(w + WS_ROPEB);
        GAS bf16_t* kb = (GAS bf16_t*)(w + WS_KB); GAS bf16_t* vb = (GAS bf16_t*)(w + WS_VB);
        const int pn = u.pn;
        if (pn < 2) {
            const int h = pn * 4 + wc, i0 = 8 * (fq & 1);
#pragma unroll
            for (int ai = 0; ai < 2; ++ai) {
                float kq[4], krs[4]; u32x4 kA[4], kB[4], cw4[4], sw4[4];
#pragma unroll
                for (int m = 0; m < 4; ++m) { const int row = EPI_ROW(u, ai, m); kq[m] = kvss[(size_t)row * 4 + fq]; krs[m] = krss[row];
                    const GAS bf16_t* kp0 = kr + (size_t)row * 32 + i0; kA[m] = *(const GAS u32x4*)kp0; kB[m] = *(const GAS u32x4*)(kp0 + 16);
                    const GAS bf16_t* rp = ropeb + (size_t)row * 32 + i0; cw4[m] = *(const GAS u32x4*)rp; sw4[m] = *(const GAS u32x4*)(rp + 16); }
#pragma unroll
                for (int m = 0; m < 4; ++m) {
                    const int row = EPI_ROW(u, ai, m);
                    float ks = kq[m]; ks = sum_x16(ks); ks = sum_x32(ks);
                    const float rkv = __builtin_amdgcn_rsqf(ks * (1.0f / 256.0f) + EPS);
                    f32x4 v00 = acc[ai][0][m][0] * rkv, v01 = acc[ai][0][m][1] * rkv, v10 = acc[ai][1][m][0] * rkv, v11 = acc[ai][1][m][1] * rkv;
                    float s = sumsq16(v00, v01, v10, v11); s = sum_x16(s); s = sum_x32(s);
                    const float rk = __builtin_amdgcn_rsqf((s + krs[m]) * (1.0f / 96.0f) + EPS);
                    const int b = row >> 11, sq = row & 2047;
                    GAS bf16_t* kp = kb + ((size_t)((b * NH + h) * SEQ + sq)) * 96;
                    { const f32x4 g0a = *(LAS const f32x4*)(gkl + 8 * fq), g0b = *(LAS const f32x4*)(gkl + 8 * fq + 4);
                      *(GAS u32x4*)(kp + 8 * fq) = pack8(v00 * g0a * rk, v01 * g0b * rk); }
                    { const f32x4 g1a = *(LAS const f32x4*)(gkl + 32 + 8 * fq), g1b = *(LAS const f32x4*)(gkl + 32 + 8 * fq + 4);
                      *(GAS u32x4*)(kp + 32 + 8 * fq) = pack8(v10 * g1a * rk, v11 * g1b * rk); }
                    asm volatile("" ::: "memory");
                    const f32x4 gAa = *(LAS const f32x4*)(gkl + 64 + i0), gAb = *(LAS const f32x4*)(gkl + 64 + i0 + 4), gBa = *(LAS const f32x4*)(gkl + 80 + i0), gBb = *(LAS const f32x4*)(gkl + 80 + i0 + 4);
                    const u32x4 a4 = kA[m], b4 = kB[m], cq = cw4[m], sq4 = sw4[m];
                    const f32x4 xAa = (f32x4){bflo(a4.x), bfhi(a4.x), bflo(a4.y), bfhi(a4.y)} * gAa * rk, xAb = (f32x4){bflo(a4.z), bfhi(a4.z), bflo(a4.w), bfhi(a4.w)} * gAb * rk;
                    const f32x4 xBa = (f32x4){bflo(b4.x), bfhi(b4.x), bflo(b4.y), bfhi(b4.y)} * gBa * rk, xBb = (f32x4){bflo(b4.z), bfhi(b4.z), bflo(b4.w), bfhi(b4.w)} * gBb * rk;
                    const f32x4 ca = (f32x4){bflo(cq.x), bfhi(cq.x), bflo(cq.y), bfhi(cq.y)}, cb = (f32x4){bflo(cq.z), bfhi(cq.z), bflo(cq.w), bfhi(cq.w)};
                    const f32x4 sa = (f32x4){bflo(sq4.x), bfhi(sq4.x), bflo(sq4.y), bfhi(sq4.y)}, sb = (f32x4){bflo(sq4.z), bfhi(sq4.z), bflo(sq4.w), bfhi(sq4.w)};
                    f32x4 oa, ob;
                    if (fq < 2) { oa = xAa * ca - xBa * sa; ob = xAb * cb - xBb * sb; } else { oa = xBa * ca + xAa * sa; ob = xBb * cb + xAb * sb; }
                    *(GAS u32x4*)(kp + 64 + 8 * fq) = pack8(oa, ob);
                    asm volatile("" ::: "memory");
                }
            }
        } else {
            const int h = (pn - 2) * 4 + wc;
            float kq[2][4];
            ROWS8(ai, m) kq[ai][m] = kvss[(size_t)EPI_ROW(u, ai, m) * 4 + fq];
            ROWS8(ai, m) {
                    const int row = EPI_ROW(u, ai, m);
                    float ks = kq[ai][m]; ks = sum_x16(ks); ks = sum_x32(ks);
                    const float rkv = __builtin_amdgcn_rsqf(ks * (1.0f / 256.0f) + EPS);
                    const int b = row >> 11, sq = row & 2047;
                    GAS bf16_t* vp = vb + ((size_t)((b * NH + h) * SEQ + sq)) * 64;
                    *(GAS u32x4*)(vp + 8 * fq) = pack8(acc[ai][0][m][0] * rkv, acc[ai][0][m][1] * rkv);
                    *(GAS u32x4*)(vp + 32 + 8 * fq) = pack8(acc[ai][1][m][0] * rkv, acc[ai][1][m][1] * rkv);
                    asm volatile("" ::: "memory");
                }
        }
    }
};

struct EpiS {
    static constexpr bool PERM = false;
    unsigned char* ws;
    __device__ __forceinline__ void operator()(const Acc& acc, const Unit& u, int wr, int wc, int fr, int fq) const {
        GAS unsigned char* w = (GAS unsigned char*)ws; asm volatile("" : "+s"(w)); GAS float* sst = (GAS float*)(w + WS_SST);
        ROWS8(ai, m) {
                const int row = EPI_ROW(u, ai, m);
                GAS float* p = sst + (size_t)row * 128 + wc * 32 + 4 * fq;
                *(GAS f32x4*)p = acc[ai][0][m][0]; *(GAS f32x4*)(p + 16) = acc[ai][0][m][1];
            }
    }
};

__device__ __forceinline__ float gelu_tanh(float x) {
    const float z = 0.7978845608028654f * (x + 0.044715f * x * x * x);
    return x * __builtin_amdgcn_rcpf(1.0f + __builtin_amdgcn_exp2f(-2.8853900817779268f * z));
}
struct EpiY {
    static constexpr bool PERM = true;
    unsigned char* ws;
    __device__ __forceinline__ void operator()(const Acc& acc, const Unit& u, int wr, int wc, int fr, int fq) const {
        GAS unsigned char* w = (GAS unsigned char*)ws; asm volatile("" : "+s"(w)); GAS bf16_t* yb = (GAS bf16_t*)(w + WS_YB);
        const int g = u.pm >> 2, pnl = u.pn & 1;
        ROWS8(ai, m) {
                const int rg = (u.pm & 3) * 256 + ai * 128 + wr * 64 + m * 16 + fr, b = rg >> 6, c = rg & 63;
#pragma unroll
                for (int bj = 0; bj < 2; ++bj) {
                    const int nl = pnl * 256 + wc * 64 + bj * 32 + 8 * fq, t = nl >> 4, i0 = nl & 15;
                    f32x4 a = acc[ai][bj][m][0], bq = acc[ai][bj][m][1];
#pragma unroll
                    for (int j = 0; j < 4; ++j) { a[j] = gelu_tanh(a[j]); bq[j] = gelu_tanh(bq[j]); }
                    GAS bf16_t* p = yb + (size_t)(b * SEQ + c * LC + t) * 512 + g * 16 + i0;
                    *(GAS u32x4*)p = pack8(a, bq);
                }
                asm volatile("" ::: "memory");
            }
    }
};

struct EpiProj {
    static constexpr bool PERM = true;
    unsigned char* ws;
    __device__ __forceinline__ void operator()(const Acc& acc, const Unit& u, int wr, int wc, int fr, int fq) const {
        GAS unsigned char* w = (GAS unsigned char*)ws; asm volatile("" : "+s"(w)); const GAS unsigned char* gt = (const GAS unsigned char*)(w + WS_GT); GAS bf16_t* mg = (GAS bf16_t*)(w + WS_MG);
        u32x2 gw[2][4][2];
        ROWS8(ai, m) { const GAS unsigned char* gp = gt + (size_t)EPI_ROW(u, ai, m) * 2048 + u.pn * 256 + wc * 64 + 8 * fq; gw[ai][m][0] = *(const GAS u32x2*)gp; gw[ai][m][1] = *(const GAS u32x2*)(gp + 32); }
        ROWS8(ai, m) {
                const int row = EPI_ROW(u, ai, m);
#pragma unroll
                for (int bj = 0; bj < 2; ++bj) {
                    const int col = u.pn * 256 + wc * 64 + bj * 32 + 8 * fq; const u32x2 g = gw[ai][m][bj];
                    const f32x4 a = acc[ai][bj][m][0] * unpack4_u8(g.x), b = acc[ai][bj][m][1] * unpack4_u8(g.y);
                    *(GAS u32x4*)(mg + (size_t)row * 1024 + col) = pack8(a, b);
                }
                asm volatile("" ::: "memory");
            }
    }
};

struct EpiGlu {
    static constexpr bool PERM = true;
    unsigned char* ws;
    __device__ __forceinline__ void operator()(const Acc& acc, const Unit& u, int wr, int wc, int fr, int fq) const {
        GAS unsigned char* w = (GAS unsigned char*)ws; asm volatile("" : "+s"(w)); const GAS unsigned char* gt = (const GAS unsigned char*)(w + WS_GT); GAS bf16_t* mg = (GAS bf16_t*)(w + WS_MG);
        u32x2 gw[2][4]; u32x4 mw[2][4];
        ROWS8(ai, m) { const size_t row = (size_t)EPI_ROW(u, ai, m); const int col = u.pn * 128 + wc * 32 + 8 * fq; gw[ai][m] = *(const GAS u32x2*)(gt + row * 2048 + 1024 + col); mw[ai][m] = *(const GAS u32x4*)(mg + row * 1024 + col); }
        ROWS8(ai, m) {
                const int row = EPI_ROW(u, ai, m), col = u.pn * 128 + wc * 32 + 8 * fq;
                const u32x2 g = gw[ai][m]; const u32x4 mo = mw[ai][m];
                const f32x4 g1a = unpack4_u8(g.x), g1b = unpack4_u8(g.y);
                f32x4 va = acc[ai][0][m][0], vb = acc[ai][0][m][1]; const f32x4 ga = acc[ai][1][m][0], gb = acc[ai][1][m][1];
                const f32x4 ma = (f32x4){bflo(mo.x), bfhi(mo.x), bflo(mo.y), bfhi(mo.y)}, mb = (f32x4){bflo(mo.z), bfhi(mo.z), bflo(mo.w), bfhi(mo.w)};
#pragma unroll
                for (int j = 0; j < 4; ++j) { va[j] = ma[j] + va[j] * fast_sigmoid(ga[j]) * g1a[j]; vb[j] = mb[j] + vb[j] * fast_sigmoid(gb[j]) * g1b[j]; }
                *(GAS u32x4*)(mg + (size_t)row * 1024 + col) = pack8(va, vb);
                asm volatile("" ::: "memory");
            }
    }
};

struct EpiOut {
    static constexpr bool PERM = true;
    unsigned char* ws;
    __device__ __forceinline__ void operator()(const Acc& acc, const Unit& u, int wr, int wc, int fr, int fq) const {
        GAS unsigned char* w = (GAS unsigned char*)ws; asm volatile("" : "+s"(w)); GAS bf16_t* xb = (GAS bf16_t*)(w + WS_XB); GAS float* ssx = (GAS float*)(w + WS_SSX);
        u32x4 xw[2][4][2];
        ROWS8(ai, m) { const GAS bf16_t* p = xb + (size_t)EPI_ROW(u, ai, m) * 1024 + u.pn * 256 + wc * 64 + 8 * fq; xw[ai][m][0] = *(const GAS u32x4*)p; xw[ai][m][1] = *(const GAS u32x4*)(p + 32); }
        ROWS8(ai, m) {
                const int row = EPI_ROW(u, ai, m);
                float s = 0.f;
#pragma unroll
                for (int bj = 0; bj < 2; ++bj) {
                    GAS bf16_t* p = xb + (size_t)row * 1024 + u.pn * 256 + wc * 64 + bj * 32 + 8 * fq; const u32x4 x4 = xw[ai][m][bj];
                    const f32x4 a = (f32x4){bflo(x4.x), bfhi(x4.x), bflo(x4.y), bfhi(x4.y)} + acc[ai][bj][m][0], b = (f32x4){bflo(x4.z), bfhi(x4.z), bflo(x4.w), bfhi(x4.w)} + acc[ai][bj][m][1];
                    *(GAS u32x4*)p = pack8(a, b);
                    s += ((a[0] * a[0] + a[1] * a[1]) + (a[2] * a[2] + a[3] * a[3])) + ((b[0] * b[0] + b[1] * b[1]) + (b[2] * b[2] + b[3] * b[3]));
                }
                s = sum_x16(s); s = sum_x32(s);
                if (fq == 0) ssx[(size_t)row * 16 + u.pn * 4 + wc] = s;
                asm volatile("" ::: "memory");
            }
    }
};

struct MoeOrder {
    static constexpr bool GATHER = false;
    const int* tseg; int tile0, ntile, NC, G, c;
    int loff = 0, lmax = 0x7fffffff;
    __device__ int vcu() const { return (G % 8 == 0) ? (c % 8) * (G / 8) + c / 8 : c; }
    __device__ bool unit(int L, Unit& u) const { const int pm = tile0 + L / NC, pnl = L % NC; u.pm = pm; u.pn = (tseg[pm] & 31) * NC + pnl; return true; }
    __device__ bool next(int i, Unit& u) const {
        const int L = i * G + vcu() + loff; if (L >= ntile * NC || L >= lmax) return false;
        return unit(L, u);
    }
};
struct MoeGatherOrder : MoeOrder { static constexpr bool GATHER = true; const int* gidx; };
struct MoeDownAOrder : MoeOrder {
    int nbusy;
    __device__ bool next(int i, Unit& u) const {
        const int vc = vcu(), F = G - nbusy; int L;
        if (vc >= nbusy) { const int j = vc - nbusy; L = (i < 2) ? i * F + j : 2 * F + (i - 2) * G + vc; }
        else L = 2 * F + i * G + vc;
        if (L >= ntile * NC) return false;
        return unit(L, u);
    }
};

struct EpiGU {
    static constexpr bool PERM = true;
    unsigned char* ws;
    __device__ __forceinline__ void operator()(const Acc& acc, const Unit& u, int wr, int wc, int fr, int fq) const {
        GAS unsigned char* w = (GAS unsigned char*)ws; asm volatile("" : "+s"(w)); const GAS float* ars = (const GAS float*)(w + WS_ARS); GAS bf16_t* hh = (GAS bf16_t*)(w + WS_HH);
        const int pnl = u.pn & 1;
        float rsv[2][4];
        ROWS8(ai, m) rsv[ai][m] = ars[EPI_ROW(u, ai, m)];
        ROWS8(ai, m) {
                const int row = EPI_ROW(u, ai, m);
                const float rs = rsv[ai][m];
                f32x4 ga = acc[ai][0][m][0] * rs, gb = acc[ai][0][m][1] * rs, ua = acc[ai][1][m][0] * rs, ub = acc[ai][1][m][1] * rs;
#pragma unroll
                for (int j = 0; j < 4; ++j) { ga[j] = ga[j] * fast_sigmoid(ga[j]) * ua[j]; gb[j] = gb[j] * fast_sigmoid(gb[j]) * ub[j]; }
                *(GAS u32x4*)(hh + (size_t)row * 256 + pnl * 128 + wc * 32 + 8 * fq) = pack8(ga, gb);
                asm volatile("" ::: "memory");
            }
    }
};

template <bool PASS_B> struct EpiDown {
    static constexpr bool PERM = true;
    unsigned char* ws; float* out;
    __device__ __forceinline__ void operator()(const Acc& acc, const Unit& u, int wr, int wc, int fr, int fq) const {
        GAS unsigned char* w = (GAS unsigned char*)ws; asm volatile("" : "+s"(w)); const GAS int* atok = (const GAS int*)(w + WS_ATOK); const GAS float* aw = (const GAS float*)(w + WS_AW); GAS bf16_t* xb = (GAS bf16_t*)(w + WS_XB); GAS float* ssx = (GAS float*)(w + WS_SSX);
        GAS float* og = (GAS float*)out;
        const int pnl = u.pn & 3;
        int tk[2][4]; float wg[2][4]; u32x4 xw[2][4][2];
        ROWS8(ai, m) { const int row = EPI_ROW(u, ai, m); tk[ai][m] = atok[row]; wg[ai][m] = aw[row]; }
        ROWS8(ai, m) { const int t0 = tk[ai][m] < 0 ? 0 : tk[ai][m]; const GAS bf16_t* p = xb + (size_t)t0 * 1024 + pnl * 256 + wc * 64 + 8 * fq; xw[ai][m][0] = *(const GAS u32x4*)p; xw[ai][m][1] = *(const GAS u32x4*)(p + 32); }
        ROWS8(ai, m) {
                const int tok = tk[ai][m]; const float wgt = wg[ai][m];
                const int t0 = tok < 0 ? 0 : tok;
                float s = 0.f;
#pragma unroll
                for (int bj = 0; bj < 2; ++bj) {
                    const size_t o = (size_t)t0 * 1024 + pnl * 256 + wc * 64 + bj * 32 + 8 * fq; const u32x4 x4 = xw[ai][m][bj];
                    const f32x4 a = (f32x4){bflo(x4.x), bfhi(x4.x), bflo(x4.y), bfhi(x4.y)} + acc[ai][bj][m][0] * wgt, b = (f32x4){bflo(x4.z), bfhi(x4.z), bflo(x4.w), bfhi(x4.w)} + acc[ai][bj][m][1] * wgt;
                    if (tok >= 0) {
                        if (PASS_B && og) { *(GAS f32x4*)(og + o) = a; *(GAS f32x4*)(og + o + 4) = b; }
                        else *(GAS u32x4*)(xb + o) = pack8(a, b); }
                    s += ((a[0] * a[0] + a[1] * a[1]) + (a[2] * a[2] + a[3] * a[3])) + ((b[0] * b[0] + b[1] * b[1]) + (b[2] * b[2] + b[3] * b[3]));
                }
                if (PASS_B && !og) { s = sum_x16(s); s = sum_x32(s); if (fq == 0 && tok >= 0) ssx[(size_t)tok * 16 + pnl * 4 + wc] = s; }
                asm volatile("" ::: "memory");
            }
    }
};

struct SsmSOrder {
    static constexpr bool GATHER = false; int G, c;
    __device__ bool next(int i, Unit& u) const { const int cc = (c + G / 2) % G; const int L = i * G + cc; if (L >= 128) return false; u.pm = L; u.pn = L >> 2; return true; }
};
struct SsmYOrder {
    static constexpr bool GATHER = false; int G, c;
    __device__ bool next(int i, Unit& u) const { const int vc = (G % 8 == 0) ? (c % 8) * (G / 8) + c / 8 : c; const int L = i * G + vc; if (L >= 256) return false; u.pm = L >> 1; u.pn = (L >> 3) * 2 + (L & 1); return true; }
};
namespace att {
#define KSWZ(row, colB) ((row) * 256 + ((colB) ^ (((row) & 15) << 4)))
#define SBAR() __builtin_amdgcn_sched_barrier(0)
constexpr int SHM_K = 32768, SHM_V = 16384, OFF_V = 2 * SHM_K, OFF_WS = 2 * SHM_K + 2 * SHM_V;
__device__ __forceinline__ int crow(int r, int hi) { return (r & 3) + 8 * (r >> 2) + 4 * hi; }
__device__ __forceinline__ int v_st(int k, int c) { const int kk = (k & ~0xC) | ((k & 4) << 1) | ((k & 8) >> 1); return ((kk >> 3) * 2 + (c >> 5)) * 512 + ((kk & 7) * 32 + (c & 31)) * 2; }
__device__ __forceinline__ int v_rd_base(int lane) { return ((lane & 3) << 3) | (((lane >> 2) & 3) << 6) | (((lane >> 4) & 1) << 5) | (((lane >> 5) & 1) << 8); }
constexpr int v_rd_off(int d0, int ks, int half) { return d0 * 512 + ks * 2048 + half * 1024; }
template <int OFF> __device__ __forceinline__ s16x4 tr_read(int vb) {
    s16x4 r; asm volatile("ds_read_b64_tr_b16 %0, %1 offset:%2" : "=&v"(r) : "v"(vb), "i"(OFF) : "memory"); return r;
}
template <int D0> __device__ __forceinline__ void pv_one(f32x16& od, int vb, bf16x8 pa0, bf16x8 pa1, bf16x8 pa2, bf16x8 pa3) {
    const s16x4 l0 = tr_read<v_rd_off(D0, 0, 0)>(vb), h0 = tr_read<v_rd_off(D0, 0, 1)>(vb), l1 = tr_read<v_rd_off(D0, 1, 0)>(vb), h1 = tr_read<v_rd_off(D0, 1, 1)>(vb);
    const s16x4 l2 = tr_read<v_rd_off(D0, 2, 0)>(vb), h2 = tr_read<v_rd_off(D0, 2, 1)>(vb), l3 = tr_read<v_rd_off(D0, 3, 0)>(vb), h3 = tr_read<v_rd_off(D0, 3, 1)>(vb);
    asm volatile("s_waitcnt lgkmcnt(0)" ::: "memory"); SBAR();
#define PK(L, H) (bf16x8){L[0], L[1], L[2], L[3], H[0], H[1], H[2], H[3]}
    od = __builtin_amdgcn_mfma_f32_32x32x16_bf16(pa0, PK(l0, h0), od, 0, 0, 0);
    od = __builtin_amdgcn_mfma_f32_32x32x16_bf16(pa1, PK(l1, h1), od, 0, 0, 0);
    od = __builtin_amdgcn_mfma_f32_32x32x16_bf16(pa2, PK(l2, h2), od, 0, 0, 0);
    od = __builtin_amdgcn_mfma_f32_32x32x16_bf16(pa3, PK(l3, h3), od, 0, 0, 0);
#undef PK
}
__device__ __forceinline__ void attn_unit(char* lds, int b, int h, int qb, const bf16_t* TQ, const float* qss, const float* rope, const float* gq, float kbound,
                                          const bf16_t* KB, const bf16_t* VB, bf16_t* OB, int variant = 0) {
    int tid_ = threadIdx.x; asm volatile("" : "+v"(tid_));
    const int tid = tid_, wid = tid >> 6, lane = tid & 63, r32 = lane & 31, hi = lane >> 5;
    char* K_lds = lds; char* V_lds = lds + OFF_V; float* li_l = (float*)(lds + OFF_WS) + wid * 64;
    constexpr float C = 0.10206207261596575f * 1.4426950408889634f;
    const int row = b * SEQ + qb * 256 + wid * 32 + r32;
    bf16x8 qr[6]; float mb;
    {
        const bf16_t* tq = TQ + (size_t)row * 768 + h * 96 + hi * 8;
        float qf[6][8]; float ss = 0.f;
#pragma unroll
        for (int d0 = 0; d0 < 6; ++d0) { const u32x4 w = *(const u32x4*)(tq + d0 * 16);
            qf[d0][0] = bflo(w.x); qf[d0][1] = bfhi(w.x); qf[d0][2] = bflo(w.y); qf[d0][3] = bfhi(w.y); qf[d0][4] = bflo(w.z); qf[d0][5] = bfhi(w.z); qf[d0][6] = bflo(w.w); qf[d0][7] = bfhi(w.w);
#pragma unroll
            for (int j = 0; j < 8; ++j) ss += qf[d0][j] * qf[d0][j]; }
        ss = sum_x32(ss);
        const f32x4 qa = *(const f32x4*)(qss + (size_t)row * 8), qb4 = *(const f32x4*)(qss + (size_t)row * 8 + 4);
        const float a = __builtin_amdgcn_rsqf((((qa[0] + qa[1]) + (qa[2] + qa[3])) + ((qb4[0] + qb4[1]) + (qb4[2] + qb4[3]))) * (1.0f / 384.0f) + EPS);
        const float f = a * __builtin_amdgcn_rsqf(a * a * ss * (1.0f / 96.0f) + EPS);
#pragma unroll
        for (int d0 = 0; d0 < 6; ++d0) { const f32x4 g0 = *(const f32x4*)(gq + d0 * 16 + hi * 8), g1 = *(const f32x4*)(gq + d0 * 16 + hi * 8 + 4);
#pragma unroll
            for (int j = 0; j < 4; ++j) { qf[d0][j] *= f * g0[j]; qf[d0][4 + j] *= f * g1[j]; } }
        const float* rp = rope + (size_t)row * 32 + hi * 8;
        const f32x4 c0 = *(const f32x4*)rp, c1 = *(const f32x4*)(rp + 4), s0 = *(const f32x4*)(rp + 16), s1 = *(const f32x4*)(rp + 20);
#pragma unroll
        for (int j = 0; j < 8; ++j) { const float cs = j < 4 ? c0[j & 3] : c1[j & 3], sn = j < 4 ? s0[j & 3] : s1[j & 3]; const float x1 = qf[4][j], x2 = qf[5][j];
            qf[4][j] = x1 * cs - x2 * sn; qf[5][j] = x2 * cs + x1 * sn; }
        float qn = 0.f;
#pragma unroll
        for (int d0 = 0; d0 < 6; ++d0)
#pragma unroll
            for (int j = 0; j < 8; ++j) qn += qf[d0][j] * qf[d0][j];
        qn = sum_x32(qn);
        mb = sqrtf(qn) * kbound * C;
#pragma unroll
        for (int d0 = 0; d0 < 6; ++d0) { u32x4 w; w.x = cvt_pk_bf16(qf[d0][0] * C, qf[d0][1] * C); w.y = cvt_pk_bf16(qf[d0][2] * C, qf[d0][3] * C); w.z = cvt_pk_bf16(qf[d0][4] * C, qf[d0][5] * C); w.w = cvt_pk_bf16(qf[d0][6] * C, qf[d0][7] * C);
            qr[d0] = *reinterpret_cast<bf16x8*>(&w); }
    }
    const bf16_t* Kh = KB + (size_t)(b * NH + h) * SEQ * 96; const bf16_t* Vh = VB + (size_t)(b * NH + h) * SEQ * 64;
    const int sr = tid >> 2, sc = tid & 3;
    const int vb0 = (int)(uintptr_t)V_lds + v_rd_base(lane);
    const int NS = 2 * qb + 2, cw = 4 * qb + (wid >> 1);
    float l_reg = 0.f; f32x16 o0 = {}, o1 = {};
    bf16x8 k0r, k1r, k2r, v0r, v1r;
#define SLOAD(key0) do { const bf16_t* kp_ = Kh + (size_t)((key0) + sr) * 96 + sc * 8; k0r = *(const bf16x8*)kp_; k1r = *(const bf16x8*)(kp_ + 32); k2r = *(const bf16x8*)(kp_ + 64); \
        const bf16_t* vp_ = Vh + (size_t)((key0) + sr) * 64 + sc * 8; v0r = *(const bf16x8*)vp_; v1r = *(const bf16x8*)(vp_ + 32); } while (0)
#define SWRITE(bf) do { int t_ = threadIdx.x; asm volatile("" : "+v"(t_)); const int sr_ = t_ >> 2, sc_ = t_ & 3; \
        char* kd_ = K_lds + (bf) * SHM_K; *(bf16x8*)(kd_ + KSWZ(sr_, sc_ * 16)) = k0r; *(bf16x8*)(kd_ + KSWZ(sr_, (sc_ + 4) * 16)) = k1r; *(bf16x8*)(kd_ + KSWZ(sr_, (sc_ + 8) * 16)) = k2r; \
        char* vd_ = V_lds + (bf) * SHM_V + (sr_ >> 6) * 8192; *(bf16x8*)(vd_ + v_st(sr_ & 63, sc_ * 8)) = v0r; *(bf16x8*)(vd_ + v_st(sr_ & 63, (sc_ + 4) * 8)) = v1r; } while (0)
#define QKT(P0, P1, KS) do { const char* Ks_ = (KS); _Pragma("unroll") for (int r = 0; r < 16; ++r) { P0[r] = -mb; P1[r] = -mb; } \
        bf16x8 kf0[6], kf1[6]; \
        _Pragma("unroll") for (int d0 = 0; d0 < 6; ++d0) { const int cb = (d0 * 16 + hi * 8) * 2; \
            kf0[d0] = *reinterpret_cast<const bf16x8*>(Ks_ + KSWZ(r32, cb)); kf1[d0] = *reinterpret_cast<const bf16x8*>(Ks_ + KSWZ(32 + r32, cb)); } \
        SBAR();   \
        _Pragma("unroll") for (int d0 = 0; d0 < 6; ++d0) { \
            P0 = __builtin_amdgcn_mfma_f32_32x32x16_bf16(kf0[d0], qr[d0], P0, 0, 0, 0); P1 = __builtin_amdgcn_mfma_f32_32x32x16_bf16(kf1[d0], qr[d0], P1, 0, 0, 0); } } while (0)
#define PK4(P, BASE, OUT) do { unsigned a0 = cvt_pk_bf16(P[BASE + 0], P[BASE + 1]), a1 = cvt_pk_bf16(P[BASE + 2], P[BASE + 3]);   \
    unsigned b0_ = cvt_pk_bf16(P[BASE + 4], P[BASE + 5]), b1_ = cvt_pk_bf16(P[BASE + 6], P[BASE + 7]);                              \
    auto r0 = __builtin_amdgcn_permlane32_swap(a0, b0_, false, false); auto r1 = __builtin_amdgcn_permlane32_swap(a1, b1_, false, false); \
    u32x4 w = {r0[0], r1[0], r0[1], r1[1]}; OUT = *reinterpret_cast<bf16x8*>(&w); } while (0)
#define SMX(P0, P1) do { float ps = 0.f; _Pragma("unroll") for (int r = 0; r < 16; ++r) { P0[r] = __builtin_amdgcn_exp2f(P0[r]); P1[r] = __builtin_amdgcn_exp2f(P1[r]); ps += P0[r] + P1[r]; } \
        ps = sum_x32(ps); l_reg += ps; PK4(P0, 0, pa0); PK4(P0, 8, pa1); PK4(P1, 0, pa2); PK4(P1, 8, pa3); } while (0)
#define PV(VB_) do { const int vb_ = (VB_); pv_one<0>(o0, vb_, pa0, pa1, pa2, pa3); pv_one<1>(o1, vb_, pa0, pa1, pa2, pa3); } while (0)
#define PKV(L, H) (bf16x8){L[0], L[1], L[2], L[3], H[0], H[1], H[2], H[3]}
#define GAP_EXP4(P, B) do { P[B] = __builtin_amdgcn_exp2f(P[B]); P[B + 1] = __builtin_amdgcn_exp2f(P[B + 1]); P[B + 2] = __builtin_amdgcn_exp2f(P[B + 2]); P[B + 3] = __builtin_amdgcn_exp2f(P[B + 3]); asm volatile("" : "+v"(P)); SBAR(); } while (0)
#define GAP_SUM8(P, B) do { psum_ += ((P[B] + P[B + 1]) + (P[B + 2] + P[B + 3])) + ((P[B + 4] + P[B + 5]) + (P[B + 6] + P[B + 7])); asm volatile("" : "+v"(psum_)); SBAR(); } while (0)
#define GAP_PK(P, BASE, OUT) do { PK4(P, BASE, OUT); asm volatile("" : "+v"(OUT)); SBAR(); } while (0)
#define EXPALL(P0, P1) do { _Pragma("unroll") for (int r = 0; r < 16; ++r) { P0[r] = __builtin_amdgcn_exp2f(P0[r]); P1[r] = __builtin_amdgcn_exp2f(P1[r]); } } while (0)
#define SUMPACK(P0, P1) do { float ps = 0.f; _Pragma("unroll") for (int r = 0; r < 16; ++r) ps += P0[r] + P1[r]; ps = sum_x32(ps); l_reg += ps; PK4(P0, 0, pa0); PK4(P0, 8, pa1); PK4(P1, 0, pa2); PK4(P1, 8, pa3); } while (0)
#define BLK_QK(P0, P1, KS, S0, S1) do { const char* Ks_ = (KS); bf16x8 kf0[6], kf1[6]; \
        _Pragma("unroll") for (int d0 = 0; d0 < 6; ++d0) { const int cb = (d0 * 16 + hi * 8) * 2; kf0[d0] = *reinterpret_cast<const bf16x8*>(Ks_ + KSWZ(r32, cb)); kf1[d0] = *reinterpret_cast<const bf16x8*>(Ks_ + KSWZ(32 + r32, cb)); } \
        SBAR(); _Pragma("unroll") for (int r = 0; r < 16; ++r) { P0[r] = -mb; P1[r] = -mb; } float psum_ = 0.f; \
        P0 = __builtin_amdgcn_mfma_f32_32x32x16_bf16(kf0[0], qr[0], P0, 0, 0, 0); GAP_SUM8(S0, 0); \
        P1 = __builtin_amdgcn_mfma_f32_32x32x16_bf16(kf1[0], qr[0], P1, 0, 0, 0); GAP_SUM8(S0, 8); \
        P0 = __builtin_amdgcn_mfma_f32_32x32x16_bf16(kf0[1], qr[1], P0, 0, 0, 0); GAP_SUM8(S1, 0); \
        P1 = __builtin_amdgcn_mfma_f32_32x32x16_bf16(kf1[1], qr[1], P1, 0, 0, 0); GAP_SUM8(S1, 8); \
        P0 = __builtin_amdgcn_mfma_f32_32x32x16_bf16(kf0[2], qr[2], P0, 0, 0, 0); GAP_PK(S0, 0, pa0); \
        P1 = __builtin_amdgcn_mfma_f32_32x32x16_bf16(kf1[2], qr[2], P1, 0, 0, 0); GAP_PK(S0, 8, pa1); \
        P0 = __builtin_amdgcn_mfma_f32_32x32x16_bf16(kf0[3], qr[3], P0, 0, 0, 0); GAP_PK(S1, 0, pa2); \
        P1 = __builtin_amdgcn_mfma_f32_32x32x16_bf16(kf1[3], qr[3], P1, 0, 0, 0); GAP_PK(S1, 8, pa3); \
        P0 = __builtin_amdgcn_mfma_f32_32x32x16_bf16(kf0[4], qr[4], P0, 0, 0, 0); P1 = __builtin_amdgcn_mfma_f32_32x32x16_bf16(kf1[4], qr[4], P1, 0, 0, 0); \
        P0 = __builtin_amdgcn_mfma_f32_32x32x16_bf16(kf0[5], qr[5], P0, 0, 0, 0); P1 = __builtin_amdgcn_mfma_f32_32x32x16_bf16(kf1[5], qr[5], P1, 0, 0, 0); \
        psum_ = sum_x32(psum_); l_reg += psum_; SBAR(); } while (0)
#define BLK_PV(VB_, X0, X1) do { const int vb_ = (VB_); \
        const s16x4 a0l = tr_read<v_rd_off(0, 0, 0)>(vb_), a0h = tr_read<v_rd_off(0, 0, 1)>(vb_), b0l = tr_read<v_rd_off(1, 0, 0)>(vb_), b0h = tr_read<v_rd_off(1, 0, 1)>(vb_); \
        const s16x4 a1l = tr_read<v_rd_off(0, 1, 0)>(vb_), a1h = tr_read<v_rd_off(0, 1, 1)>(vb_), b1l = tr_read<v_rd_off(1, 1, 0)>(vb_), b1h = tr_read<v_rd_off(1, 1, 1)>(vb_); \
        const s16x4 a2l = tr_read<v_rd_off(0, 2, 0)>(vb_), a2h = tr_read<v_rd_off(0, 2, 1)>(vb_), b2l = tr_read<v_rd_off(1, 2, 0)>(vb_), b2h = tr_read<v_rd_off(1, 2, 1)>(vb_); \
        const s16x4 a3l = tr_read<v_rd_off(0, 3, 0)>(vb_), a3h = tr_read<v_rd_off(0, 3, 1)>(vb_), b3l = tr_read<v_rd_off(1, 3, 0)>(vb_), b3h = tr_read<v_rd_off(1, 3, 1)>(vb_); \
        asm volatile("s_waitcnt lgkmcnt(0)" ::: "memory"); SBAR(); \
        o0 = __builtin_amdgcn_mfma_f32_32x32x16_bf16(pa0, PKV(a0l, a0h), o0, 0, 0, 0); GAP_EXP4(X0, 0); \
        o1 = __builtin_amdgcn_mfma_f32_32x32x16_bf16(pa0, PKV(b0l, b0h), o1, 0, 0, 0); GAP_EXP4(X0, 4); \
        o0 = __builtin_amdgcn_mfma_f32_32x32x16_bf16(pa1, PKV(a1l, a1h), o0, 0, 0, 0); GAP_EXP4(X0, 8); \
        o1 = __builtin_amdgcn_mfma_f32_32x32x16_bf16(pa1, PKV(b1l, b1h), o1, 0, 0, 0); GAP_EXP4(X0, 12); \
        o0 = __builtin_amdgcn_mfma_f32_32x32x16_bf16(pa2, PKV(a2l, a2h), o0, 0, 0, 0); GAP_EXP4(X1, 0); \
        o1 = __builtin_amdgcn_mfma_f32_32x32x16_bf16(pa2, PKV(b2l, b2h), o1, 0, 0, 0); GAP_EXP4(X1, 4); \
        o0 = __builtin_amdgcn_mfma_f32_32x32x16_bf16(pa3, PKV(a3l, a3h), o0, 0, 0, 0); GAP_EXP4(X1, 8); \
        o1 = __builtin_amdgcn_mfma_f32_32x32x16_bf16(pa3, PKV(b3l, b3h), o1, 0, 0, 0); GAP_EXP4(X1, 12); } while (0)
    bool pend = false;
    if (wid < 4) __builtin_amdgcn_s_setprio(1);
    f32x16 pA0 = {}, pA1 = {}, pB0 = {}, pB1 = {}; bf16x8 pa0 = {}, pa1 = {}, pa2 = {}, pa3 = {};
    SLOAD(0);
    for (int s = 0; s < NS; ++s) {
        const int bf = s & 1;
        asm volatile("s_waitcnt vmcnt(0)" ::: "memory");
        SWRITE(bf);
        if (s + 1 < NS) SLOAD((s + 1) * 128);
        __syncthreads();
        const bool va = 2 * s <= cw, vb2 = 2 * s + 1 <= cw;
        const char* Kb_ = K_lds + bf * SHM_K; const int vbase = vb0 + bf * SHM_V;
        SBAR();
        if (va && vb2 && pend) {
            const int vprev = vb0 + (bf ^ 1) * SHM_V + 8192;
            BLK_QK(pA0, pA1, Kb_, pB0, pB1);
            BLK_PV(vprev, pA0, pA1);
            BLK_QK(pB0, pB1, Kb_ + 16384, pA0, pA1);
            BLK_PV(vbase, pB0, pB1);
        } else {
            if (pend) { SUMPACK(pB0, pB1); SBAR(); PV(vb0 + (bf ^ 1) * SHM_V + 8192); }
            if (va) { QKT(pA0, pA1, Kb_); EXPALL(pA0, pA1); SUMPACK(pA0, pA1); SBAR(); PV(vbase); }
            if (vb2) { QKT(pB0, pB1, Kb_ + 16384); EXPALL(pB0, pB1); }
        }
        pend = vb2;
    }
    if (pend) { SUMPACK(pB0, pB1); SBAR(); PV(vb0 + ((NS - 1) & 1) * SHM_V + 8192); }
    __builtin_amdgcn_s_setprio(0);
#undef BLK_QK
#undef BLK_PV
#undef SUMPACK
#undef EXPALL
#undef GAP_EXP4
#undef GAP_SUM8
#undef GAP_PK
#undef PKV
#undef SLOAD
#undef SWRITE
#undef QKT
#undef SMX
#undef PK4
#undef PV
    if (hi == 0) li_l[r32] = l_reg; asm volatile("s_waitcnt lgkmcnt(0)" ::: "memory");
    bf16_t* ot = (bf16_t*)(lds + OFF_WS + 2048) + wid * 2048;
#pragma unroll
    for (int r = 0; r < 16; ++r) { const int orow = crow(r, hi); const float rl = __builtin_amdgcn_rcpf(li_l[orow]);
        ot[orow * 64 + r32] = (bf16_t)f2bf(o0[r] * rl); ot[orow * 64 + 32 + r32] = (bf16_t)f2bf(o1[r] * rl); }
    asm volatile("s_waitcnt lgkmcnt(0)" ::: "memory");
    bf16_t* Ow = OB + (size_t)(b * SEQ + qb * 256 + wid * 32) * 512 + h * 64;
#pragma unroll
    for (int i = 0; i < 4; ++i) { const int ch = i * 64 + lane, orow = ch >> 3, oc = (ch & 7) * 8;
        *(u32x4*)(Ow + (size_t)orow * 512 + oc) = *(const u32x4*)(ot + orow * 64 + oc); }
    asm volatile("s_waitcnt lgkmcnt(0)" ::: "memory");
}
#undef KSWZ
}

__device__ __forceinline__ float wave_sum(float v) {
    return sum_x32(sum_x16(row_sum16(v)));
}
__device__ __forceinline__ float wave_max(float v) {
    return max_x32(max_x16(row_max16(v)));
}

struct TDesc { const float* W; const float* gain; bf16_t* WT; int K, N, kb, dr0, sc0; };
__device__ __forceinline__ void tr_load(const TDesc& d, f32x4 (&v)[8], int lane) {
    if (d.sc0 < 0) { float z = 0.f; asm volatile("" : "+v"(z));
#pragma unroll
        for (int i = 0; i < 8; ++i) v[i] = (f32x4){z, z, z, z};
        return; }
    const float* src = d.W + (size_t)(64 * d.kb + (lane >> 3)) * d.N + d.sc0 + 4 * (lane & 7);
#pragma unroll
    for (int i = 0; i < 8; ++i) v[i] = __builtin_nontemporal_load((const f32x4*)(src + (size_t)(8 * i) * d.N));
}
__device__ __forceinline__ void tr_store(const TDesc& d, const f32x4 (&v)[8], LAS float* scr, int lane) {
    const int k0 = 64 * d.kb, K = d.K;
    if (d.sc0 < 0) {
#pragma unroll
        for (int j = 0; j < 4; ++j) { const int n = (lane >> 3) + 8 * j; *(u32x4*)(d.WT + (size_t)(d.dr0 + n) * K + k0 + 8 * (lane & 7)) = (u32x4){0u, 0u, 0u, 0u}; }
        return;
    }
#pragma unroll
    for (int i = 0; i < 8; ++i) { const int kk = 8 * i + (lane >> 3); const float g = d.gain ? d.gain[k0 + kk] : 1.0f; LAS float* s = scr + kk * 33 + 4 * (lane & 7);
        s[0] = v[i][0] * g; s[1] = v[i][1] * g; s[2] = v[i][2] * g; s[3] = v[i][3] * g; }
    asm volatile("s_waitcnt lgkmcnt(0)" ::: "memory");
    const int c = lane & 7;
#pragma unroll
    for (int j = 0; j < 4; ++j) { const int n = (lane >> 3) + 8 * j; const LAS float* s = scr + (8 * c) * 33 + n;
        u32x4 o; o.x = cvt_pk_bf16(s[0 * 33], s[1 * 33]); o.y = cvt_pk_bf16(s[2 * 33], s[3 * 33]); o.z = cvt_pk_bf16(s[4 * 33], s[5 * 33]); o.w = cvt_pk_bf16(s[6 * 33], s[7 * 33]);
        *(u32x4*)(d.WT + (size_t)(d.dr0 + n) * K + k0 + 8 * c) = o; }
    asm volatile("s_waitcnt lgkmcnt(0)" ::: "memory");
}
__device__ __forceinline__ int win_src(int nb) {
    if (nb < 64) return 1184 + 32 * nb;
    if (nb < 80) return 672 + 32 * (nb - 64);
    if (nb < 88) return 384 + 32 * (nb - 80);
    if (nb < 96) return 32 * (nb - 88);
    if (nb < 100) return 256 + 32 * (nb - 96);
    if (nb == 100) return 640;
    return -1;
}
__device__ __forceinline__ int ukv_src(int nb) { const int pn = nb >> 3, wc = (nb >> 1) & 3, bj = nb & 1; return pn < 2 ? 128 * (4 * pn + wc) + 32 * bj : 128 * (4 * (pn - 2) + wc) + 64 + 32 * bj; }

constexpr int MIXW_ITEMS = 16 * 104 + 6 * 24 + 4 * 32 + 8 * 32 + 8 * 64 + 16 * 32;
__device__ __forceinline__ TDesc mixw_desc(const Params& P, int it2) {
    const int l = it2 / MIXW_ITEMS; int r = it2 % MIXW_ITEMS;
    bf16_t* wm = (bf16_t*)(P.ws + WS_WMIX + (unsigned)(l * (int)WMIX_LAYER));
    if (r < 16 * 104) { const int kb = r / 104, nb = r % 104; return TDesc{P.in[3] + (unsigned)(l * 1024 * 3232), P.in[2] + l * 1024, wm + WM_IN / 2, 1024, 3232, kb, 32 * nb, win_src(nb)}; } r -= 16 * 104;
    if (r < 6 * 24) { const int kb = r / 24, nb = r % 24; return TDesc{P.in[5] + (unsigned)(l * 384 * 768), P.in[4] + l * 384, wm + WM_UQ / 2, 384, 768, kb, 32 * nb, 32 * nb}; } r -= 6 * 24;
    if (r < 4 * 32) { const int kb = r / 32, nb = r % 32; return TDesc{P.in[7] + (unsigned)(l * 256 * 1024), P.in[6] + l * 256, wm + WM_UKV / 2, 256, 1024, kb, 32 * nb, ukv_src(nb)}; } r -= 4 * 32;
    if (r < 8 * 32) { const int kb = r / 32, nb = r % 32; return TDesc{P.in[10] + (unsigned)(l * 512 * 1024), nullptr, wm + WM_PROJ / 2, 512, 1024, kb, 32 * nb, 32 * nb}; } r -= 8 * 32;
    if (r < 8 * 64) { const int kb = r / 64, nb = r % 64; const int pn = nb >> 3, q = (nb >> 1) & 3, half = nb & 1;
        return TDesc{P.in[19] + (unsigned)(l * 512 * 2048), nullptr, wm + WM_GLU / 2, 512, 2048, kb, 32 * nb, half * 1024 + 128 * pn + 32 * q}; } r -= 8 * 64;
    { const int kb = r / 32, nb = r % 32; return TDesc{P.in[20] + (unsigned)(l * 1024 * 1024), nullptr, wm + WM_OUT / 2, 1024, 1024, kb, 32 * nb, 32 * nb}; }
}
constexpr int EXPW_ITEMS = 32 * (256 + 128);
__device__ __forceinline__ TDesc expw_desc(const Params& P, int l, int it) {
    const int e = it / 384; int r = it % 384;
    if (r < 256) { const int kb = r >> 4, nb = r & 15, t2 = nb >> 3, q = (nb >> 1) & 3, half = nb & 1;
        return TDesc{(half ? P.in[25] : P.in[24]) + ((size_t)l * NE + e) * 1024 * 256, P.in[21] + l * 1024, (bf16_t*)(P.ws + WS_WGU) + (size_t)e * 512 * 1024, 1024, 256, kb, 32 * nb, 128 * t2 + 32 * q}; }
    r -= 256;
    { const int kb = r >> 5, nb = r & 31;
        return TDesc{P.in[26] + ((size_t)l * NE + e) * 256 * 1024, nullptr, (bf16_t*)(P.ws + WS_WD) + (size_t)e * 1024 * 256, 256, 1024, kb, 32 * nb, 32 * nb}; }
}
#define TR_LOOP(DESC_EXPR_OF_IT, FIRST, COUNT, STRIDE) do { \
    for (int it0 = (FIRST); it0 < (COUNT); it0 += 4 * (STRIDE)) { f32x4 va[8], vb[8], vc[8], vd[8]; \
        int it = it0; const TDesc da = DESC_EXPR_OF_IT; tr_load(da, va, lane); \
        it = it0 + (STRIDE); const bool h1 = it < (COUNT); if (!h1) it = it0; const TDesc db = DESC_EXPR_OF_IT; tr_load(db, vb, lane); \
        it = it0 + 2 * (STRIDE); const bool h2 = it < (COUNT); if (!h2) it = it0; const TDesc dc = DESC_EXPR_OF_IT; tr_load(dc, vc, lane); \
        it = it0 + 3 * (STRIDE); const bool h3 = it < (COUNT); if (!h3) it = it0; const TDesc dd = DESC_EXPR_OF_IT; tr_load(dd, vd, lane); \
        tr_store(da, va, scr, lane); if (h1) tr_store(db, vb, scr, lane); if (h2) tr_store(dc, vc, scr, lane); if (h3) tr_store(dd, vd, scr, lane); } } while (0)

constexpr int SSM_PARTS = 4, SSM_CH = 16 / SSM_PARTS;
__device__ __forceinline__ void ssm_tables(const Params& P, int l, int g, int r, LAS unsigned char* scr) {
    int tid_ = threadIdx.x; asm volatile("" : "+v"(tid_)); const int tid = tid_;
    LAS f32x2* pw = (LAS f32x2*)scr;
    LAS f32x2* Bb = pw + 33 * 64;
    LAS f32x2* Cc = Bb + 64 * 16;
    LAS float* Kd = (LAS float*)(Cc + SSM_CH * 64);
    LAS float* Dk = Kd + 32 * SSM_CH * 16;
    const int lg = l * SSG + g;
    const float dt = expf(P.in[13][lg]);
    const float* lre = P.in[11] + (size_t)lg * 64; const float* lim = P.in[12] + (size_t)lg * 64;
    for (int idx = tid; idx < 33 * 64; idx += 512) { const int d = idx >> 6, p = idx & 63;
        const float mag = expf(lre[p] * dt * (float)d);
        const double ang = (double)lim[p] * (double)dt * (double)d * 0.15915494309189535; const float fr = (float)(ang - floor(ang));
        pw[idx] = (f32x2){mag * __builtin_amdgcn_cosf(fr), mag * __builtin_amdgcn_sinf(fr)}; }
    if (tid < SSM_CH) Dk[tid] = P.in[18][(size_t)lg * 16 + SSM_CH * r + tid];
    if (tid < SSM_CH * 64) { const int i = SSM_CH * r + (tid >> 6), p = tid & 63; Cc[tid] = (f32x2){P.in[16][((size_t)lg * 16 + i) * 64 + p], P.in[17][((size_t)lg * 16 + i) * 64 + p]}; }
    __syncthreads();
    for (int idx = tid; idx < 1024; idx += 512) { const int p = idx >> 4, j = idx & 15;
        const float ar = pw[64 + p].x - 1.0f, ai = pw[64 + p].y, cr = lre[p], ci = lim[p], den = 1.0f / (cr * cr + ci * ci);
        const float qr = (ar * cr + ai * ci) * den, qi = (ai * cr - ar * ci) * den;
        const float br = P.in[14][((size_t)lg * 64 + p) * 16 + j], bi = P.in[15][((size_t)lg * 64 + p) * 16 + j];
        Bb[idx] = (f32x2){qr * br - qi * bi, qr * bi + qi * br}; }
    __syncthreads();
    for (int idx = tid; idx < 32 * SSM_CH * 16; idx += 512) { const int d = idx / (SSM_CH * 16), ii = (idx >> 4) % SSM_CH, j = idx & 15; float s = 0.f;
        for (int p = 0; p < 64; ++p) { const f32x2 c = Cc[ii * 64 + p], w = pw[d * 64 + p], bq = Bb[p * 16 + j];
            const float tr = c.x * w.x - c.y * w.y, ti = c.x * w.y + c.y * w.x; s += tr * bq.x - ti * bq.y; }
        Kd[idx] = s; }
    __syncthreads();
    bf16_t* tm = (bf16_t*)(P.ws + WS_TMAT) + (size_t)g * 512 * KIN;
    for (int v = tid; v < 32 * SSM_CH * (KIN / 8); v += 512) { const int nn = v / (KIN / 8), k0 = (v % (KIN / 8)) * 8, t = nn / SSM_CH, ii = nn % SSM_CH, i = SSM_CH * r + ii, n = t * 16 + i; float e[8];
#pragma unroll
        for (int q = 0; q < 8; ++q) { const int k = k0 + q; float val;
            if (k < 512) { const int s = k >> 4, j = k & 15; val = (s <= t) ? Kd[((t - s) * SSM_CH + ii) * 16 + j] + ((s == t && i == j) ? Dk[ii] : 0.f) : 0.f; }
            else { const int p = (k - 512) & 63; const f32x2 c = Cc[ii * 64 + p], w = pw[(t + 1) * 64 + p]; val = (k < 576) ? (c.x * w.x - c.y * w.y) : -(c.x * w.y + c.y * w.x); }
            e[q] = val; }
        *(u32x4*)(tm + (size_t)n * KIN + k0) = (u32x4){cvt_pk_bf16(e[0], e[1]), cvt_pk_bf16(e[2], e[3]), cvt_pk_bf16(e[4], e[5]), cvt_pk_bf16(e[6], e[7])}; }
    bf16_t* wst = (bf16_t*)(P.ws + WS_WST) + (size_t)g * 256 * 512;
    for (int v = tid; v < (256 / SSM_PARTS) * 64; v += 512) { const int n = (256 / SSM_PARTS) * r + (v >> 6), k0 = (v & 63) * 8; float e[8];
#pragma unroll
        for (int q = 0; q < 8; ++q) { const int k = k0 + q, s = k >> 4, j = k & 15, p = n & 63; float val = 0.f;
            if (n < 128) { const f32x2 w = pw[(31 - s) * 64 + p], bq = Bb[p * 16 + j]; val = (n < 64) ? (w.x * bq.x - w.y * bq.y) : (w.x * bq.y + w.y * bq.x); }
            e[q] = val; }
        *(u32x4*)(wst + (size_t)n * 512 + k0) = (u32x4){cvt_pk_bf16(e[0], e[1]), cvt_pk_bf16(e[2], e[3]), cvt_pk_bf16(e[4], e[5]), cvt_pk_bf16(e[6], e[7])}; }
    if (r == 0 && tid < 64) { const f32x2 w = pw[32 * 64 + tid]; float* lam = (float*)(P.ws + WS_LAM) + (size_t)(g * 64 + tid) * 2; lam[0] = w.x; lam[1] = w.y; }
    __syncthreads();
}

__device__ __forceinline__ void router_weights(const Params& P, int l, int gtid, int gthreads) {
    bf16_t* wr = (bf16_t*)(P.ws + WS_WMIX + (size_t)l * WMIX_LAYER + WM_R);
    for (int idx = gtid; idx < 48 * 1024; idx += gthreads) { const int n = idx >> 10, k = idx & 1023; float v = 0.f;
        if (n < 4) v = P.in[22][((size_t)l * 1024 + k) * 4 + n]; else if (n < 36) v = P.in[23][((size_t)l * 1024 + k) * 32 + (n - 4)];
        wr[idx] = (bf16_t)f2bf(v * P.in[21][l * 1024 + k]); }
}

__device__ __forceinline__ void ssm_scan_task(const Params& P, int w, int lane) {
    const float* sst = (const float*)(P.ws + WS_SST); bf16_t* inb = (bf16_t*)(P.ws + WS_IN); const float* lam = (const float*)(P.ws + WS_LAM);
    const int g = w >> 4, b = w & 15;
    const float lr = lam[(g * 64 + lane) * 2], li = lam[(g * 64 + lane) * 2 + 1];
    const size_t r0 = (size_t)g * 1024 + b * 64;
    float sr[NCH], si[NCH];
#pragma unroll
    for (int c = 0; c < NCH; ++c) { sr[c] = sst[(r0 + c) * 128 + lane]; si[c] = sst[(r0 + c) * 128 + 64 + lane]; }
    float xr = 0.f, xi = 0.f;
#pragma unroll
    for (int c = 0; c < NCH; ++c) {
        inb[(r0 + c) * KIN + 512 + lane] = (bf16_t)f2bf(xr); inb[(r0 + c) * KIN + 576 + lane] = (bf16_t)f2bf(xi);
        const float nr = lr * xr - li * xi + sr[c], ni = lr * xi + li * xr + si[c]; xr = nr; xi = ni; }
}

__device__ __forceinline__ void router_phase(const Params& P, int l, LAS unsigned char* lds, int G, int c) {
    int tid_ = threadIdx.x; asm volatile("" : "+v"(tid_));
    const int tid = tid_, wid = tid >> 6, lane = tid & 63;
    const bf16_t* xb = (const bf16_t*)(P.ws + WS_XB); const bf16_t* wr = (const bf16_t*)(P.ws + WS_WMIX + (size_t)l * WMIX_LAYER + WM_R);
    const float* ssx = (const float*)(P.ws + WS_SSX);
    int* te = (int*)(P.ws + WS_TE); float* tw = (float*)(P.ws + WS_TW); float* trs = (float*)(P.ws + WS_TRS); int* cnt = (int*)(P.ws + WS_CNT);
    LAS float* lg = (LAS float*)lds + wid * (16 * 48); LAS int* lcnt = (LAS int*)(lds + 8 * 16 * 48 * 4);
    constexpr int WRP = 2064; LAS unsigned char* wl = lds + 32768;
    for (int q = tid; q < 48 * 128; q += 512) { const int row = q >> 7, ch = q & 127; *(LAS u32x4*)(wl + row * WRP + ch * 16) = *(const u32x4*)(wr + (size_t)row * 1024 + ch * 8); }
    for (int blk = c; blk < MT / 128; blk += G) {
        if (tid < 64) lcnt[tid] = 0;
        __syncthreads();
        const int t0 = blk * 128 + wid * 16;
        f32x4 a0 = {0.f, 0.f, 0.f, 0.f}, a1 = a0, a2 = a0;
        const bf16_t* ap = xb + (size_t)(t0 + (lane & 15)) * 1024 + 8 * (lane >> 4);
        const LAS unsigned char* bl = wl + (lane & 15) * WRP + 16 * (lane >> 4);
        bf16x8 af[32];
#pragma unroll
        for (int kk = 0; kk < 32; ++kk) af[kk] = *(const bf16x8*)(ap + kk * 32);
#pragma unroll
        for (int kk = 0; kk < 32; ++kk) { const bf16x8 b0 = *(const LAS bf16x8*)(bl + kk * 64), b1 = *(const LAS bf16x8*)(bl + 16 * WRP + kk * 64), b2 = *(const LAS bf16x8*)(bl + 32 * WRP + kk * 64);
            a0 = __builtin_amdgcn_mfma_f32_16x16x32_bf16(af[kk], b0, a0, 0, 0, 0); a1 = __builtin_amdgcn_mfma_f32_16x16x32_bf16(af[kk], b1, a1, 0, 0, 0); a2 = __builtin_amdgcn_mfma_f32_16x16x32_bf16(af[kk], b2, a2, 0, 0, 0); }
#pragma unroll
        for (int r = 0; r < 4; ++r) { const int trow = (lane >> 4) * 4 + r, col = lane & 15; lg[trow * 48 + col] = a0[r]; lg[trow * 48 + 16 + col] = a1[r]; lg[trow * 48 + 32 + col] = a2[r]; }
        asm volatile("s_waitcnt lgkmcnt(0)" ::: "memory");
        if (lane < 16) { const int tok = t0 + lane; const f32x4* sp = (const f32x4*)(ssx + (size_t)tok * 16); const f32x4 s0 = sp[0], s1 = sp[1], s2 = sp[2], s3 = sp[3];
            const float s = (((s0[0] + s0[1]) + (s0[2] + s0[3])) + ((s1[0] + s1[1]) + (s1[2] + s1[3]))) + (((s2[0] + s2[1]) + (s2[2] + s2[3])) + ((s3[0] + s3[1]) + (s3[2] + s3[3])));
            const float rs = __builtin_amdgcn_rsqf(s * (1.0f / 1024.0f) + EPS);
            float gl[4]; int gi = 0; float gm;
#pragma unroll
            for (int q = 0; q < 4; ++q) gl[q] = lg[lane * 48 + q] * rs;
            gm = gl[0];
#pragma unroll
            for (int q = 1; q < 4; ++q) if (gl[q] > gm) { gm = gl[q]; gi = q; }
            float gs = 0.f;
#pragma unroll
            for (int q = 0; q < 4; ++q) gs += expf(gl[q] - gm);
            const float gwt = 1.0f / gs;
            float el[8];
#pragma unroll
            for (int q = 0; q < 8; ++q) el[q] = lg[lane * 48 + 4 + gi * 8 + q] * rs;
            int i0 = 0; float m0 = el[0];
#pragma unroll
            for (int q = 1; q < 8; ++q) if (el[q] > m0) { m0 = el[q]; i0 = q; }
            int i1 = -1; float m1 = -3.0e38f;
#pragma unroll
            for (int q = 0; q < 8; ++q) if (q != i0 && el[q] > m1) { m1 = el[q]; i1 = q; }
            const float e1 = expf(m1 - m0), w0 = gwt / (1.0f + e1), w1 = gwt * e1 / (1.0f + e1);
            const int e0i = gi * 8 + i0, e1i = gi * 8 + i1;
            te[tok * 2] = e0i; te[tok * 2 + 1] = e1i; tw[tok * 2] = w0; tw[tok * 2 + 1] = w1; trs[tok] = rs;
            atomicAdd((int*)&lcnt[e0i], 1); atomicAdd((int*)&lcnt[32 + e1i], 1); }
        __syncthreads();
        if (tid < 64) cnt[blk * 64 + tid] = lcnt[tid];
        __syncthreads();
    }
}

__device__ __forceinline__ void scatter_phase(const Params& P, LAS unsigned char* lds, int G, int c) {
    int tid_ = threadIdx.x; asm volatile("" : "+v"(tid_)); const int tid = tid_;
    const int* te = (const int*)(P.ws + WS_TE); const float* tw = (const float*)(P.ws + WS_TW); const float* trs = (const float*)(P.ws + WS_TRS); const int* cnt = (const int*)(P.ws + WS_CNT);
    int* atok = (int*)(P.ws + WS_ATOK); float* aw = (float*)(P.ws + WS_AW); float* ars = (float*)(P.ws + WS_ARS); int* tseg = (int*)(P.ws + WS_TSEG);
    LAS int* tot = (LAS int*)lds; LAS int* bef = tot + 64; LAS int* base = bef + 64; LAS int* le = base + 65; LAS int* ptot = le + 256; LAS int* pbef = ptot + 512;
    for (int blk = c; blk < MT / 128; blk += G) {
        { const int sg = tid & 63, part = tid >> 6; int t = 0, b = 0;
#pragma unroll 8
          for (int q = part * 32; q < part * 32 + 32; ++q) { const int v = cnt[q * 64 + sg]; t += v; b += (q < blk) ? v : 0; }
          ptot[part * 64 + sg] = t; pbef[part * 64 + sg] = b; }
        if (tid < 256) le[tid] = te[blk * 256 + tid];
        __syncthreads();
        if (tid < 64) { int t = 0, b = 0;
#pragma unroll
            for (int q = 0; q < 8; ++q) { t += ptot[q * 64 + tid]; b += pbef[q * 64 + tid]; }
            tot[tid] = t; bef[tid] = b; }
        __syncthreads();
        if (tid == 0) { int s = 0; for (int q = 0; q < 64; ++q) { base[q] = s; s += (tot[q] + 255) & ~255; } base[64] = s; }
        __syncthreads();
        if (tid < 256) {
            const int i = tid >> 1, k = tid & 1, sg = k * 32 + le[tid]; int rank = 0;
            for (int a = 0; a < tid; ++a) rank += ((a & 1) * 32 + le[a] == sg) ? 1 : 0;
            const int tok = blk * 128 + i, pos = base[sg] + bef[sg] + rank;
            atok[pos] = tok; aw[pos] = tw[tok * 2 + k]; ars[pos] = trs[tok]; }
        if (blk < 64) {
            int neg1 = -1; asm volatile("" : "+v"(neg1));
            for (int r = base[blk] + tot[blk] + tid; r < base[blk + 1]; r += 512) { atok[r] = neg1; aw[r] = 0.f; ars[r] = 0.f; }
            for (int t = (base[blk] >> 8) + tid; t < (base[blk + 1] >> 8); t += 512) tseg[t] = blk;
            if (blk == 0 && tid == 0) { tseg[512] = base[32] >> 8; tseg[513] = base[64] >> 8; } }
        __syncthreads();
    }
}
__constant__ double ROPE_INVF[16] = {1.0, 0.5623413251903491, 0.31622776601683794, 0.1778279410038923, 0.1, 0.05623413251903491, 0.03162277660168379, 0.01778279410038923, 0.01,
                                     0.005623413251903491, 0.0031622776601683794, 0.0017782794100389228, 0.001, 0.0005623413251903491, 0.00031622776601683794, 0.00017782794100389227};
constexpr int PH_PER_LAYER = 11, NPH = 1 + PH_PER_LAYER * DEPTH;

__global__ void __launch_bounds__(512, 2) mk_fwd(Params P_) {
    extern __shared__ __attribute__((aligned(16))) unsigned char lds_raw[];
    LAS unsigned char* lds = (LAS unsigned char*)lds_raw;
    const int G = gridDim.x;
#define WSFENCE const Params P = load_params(); unsigned char* ws = P.ws; int tid_f = threadIdx.x, c_f = blockIdx.x; asm volatile("" : "+v"(tid_f), "+s"(c_f)); \
    const int tid = tid_f, lane = tid & 63, wid = __builtin_amdgcn_readfirstlane(tid >> 6), c = c_f, gw = c * 8 + wid, ngw = G * 8; (void)ws; (void)tid; (void)lane; (void)wid; (void)gw; (void)ngw
    volatile LAS unsigned* MISC = (volatile LAS unsigned*)(lds + MISC_OFF);
    if (threadIdx.x < 64) MISC[threadIdx.x] = 0u;
    __syncthreads();
    XcdBarrier bar; bar.bar = (unsigned*)(P_.ws + WS_CTL); bar.x = 0; bar.st = nullptr;
    const bool multi = (P_.ph_hi - P_.ph_lo) > 1;
    if (multi) bar = xcd_barrier_post((unsigned*)(P_.ws + WS_CTL), MISC + 8);
    LAS int* idxlds = (LAS int*)(lds + IDX_OFF);
    const int lo = P_.ph_lo, hi = P_.ph_hi;
#ifndef PHMASK
#define PHMASK 0x7fff
#endif
#define IN(k) (lo <= (k) && (k) < hi)
#define EN(i) ((PHMASK >> (i)) & 1)
#ifndef REPMASK
#define REPMASK 0
#endif
#define REPS(i) (((REPMASK >> (i)) & 1) ? 2 : 1)
#define SEAM(k) do { if (IN(k) && IN((k) + 1)) xcd_barrier(bar); } while (0)

    if (EN(0) && IN(0)) { WSFENCE;
        LAS float* scr = (LAS float*)(lds + wid * 8448);
        if (!(P.variant & 128)) TR_LOOP(mixw_desc(P, it), gw, 2 * MIXW_ITEMS, ngw);
        router_weights(P, 0, c * 512 + tid, G * 512); router_weights(P, 1, c * 512 + tid, G * 512);
        {
            const int* pos = (const int*)P.in[1]; float* rope = (float*)(ws + WS_ROPE);
            for (int idx = c * 512 + tid; idx < MT * 16; idx += G * 512) { const int tok = idx >> 4, i = idx & 15;
                const double t = (double)pos[tok] * ROPE_INVF[i] * 0.15915494309189535; const float fr = (float)(t - floor(t));
                const float cs = __builtin_amdgcn_cosf(fr), sn = __builtin_amdgcn_sinf(fr); bf16_t* ropeb = (bf16_t*)(ws + WS_ROPEB);
                rope[(size_t)tok * 32 + i] = cs; rope[(size_t)tok * 32 + 16 + i] = sn; ropeb[(size_t)tok * 32 + i] = (bf16_t)f2bf(cs); ropeb[(size_t)tok * 32 + 16 + i] = (bf16_t)f2bf(sn); }
        }
        {
            const float* x = P.in[0]; bf16_t* xb = (bf16_t*)(ws + WS_XB); float* ssx = (float*)(ws + WS_SSX);
            if (!(P.variant & 256)) for (int m = gw; m < MT; m += ngw) { const f32x4* xr = (const f32x4*)(x + (size_t)m * DM) + lane; f32x4 v[4]; float s = 0.f;
#pragma unroll
                for (int j = 0; j < 4; ++j) { v[j] = __builtin_nontemporal_load(xr + 64 * j); s += (v[j][0] * v[j][0] + v[j][1] * v[j][1]) + (v[j][2] * v[j][2] + v[j][3] * v[j][3]); }
                s = wave_sum(s);
                u32x2* o = (u32x2*)(xb + (size_t)m * DM) + lane;
#pragma unroll
                for (int j = 0; j < 4; ++j) { u32x2 w; w.x = cvt_pk_bf16(v[j][0], v[j][1]); w.y = cvt_pk_bf16(v[j][2], v[j][3]); o[64 * j] = w; }
                if (lane < 16) ssx[(size_t)m * 16 + lane] = lane == 0 ? s : 0.f; }
        }
    }
    SEAM(0);

    for (int l = 0; l < DEPTH; ++l) {
        const int pb = 1 + PH_PER_LAYER * l;
        if (EN(1) && IN(pb + 0)) { WSFENCE;
            pg8::Gemm g{(const bf16_t*)(ws + WS_XB), (const bf16_t*)(ws + WS_WMIX + (size_t)l * WMIX_LAYER + WM_IN), 1024, 1024, (P.variant >> 4) & 1}; pg8::StaticOrder S; S.init(MT, NIN, G, c);
            { const int nu = (MT / 256) * (NIN / 256), nshort = G - nu % G, first = nu % G;
              if (nu % G == 0) { for (int t = c; t < SSG * SSM_PARTS; t += G) ssm_tables(P, l, t / SSM_PARTS, t % SSM_PARTS, lds); }
              else if (c >= first) { for (int t = c - first; t < SSG * SSM_PARTS; t += nshort) ssm_tables(P, l, t / SSM_PARTS, t % SSM_PARTS, lds); } }
            EpiIn E{ws};
            pg8::gemm_phase<EpiIn, pg8::StaticOrder>(lds, idxlds, g, S, E);
        }
        SEAM(pb + 0);
        if (EN(2) && IN(pb + 1)) { WSFENCE;
            { pg8::Gemm g{(const bf16_t*)(ws + WS_QC), (const bf16_t*)(ws + WS_WMIX + (size_t)l * WMIX_LAYER + WM_UQ), 384, 384, (P.variant >> 10) & 1}; pg8::StaticOrder S; S.init(MT, 768, G, c);
              EpiPlain E{ws, WS_TQ, 768}; pg8::gemm_phase<EpiPlain, pg8::StaticOrder>(lds, idxlds, g, S, E); }
            { pg8::Gemm g{(const bf16_t*)(ws + WS_KVC), (const bf16_t*)(ws + WS_WMIX + (size_t)l * WMIX_LAYER + WM_UKV), 256, 256, (P.variant >> 11) & 1}; pg8::StaticOrder S; S.init(MT, 1024, G, c);
              LAS float* gkl = (LAS float*)(lds + MISC_OFF + 256);
              if (tid < 96) gkl[tid] = P.in[9][l * 96 + tid];
              __syncthreads();
              EpiKV E{ws, gkl};
              pg8::gemm_phase<EpiKV, pg8::StaticOrder>(lds, idxlds, g, S, E); }
            { pg8::Gemm g{(const bf16_t*)(ws + WS_IN), (const bf16_t*)(ws + WS_WST), 512, KIN, (P.variant >> 12) & 1}; SsmSOrder S{G, c};
              EpiS E{ws}; pg8::gemm_phase<EpiS, SsmSOrder>(lds, idxlds, g, S, E); }
        }
        SEAM(pb + 1);
        if (EN(3) && IN(pb + 2)) { WSFENCE;
            if (wid < 2) for (int t = c * 2 + wid; t < SSG * NB; t += G * 2) ssm_scan_task(P, t, lane);
            const float* gk = P.in[9] + l * 96;
            float gmx = fmaxf(fabsf(gk[lane]), lane < 32 ? fabsf(gk[64 + lane]) : 0.f); gmx = wave_max(gmx);
            const float kbound = 9.797958971132712f * gmx;
            __syncthreads();
            for (int L = c; L < NB * NH * 8; L += G) { const int p = L & 127, k = L >> 7, b = p >> 3, h = p & 7;
                const int qb = (k == 0) ? 7 : (k == 1) ? 6 : (k == 2) ? 0 : (k == 3) ? 1 : (k == 4) ? 5 : (k == 5) ? 4 : (k == 6) ? 2 : 3;
                att::attn_unit((char*)lds_raw, b, h, qb, (const bf16_t*)(ws + WS_TQ), (const float*)(ws + WS_QSS), (const float*)(ws + WS_ROPE), P.in[8] + l * 96, kbound,
                               (const bf16_t*)(ws + WS_KB), (const bf16_t*)(ws + WS_VB), (bf16_t*)(ws + WS_OB), P.variant);
                __syncthreads(); }
        }
        SEAM(pb + 2);
        if (EN(4) && IN(pb + 3)) { WSFENCE;
            { pg8::Gemm g{(const bf16_t*)(ws + WS_IN), (const bf16_t*)(ws + WS_TMAT), KIN, KIN}; SsmYOrder S{G, c};
              EpiY E{ws}; pg8::gemm_phase<EpiY, SsmYOrder>(lds, idxlds, g, S, E); }
            { pg8::Gemm g{(const bf16_t*)(ws + WS_OB), (const bf16_t*)(ws + WS_WMIX + (size_t)l * WMIX_LAYER + WM_PROJ), 512, 512}; pg8::StaticOrder S; S.init(MT, 1024, G, c);
              EpiProj E{ws}; pg8::gemm_phase<EpiProj, pg8::StaticOrder>(lds, idxlds, g, S, E); }
        }
        SEAM(pb + 3);
        if (EN(5) && IN(pb + 4)) { WSFENCE;
            pg8::Gemm g{(const bf16_t*)(ws + WS_YB), (const bf16_t*)(ws + WS_WMIX + (size_t)l * WMIX_LAYER + WM_GLU), 512, 512, (P.variant >> 4) & 1}; pg8::StaticOrder S; S.init(MT, 2048, G, c);
            EpiGlu E{ws}; pg8::gemm_phase<EpiGlu, pg8::StaticOrder>(lds, idxlds, g, S, E);
        }
        SEAM(pb + 4);
        if (EN(6) && IN(pb + 5)) { WSFENCE;
            pg8::Gemm g{(const bf16_t*)(ws + WS_MG), (const bf16_t*)(ws + WS_WMIX + (size_t)l * WMIX_LAYER + WM_OUT), 1024, 1024}; pg8::StaticOrder S; S.init(MT, 1024, G, c);
            EpiOut E{ws}; pg8::gemm_phase<EpiOut, pg8::StaticOrder>(lds, idxlds, g, S, E);
        }
        SEAM(pb + 5);
        if (EN(7) && IN(pb + 6)) { WSFENCE;
            if (!(P.variant & 64)) router_phase(P, l, lds, G, c);
            LAS float* scr = (LAS float*)(lds + 32768 + wid * 8448);
            if (!(P.variant & 32)) TR_LOOP(expw_desc(P, l, it), gw, EXPW_ITEMS, ngw);
        }
        SEAM(pb + 6);
        if (EN(8) && IN(pb + 7)) { WSFENCE; scatter_phase(P, lds, G, c); }
        SEAM(pb + 7);
        if (EN(9) && IN(pb + 8)) { WSFENCE;
            const int* tseg = (const int*)(ws + WS_TSEG); const int ntT = tseg[513];
            pg8::Gemm g{(const bf16_t*)(ws + WS_XB), (const bf16_t*)(ws + WS_WGU), 1024, 1024};
            MoeGatherOrder S; S.tseg = tseg; S.tile0 = 0; S.ntile = ntT; S.NC = 2; S.G = G; S.c = c; S.gidx = (const int*)(ws + WS_ATOK); S.lmax = 2 * G;
            EpiGU E{ws}; pg8::gemm_phase<EpiGU, MoeGatherOrder>(lds, idxlds, g, S, E);
        }
        SEAM(pb + 8);
        if (EN(10) && IN(pb + 9)) { WSFENCE;
            const int* tseg = (const int*)(ws + WS_TSEG); const int ntA = tseg[512], ntT = tseg[513];
            const int nleft = (2 * ntT > 2 * G) ? 2 * ntT - 2 * G : 0;
            if (nleft > 0) { pg8::Gemm g{(const bf16_t*)(ws + WS_XB), (const bf16_t*)(ws + WS_WGU), 1024, 1024};
                MoeGatherOrder S; S.tseg = tseg; S.tile0 = 0; S.ntile = ntT; S.NC = 2; S.G = G; S.c = c; S.gidx = (const int*)(ws + WS_ATOK); S.loff = 2 * G;
                EpiGU E{ws}; pg8::gemm_phase<EpiGU, MoeGatherOrder>(lds, idxlds, g, S, E); }
            pg8::Gemm g{(const bf16_t*)(ws + WS_HH), (const bf16_t*)(ws + WS_WD), 256, 256};
            MoeDownAOrder S; S.tseg = tseg; S.tile0 = 0; S.ntile = ntA; S.NC = 4; S.G = G; S.c = c; S.nbusy = nleft < G ? nleft : G - 1;
            EpiDown<false> E{ws, nullptr}; pg8::gemm_phase<EpiDown<false>, MoeDownAOrder>(lds, idxlds, g, S, E);
        }
        SEAM(pb + 9);
        if (EN(11) && IN(pb + 10)) { WSFENCE;
            const int* tseg = (const int*)(ws + WS_TSEG); const int ntA = tseg[512], ntT = tseg[513];
            pg8::Gemm g{(const bf16_t*)(ws + WS_HH), (const bf16_t*)(ws + WS_WD), 256, 256, (P.variant >> 13) & 1};
            MoeOrder S; S.tseg = tseg; S.tile0 = ntA; S.ntile = ntT - ntA; S.NC = 4; S.G = G; S.c = c;
            EpiDown<true> E{ws, l + 1 == DEPTH ? P.out : nullptr}; pg8::gemm_phase<EpiDown<true>, MoeOrder>(lds, idxlds, g, S, E);
        }
        SEAM(pb + 10);
    }
#undef IN
#undef SEAM
}

#ifndef MK_PER_PHASE
#define MK_PER_PHASE 0
#endif
extern "C" void kernel_launch(void* const* d_in, const int* in_sizes, int n_in, void* d_out, int out_size, void* d_ws, size_t ws_size, hipStream_t stream) {
    static int grid = 0;
    if (grid == 0) {
        if (n_in != 27 || in_sizes[0] != MT * DM || out_size != MT * DM || ws_size < WS_END) {
            fprintf(stderr, "kernel_launch: unexpected shapes: n_in %d in0 %d out %d ws %zu (need %zu)\n", n_in, n_in > 0 ? in_sizes[0] : -1, out_size, ws_size, (size_t)WS_END); grid = -1; return; }
        int dev = 0, cus = 0, per_cu = 0;
        if (hipGetDevice(&dev) != hipSuccess || hipDeviceGetAttribute(&cus, hipDeviceAttributeMultiprocessorCount, dev) != hipSuccess) { grid = -1; return; }
        if (hipFuncSetAttribute((const void*)mk_fwd, hipFuncAttributeMaxDynamicSharedMemorySize, LDS_BYTES) != hipSuccess) { fprintf(stderr, "kernel_launch: hipFuncSetAttribute failed\n"); grid = -1; return; }
        if (hipOccupancyMaxActiveBlocksPerMultiprocessor(&per_cu, (const void*)mk_fwd, 512, LDS_BYTES) != hipSuccess || per_cu < 1)
            fprintf(stderr, "kernel_launch: occupancy query reports %d workgroups per CU\n", per_cu);
        (void)hipGetLastError();
        grid = cus;
    }
    if (grid < 0) return;
    if (hipMemsetAsync((char*)d_ws + WS_CTL, 0, CTL_ZERO_BYTES, stream) != hipSuccess) return;
    Params p{};
    for (int i = 0; i < 27; ++i) p.in[i] = (const float*)d_in[i];
    p.out = (float*)d_out; p.ws = (unsigned char*)d_ws;
#if MK_PER_PHASE
    for (int ph = 0; ph < NPH; ++ph) { p.ph_lo = ph; p.ph_hi = ph + 1; hipLaunchKernelGGL(mk_fwd, dim3(grid), dim3(512), LDS_BYTES, stream, p); }
#else
    p.ph_lo = 0; p.ph_hi = NPH; hipLaunchKernelGGL(mk_fwd, dim3(grid), dim3(512), LDS_BYTES, stream, p);
#endif
#ifdef PROBE_PHASES
    p.out = (float*)((unsigned char*)d_ws + WS_S5G);
#ifdef PROBE_VARIANT
    p.variant = PROBE_VARIANT;
#endif
    for (int l = 0; l < DEPTH; ++l) for (int k = 0; k < PH_PER_LAYER; ++k) if ((PROBE_PHASES >> k) & 1) { p.ph_lo = 1 + PH_PER_LAYER * l + k; p.ph_hi = p.ph_lo + 1; hipLaunchKernelGGL(mk_fwd, dim3(grid), dim3(512), LDS_BYTES, stream, p); }
    if ((PROBE_PHASES >> 14) & 1) { p.ph_lo = 0; p.ph_hi = 1; hipLaunchKernelGGL(mk_fwd, dim3(grid), dim3(512), LDS_BYTES, stream, p); }
#endif
    const hipError_t le = hipPeekAtLastError();
    if (le != hipSuccess) fprintf(stderr, "kernel_launch: launch failed: %s\n", hipGetErrorName(le));
}
```

```cpp
#include <hip/hip_runtime.h>
#include <cstdio>
#include <cstdint>

#define GAS __attribute__((address_space(1)))
#define LAS __attribute__((address_space(3)))
typedef unsigned short bf16_t;
typedef short bf16x8 __attribute__((ext_vector_type(8)));
typedef short s16x4 __attribute__((ext_vector_type(4)));
typedef float f32x4 __attribute__((ext_vector_type(4)));
typedef float f32x2 __attribute__((ext_vector_type(2)));
typedef float f32x16 __attribute__((ext_vector_type(16)));
typedef unsigned u32x4 __attribute__((ext_vector_type(4)));
typedef unsigned u32x2 __attribute__((ext_vector_type(2)));

constexpr int NB = 16, SEQ = 2048, DM = 1024, MT = NB * SEQ, DEPTH = 2;
constexpr int NH = 8, DQK = 96, DV = 64, QL = 384, KVL = 256, DR = 32;
constexpr int SSW = 512, SSG = 32, SSP = 64;
constexpr int LC = 32, NCH = SEQ / LC, KIN = LC * 16 + 128;
constexpr int NIN = 3328;
constexpr int NE = 32, DE = 256;
constexpr float EPS = 1e-6f;
constexpr int MAXTILES = 320, MAXROWS = MAXTILES * 256;

__device__ __forceinline__ unsigned f2bf(float f) { unsigned u = __builtin_bit_cast(unsigned, f); return (u + 0x7fffu + ((u >> 16) & 1u)) >> 16; }
__device__ __forceinline__ unsigned pk2(float lo, float hi) { return f2bf(lo) | (f2bf(hi) << 16); }
__device__ __forceinline__ float bf2f(unsigned short h) { return __builtin_bit_cast(float, (unsigned)h << 16); }
__device__ __forceinline__ float bflo(unsigned w) { return __builtin_bit_cast(float, w << 16); }
__device__ __forceinline__ float bfhi(unsigned w) { return __builtin_bit_cast(float, w & 0xffff0000u); }
__device__ __forceinline__ unsigned cvt_pk_bf16(float lo, float hi) { unsigned r; asm volatile("v_cvt_pk_bf16_f32 %0, %1, %2" : "=v"(r) : "v"(lo), "v"(hi)); return r; }
__device__ __forceinline__ float fast_sigmoid(float v) { return __builtin_amdgcn_rcpf(1.0f + __builtin_amdgcn_exp2f(-1.4426950408889634f * v)); }


__device__ __forceinline__ void swap16(float v, float& a, float& b) { const unsigned u = __builtin_bit_cast(unsigned, v); auto r = __builtin_amdgcn_permlane16_swap(u, u, false, false); const unsigned x = r[0], y = r[1]; a = __builtin_bit_cast(float, x); b = __builtin_bit_cast(float, y); }
__device__ __forceinline__ void swap32(float v, float& a, float& b) { const unsigned u = __builtin_bit_cast(unsigned, v); auto r = __builtin_amdgcn_permlane32_swap(u, u, false, false); const unsigned x = r[0], y = r[1]; a = __builtin_bit_cast(float, x); b = __builtin_bit_cast(float, y); }
__device__ __forceinline__ float sum_x16(float v) { float a, b; swap16(v, a, b); return a + b; }
__device__ __forceinline__ float sum_x32(float v) { float a, b; swap32(v, a, b); return a + b; }
__device__ __forceinline__ float max_x16(float v) { float a, b; swap16(v, a, b); return fmaxf(a, b); }
__device__ __forceinline__ float max_x32(float v) { float a, b; swap32(v, a, b); return fmaxf(a, b); }
__device__ __forceinline__ float from_x32(float v, int lane_hi) { float a, b; swap32(v, a, b); return lane_hi ? a : b; }
template <int CTRL> __device__ __forceinline__ float dpp_f(float v) { const int u = __builtin_bit_cast(int, v); return __builtin_bit_cast(float, __builtin_amdgcn_update_dpp(u, u, CTRL, 0xf, 0xf, false)); }
__device__ __forceinline__ float row_sum16(float v) { v += dpp_f<0xB1>(v); v += dpp_f<0x4E>(v); v += dpp_f<0x124>(v); v += dpp_f<0x128>(v); return v; }
__device__ __forceinline__ float row_max16(float v) { v = fmaxf(v, dpp_f<0xB1>(v)); v = fmaxf(v, dpp_f<0x4E>(v)); v = fmaxf(v, dpp_f<0x124>(v)); v = fmaxf(v, dpp_f<0x128>(v)); return v; }

namespace pg8 {
constexpr int BM = 256, BK = 64, HALF = 128, HTB = HALF * BK * 2, STAGE_BYTES = 8 * HTB, NXCD = 8, WGM = 8;
__host__ __device__ __forceinline__ int lds_byte(int r, int c) { const int st = (r >> 4) * 2 + (c >> 5), rr = r & 15, cc = c & 31, ob = rr * 64 + cc * 2; return st * 1024 + (ob ^ (((ob >> 9) & 1) << 5)); }
__host__ __device__ __forceinline__ void stage_rc(int b, int& R, int& C) { const int st = b / 1024, sb = b % 1024, swz = sb ^ (((sb >> 9) & 1) << 5); R = (st >> 1) * 16 + swz / 64; C = (st & 1) * 32 + (swz % 64) / 2; }
__host__ __device__ __forceinline__ int perm32(int rho) { const int n = rho >> 4, i = rho & 15; return 8 * (i >> 2) + 4 * n + (i & 3); }

struct Unit { int pm, pn; };
struct Gemm { const bf16_t* A; const bf16_t* Bt; int K; int lda; int flags = 0; };

struct StaticOrder {
    static constexpr bool GATHER = false;
    int nM, nN, nwg, G, c;
    __device__ void init(int M, int N, int G_, int c_) { nM = M / BM; nN = N / BM; nwg = nM * nN; G = G_; c = c_; }
    __device__ bool next(int i, Unit& u) const {
        const long L = (long)i * G + c; if (L >= nwg) return false;
        int wgid = (int)L; { const int q = nwg / NXCD, r = nwg % NXCD, xcd = wgid % NXCD, off = wgid / NXCD; wgid = (xcd < r ? xcd * (q + 1) : r * (q + 1) + (xcd - r) * q) + off; }
        const int nig = WGM * nN, gid = wgid / nig, fm = gid * WGM, gsz = (nM - fm) < WGM ? (nM - fm) : WGM;
        u.pm = fm + ((wgid % nig) % gsz); u.pn = (wgid % nig) / gsz; return true;
    }
};

#ifdef PROBE_NOEPI
#define PG8_PROBE_SKIP && (*(const int __attribute__((address_space(4)))*)((const char __attribute__((address_space(4)))*)__builtin_amdgcn_kernarg_segment_ptr() + 232) == 0)
#else
#define PG8_PROBE_SKIP
#endif
template <class Epi, class Sched>
__device__ __forceinline__ void gemm_phase(LAS unsigned char* lds, LAS int* idxlds, const Gemm g, const Sched& S, const Epi& E) {
    int tid_ = threadIdx.x; asm volatile("" : "+v"(tid_));
    const int tid = tid_, wid = __builtin_amdgcn_readfirstlane(tid >> 6), lane = tid & 63, wr = wid >> 2, wc = wid & 3, fr = lane & 15, fq = lane >> 4;
    const int K = g.K, nt = K / BK, lda = g.lda;
    unsigned voffB[2], vA[2][2], vAn[2][2];
#pragma unroll
    for (int i = 0; i < 2; ++i) { int R, C; stage_rc(tid * 16 + i * 8192, R, C);
        const int Rb = Epi::PERM ? (64 * (R >> 5) + perm32(R & 31)) : R; voffB[i] = (unsigned)(Rb * K + C) * 2u;
        vA[0][i] = (unsigned)(R * lda + C) * 2u; vA[1][i] = vA[0][i]; vAn[0][i] = vA[0][i]; vAn[1][i] = vA[0][i]; }
    const unsigned kstep = (unsigned)(BK * 2);
    const unsigned hstepB = (unsigned)(Epi::PERM ? 32 : HALF) * K * 2, tstepB = (unsigned)(2 * HALF) * K * 2;
    const unsigned hstepA = Sched::GATHER ? 0u : (unsigned)HALF * lda * 2, tstepA = Sched::GATHER ? 0u : (unsigned)BM * lda * 2;
    const unsigned ldsw = (unsigned)wid * 1024u;
    const int aoff = lds_byte(wr * 64 + fr, fq * 8), boff = lds_byte(wc * 32 + fr, fq * 8);
#define PG8_SA(b, h) (((b) * 2 + (h)) * HTB)
#define PG8_SB(b, h) ((4 + (b) * 2 + (h)) * HTB)
#define PG8_STAGE(bufoff, gbase, voff) do { const char* gb_ = (const char*)(gbase); asm volatile("" : "+s"(gb_));   \
        _Pragma("unroll") for (int _i = 0; _i < 2; ++_i) \
        __builtin_amdgcn_global_load_lds((const unsigned*)(gb_ + (voff)[_i]), (LAS unsigned*)(lds + (bufoff) + ldsw + _i * 8192), 16, 0, 0); } while (0)
#define PG8_STAGE_A(bufoff, gbase, h, NXT) do { if constexpr (Sched::GATHER) { if (NXT) PG8_STAGE(bufoff, gbase, vAn[h]); else PG8_STAGE(bufoff, gbase, vA[h]); } \
        else PG8_STAGE(bufoff, (gbase) + (h) * hstepA, vA[0]); } while (0)
#define PG8_LDA(dst, b, h) do { _Pragma("unroll") for (int m = 0; m < 4; ++m) _Pragma("unroll") for (int k = 0; k < 2; ++k) dst[m][k] = *(const LAS bf16x8*)(lds + PG8_SA(b, h) + aoff + m * 2048 + k * 1024); } while (0)
#define PG8_LDB(dst, b, h) do { _Pragma("unroll") for (int n = 0; n < 2; ++n) _Pragma("unroll") for (int k = 0; k < 2; ++k) dst[n][k] = *(const LAS bf16x8*)(lds + PG8_SB(b, h) + boff + n * 2048 + k * 1024); } while (0)
#define PG8_MMA(ai, bj, At, Bt) do { __builtin_amdgcn_s_setprio(1); _Pragma("unroll") for (int m = 0; m < 4; ++m) _Pragma("unroll") for (int n = 0; n < 2; ++n) _Pragma("unroll") for (int k = 0; k < 2; ++k) \
        acc[ai][bj][m][n] = __builtin_amdgcn_mfma_f32_16x16x32_bf16(Bt[n][k], At[m][k], acc[ai][bj][m][n], 0, 0, 0); __builtin_amdgcn_s_setprio(0); } while (0)
#define PG8_WAIT_V(n) asm volatile("s_waitcnt vmcnt(" #n ")" ::: "memory")
#define PG8_WAIT_L(n) asm volatile("s_waitcnt lgkmcnt(" #n ")" ::: "memory")
#define PG8_BAR __builtin_amdgcn_s_barrier()
#define PG8_SCHED __builtin_amdgcn_sched_barrier(0)
#define PG8_GOFF(dst, ui_) do { _Pragma("unroll") for (int _i = 0; _i < 2; ++_i) { int _R, _C; stage_rc(tid * 16 + _i * 8192, _R, _C); _Pragma("unroll") for (int _h = 0; _h < 2; ++_h) \
        dst[_h][_i] = (unsigned)(idxlds[(ui_) * 256 + _h * 128 + _R] * lda + _C) * 2u; } } while (0)
    Unit cur, nxt; int ui = 0;
    if (!S.next(0, cur)) return;
    if constexpr (Sched::GATHER) {
        for (int i = 0; i < 4; ++i) { Unit u; if (!S.next(i, u)) break; if (tid < 256) { const int t = S.gidx[u.pm * 256 + tid]; idxlds[i * 256 + tid] = t < 0 ? 0 : t; } }
        asm volatile("s_waitcnt vmcnt(0) lgkmcnt(0)" ::: "memory"); __builtin_amdgcn_s_barrier(); asm volatile("" ::: "memory");
        PG8_GOFF(vA, 0);
    }
    f32x4 acc[2][2][4][2];
#pragma unroll
    for (int a = 0; a < 2; ++a)
#pragma unroll
        for (int b = 0; b < 2; ++b)
#pragma unroll
            for (int m = 0; m < 4; ++m)
#pragma unroll
                for (int n = 0; n < 2; ++n) acc[a][b][m][n] = (f32x4){0.f, 0.f, 0.f, 0.f};
    bf16x8 At[4][2], B0[2][2], B1[2][2];
    const char* cA = (const char*)g.A + (size_t)cur.pm * (size_t)tstepA; const char* cB = (const char*)g.Bt + (size_t)cur.pn * (size_t)tstepB;
    PG8_STAGE(PG8_SB(0, 0), cB, voffB); PG8_STAGE(PG8_SB(0, 1), cB + hstepB, voffB); PG8_STAGE_A(PG8_SA(0, 0), cA, 0, false); PG8_STAGE_A(PG8_SA(0, 1), cA, 1, false);
    if (wr == 1) PG8_BAR;
    PG8_WAIT_V(2); PG8_BAR;
    PG8_STAGE(PG8_SB(1, 0), cB + kstep, voffB); PG8_STAGE_A(PG8_SA(1, 0), cA + kstep, 0, false); PG8_STAGE(PG8_SB(1, 1), cB + hstepB + kstep, voffB);
    PG8_WAIT_V(6); PG8_BAR;
    for (;;) {
        const bool has_next = S.next(ui + 1, nxt);
                const char* nA = has_next ? (const char*)g.A + (size_t)nxt.pm * (size_t)tstepA : cA; const char* nB = has_next ? (const char*)g.Bt + (size_t)nxt.pn * (size_t)tstepB : cB;

        for (int t = 0; t < nt; t += 2) {
            const bool last = (t == nt - 2);
            const char* a1 = cA + (size_t)(t + 1) * kstep;
            const char* a2 = last ? nA : cA + (size_t)(t + 2) * kstep; const char* b2 = last ? nB : cB + (size_t)(t + 2) * kstep;
            const char* a3 = a2 + kstep; const char* b3 = b2 + kstep;
            if constexpr (Sched::GATHER) { if (last) { if (has_next) PG8_GOFF(vAn, ui + 1); else {
#pragma unroll
                for (int h = 0; h < 2; ++h) { vAn[h][0] = vA[h][0]; vAn[h][1] = vA[h][1]; } } } }
            PG8_LDB(B0, 0, 0); PG8_LDB(B1, 0, 1); PG8_SCHED; PG8_LDA(At, 0, 0); PG8_STAGE_A(PG8_SA(1, 1), a1, 1, false);
            PG8_WAIT_V(8); PG8_WAIT_L(0); PG8_BAR; PG8_MMA(0, 0, At, B0); PG8_MMA(0, 1, At, B1); PG8_BAR; PG8_SCHED;
            PG8_LDA(At, 0, 1); PG8_STAGE(PG8_SB(0, 0), b2, voffB); PG8_STAGE(PG8_SB(0, 1), b2 + hstepB, voffB); PG8_STAGE_A(PG8_SA(0, 0), a2, 0, last);
            PG8_WAIT_V(8); PG8_WAIT_L(0); PG8_BAR; PG8_MMA(1, 0, At, B0); PG8_MMA(1, 1, At, B1); PG8_BAR; PG8_SCHED;
            PG8_LDB(B0, 1, 0); PG8_LDB(B1, 1, 1); PG8_SCHED; PG8_LDA(At, 1, 0); PG8_STAGE_A(PG8_SA(0, 1), a2, 1, last);
            PG8_WAIT_V(8); PG8_WAIT_L(0); PG8_BAR; PG8_MMA(0, 0, At, B0); PG8_MMA(0, 1, At, B1); PG8_BAR; PG8_SCHED;
            PG8_LDA(At, 1, 1); PG8_STAGE(PG8_SB(1, 0), b3, voffB); PG8_STAGE(PG8_SB(1, 1), b3 + hstepB, voffB); PG8_STAGE_A(PG8_SA(1, 0), a3, 0, last);
            PG8_WAIT_V(8); PG8_WAIT_L(0); PG8_BAR; PG8_MMA(1, 0, At, B0); PG8_MMA(1, 1, At, B1); PG8_BAR; PG8_SCHED;
        }
        if (wr == 0) PG8_BAR;
        if (!(g.flags & 1) PG8_PROBE_SKIP) { int te = threadIdx.x; asm volatile("" : "+v"(te)); const int le = te & 63; E(acc, cur, wr, wc, le & 15, le >> 4); }
        if (!has_next) break;
#pragma unroll
        for (int a = 0; a < 2; ++a)
#pragma unroll
            for (int b = 0; b < 2; ++b)
#pragma unroll
                for (int m = 0; m < 4; ++m)
#pragma unroll
                    for (int n = 0; n < 2; ++n) acc[a][b][m][n] = (f32x4){0.f, 0.f, 0.f, 0.f};
        cur = nxt; cA = nA; cB = nB; ++ui;
        if constexpr (Sched::GATHER) {
#pragma unroll
            for (int h = 0; h < 2; ++h) { vA[h][0] = vAn[h][0]; vA[h][1] = vAn[h][1]; } }
        if (wr == 1) PG8_BAR;
    }
    PG8_WAIT_V(0);
    PG8_BAR;
#undef PG8_SA
#undef PG8_SB
#undef PG8_STAGE
#undef PG8_STAGE_A
#undef PG8_LDA
#undef PG8_LDB
#undef PG8_MMA
#undef PG8_WAIT_V
#undef PG8_WAIT_L
#undef PG8_BAR
#undef PG8_SCHED
#undef PG8_GOFF
}
}

#define XB_TMO      128
#define XB_XCNT(j)  (256  + 64 * (j))
#define XB_XSUB(j)  (1280 + 64 * (j))
#define XB_XGEN(j)  (2304 + 64 * (j))
#define XB_TOP      3328
#define XB_TOPGEN   3392
#define XCD_BAR_WORDS 3456
#define XB_SPIN_CAP (1u << 18)
__device__ __forceinline__ unsigned xb_ld(unsigned* p)              { return __hip_atomic_load(p, __ATOMIC_RELAXED, __HIP_MEMORY_SCOPE_AGENT); }
__device__ __forceinline__ unsigned xb_add(unsigned* p, unsigned v) { return __hip_atomic_fetch_add(p, v, __ATOMIC_RELAXED, __HIP_MEMORY_SCOPE_AGENT); }
__device__ __forceinline__ unsigned xb_xcc_id() { return (unsigned)__builtin_amdgcn_s_getreg((3 << 11) | 20) & 0xFu; }
#define XB_SPIN(cond, bar) do { unsigned _sp = 0; while (cond) { __builtin_amdgcn_s_sleep(1); \
    if ((++_sp & 255u) == 0u) { if (xb_ld(&(bar)[XB_TMO])) break; if (_sp > XB_SPIN_CAP) { atomicAdd(&(bar)[XB_TMO], 1u); break; } } } } while (0)
struct XcdBarrier { unsigned* bar; unsigned x; volatile LAS unsigned* st; };
__device__ __forceinline__ XcdBarrier xcd_barrier_post(unsigned* bar, volatile LAS unsigned* st) {
    XcdBarrier b; b.bar = bar; b.x = xb_xcc_id(); b.st = st;
    if (threadIdx.x == 0) (void)xb_add(&bar[XB_XCNT(b.x)], 1u);
    return b;
}
__device__ __forceinline__ void xcd_barrier_complete(unsigned* bar, unsigned x, unsigned& nloc, unsigned& nx) {
    const unsigned G = gridDim.x * gridDim.y * gridDim.z;
    unsigned sum, cnt, mine, sp = 0u;
    for (;;) {
        sum = 0u; cnt = 0u; mine = 0u;
#pragma unroll
        for (unsigned j = 0; j < 16; ++j) { const unsigned c = xb_ld(&bar[XB_XCNT(j)]); sum += c; cnt += (c > 0u) ? 1u : 0u; mine = (j == x) ? c : mine; }
        if (sum == G) break;
        __builtin_amdgcn_s_sleep(1);
        if ((++sp & 255u) == 0u) { if (xb_ld(&bar[XB_TMO])) break; if (sp > XB_SPIN_CAP) { atomicAdd(&bar[XB_TMO], 1u); break; } }
    }
    nloc = mine > 0u ? mine : 1u; nx = cnt > 0u ? cnt : 1u;
}
template <bool LOCAL = false> __device__ __forceinline__ void xcd_barrier(const XcdBarrier& b) {
    asm volatile("s_waitcnt vmcnt(0)" ::: "memory");
    __syncthreads();
    if (threadIdx.x == 0) {
        unsigned* bar = b.bar; unsigned bx = b.x;
        asm volatile("" : "+s"(bar), "+s"(bx));
        __builtin_amdgcn_s_waitcnt(0);
        unsigned nloc = b.st[0], nx = b.st[1];
        if (nloc == 0u) { xcd_barrier_complete(bar, bx, nloc, nx); b.st[0] = nloc; b.st[1] = nx; }
        const unsigned old = xb_add(&bar[XB_XSUB(bx)], 1u);
        const unsigned gen = old / nloc;
        if (old + 1u == (gen + 1u) * nloc) {
            if constexpr (!LOCAL) {
            __builtin_amdgcn_fence(__ATOMIC_RELEASE, "agent");
            asm volatile("s_waitcnt vmcnt(0)" ::: "memory");
            const unsigned og = xb_add(&bar[XB_TOP], 1u);
            const unsigned tg = og / nx;
            if (og + 1u == (tg + 1u) * nx) xb_add(&bar[XB_TOPGEN], 1u);
            else XB_SPIN(xb_ld(&bar[XB_TOPGEN]) == tg, bar);
            }
            __builtin_amdgcn_fence(__ATOMIC_ACQUIRE, "agent");
            xb_add(&bar[XB_XGEN(bx)], 1u);
            asm volatile("s_waitcnt vmcnt(0)" ::: "memory");
        } else {
            XB_SPIN(xb_ld(&bar[XB_XGEN(bx)]) == gen, bar);
            __builtin_amdgcn_fence(__ATOMIC_ACQUIRE, "agent");
            asm volatile("s_waitcnt vmcnt(0)" ::: "memory");
        }
    }
    __syncthreads();
}
constexpr size_t MiB = 1u << 20;
constexpr size_t WS_CTL = 0, CTL_ZERO_BYTES = 64 * 1024;
constexpr size_t WS_SSX  = 1 * MiB;
constexpr size_t WS_KVSS = 3 * MiB;
constexpr size_t WS_QSS  = WS_KVSS + 512 * 1024;
constexpr size_t WS_KRSS = WS_QSS + 1 * MiB;
constexpr size_t WS_TE   = WS_KRSS + 128 * 1024;
constexpr size_t WS_TW   = WS_TE + 256 * 1024;
constexpr size_t WS_TRS  = WS_TW + 256 * 1024;
constexpr size_t WS_CNT  = WS_TRS + 128 * 1024;
constexpr size_t WS_ATOK = WS_CNT + 64 * 1024;
constexpr size_t WS_AW   = WS_ATOK + 320 * 1024;
constexpr size_t WS_ARS  = WS_AW + 320 * 1024;
constexpr size_t WS_TSEG = WS_ARS + 320 * 1024;
constexpr size_t WS_LAM  = WS_TSEG + 4096;
constexpr size_t WS_ROPE = 8 * MiB;
constexpr size_t WS_ROPEB = 12 * MiB;
constexpr size_t WS_WMIX = 16 * MiB, WMIX_LAYER = 13 * MiB;
constexpr size_t WM_IN = 0, WM_UQ = WM_IN + (size_t)NIN * 1024 * 2, WM_UKV = WM_UQ + 768 * 384 * 2, WM_PROJ = WM_UKV + 1024 * 256 * 2, WM_GLU = WM_PROJ + 1024 * 512 * 2,
                 WM_OUT = WM_GLU + 2048 * 512 * 2, WM_R = WM_OUT + 1024 * 1024 * 2, WM_END = WM_R + 48 * 1024 * 2;
static_assert(WM_END <= WMIX_LAYER, "mixer weights");
constexpr size_t WS_TMAT = 42 * MiB;
constexpr size_t WS_WST  = 62 * MiB;
constexpr size_t WS_XB   = 70 * MiB;
constexpr size_t WS_IN   = 134 * MiB;
constexpr size_t WS_OB   = 478 * MiB;
constexpr size_t WS_YB   = 206 * MiB;
constexpr size_t WS_SST  = 222 * MiB;
constexpr size_t WS_KVC  = 174 * MiB, WS_QC = 190 * MiB, WS_KR = 214 * MiB;
constexpr size_t WS_HH   = 174 * MiB;
constexpr size_t WS_TQ   = 238 * MiB, WS_KB = 286 * MiB, WS_VB = 334 * MiB;
constexpr size_t WS_S5G  = 238 * MiB, WS_MG = 302 * MiB;
constexpr size_t WS_GT   = 366 * MiB;
constexpr size_t WS_WGU  = 430 * MiB, WS_WD = 462 * MiB;
constexpr size_t WS_END  = 510 * MiB;

constexpr int RING_BYTES = 131072, IDX_OFF = RING_BYTES, MISC_OFF = IDX_OFF + 4096, LDS_BYTES = 147456;
static_assert(MISC_OFF + 256 <= LDS_BYTES, "LDS map");

struct Params {
    const float* in[27];
    float* out; unsigned char* ws;
    int ph_lo, ph_hi, variant, pad_;
};
__device__ __forceinline__ Params load_params() {
    typedef const __attribute__((address_space(4))) Params* KP;
    KP ka = (KP)__builtin_amdgcn_kernarg_segment_ptr();
    asm volatile("" : "+s"(ka));
    Params p;
#pragma unroll
    for (int i = 0; i < 27; ++i) p.in[i] = ka->in[i];
    p.out = ka->out; p.ws = ka->ws; p.ph_lo = ka->ph_lo; p.ph_hi = ka->ph_hi; p.variant = ka->variant; p.pad_ = 0;
    return p;
}

__device__ __forceinline__ float row_rstd16(const GAS float* ss, int row, int fq, float inv_n) {
    const f32x4 v = *(const GAS f32x4*)(ss + (size_t)row * 16 + 4 * fq);
    float s = (v[0] + v[1]) + (v[2] + v[3]);
    s = sum_x16(s); s = sum_x32(s);
    return __builtin_amdgcn_rsqf(s * inv_n + EPS);
}
__device__ __forceinline__ float sumsq16(const f32x4& a, const f32x4& b, const f32x4& c, const f32x4& d) {
    return ((a[0]*a[0] + a[1]*a[1]) + (a[2]*a[2] + a[3]*a[3])) + ((b[0]*b[0] + b[1]*b[1]) + (b[2]*b[2] + b[3]*b[3])) + ((c[0]*c[0] + c[1]*c[1]) + (c[2]*c[2] + c[3]*c[3])) + ((d[0]*d[0] + d[1]*d[1]) + (d[2]*d[2] + d[3]*d[3]));
}
__device__ __forceinline__ u32x4 pack8(const f32x4& a, const f32x4& b) { u32x4 w; w.x = cvt_pk_bf16(a[0], a[1]); w.y = cvt_pk_bf16(a[2], a[3]); w.z = cvt_pk_bf16(b[0], b[1]); w.w = cvt_pk_bf16(b[2], b[3]); return w; }

__device__ __forceinline__ unsigned pack4_u8(const f32x4& v) {
    const unsigned a = (unsigned)(v[0] * 255.0f + 0.5f), b = (unsigned)(v[1] * 255.0f + 0.5f), c = (unsigned)(v[2] * 255.0f + 0.5f), d = (unsigned)(v[3] * 255.0f + 0.5f);
    return a | (b << 8) | (c << 16) | (d << 24);
}
__device__ __forceinline__ f32x4 unpack4_u8(unsigned w) { return (f32x4){(float)(w & 0xffu), (float)((w >> 8) & 0xffu), (float)((w >> 16) & 0xffu), (float)(w >> 24)} * (1.0f / 255.0f); }

using pg8::Unit;
typedef f32x4 Acc[2][2][4][2];

#define ROWS8(ai, m) _Pragma("unroll") for (int ai = 0; ai < 2; ++ai) _Pragma("unroll") for (int m = 0; m < 4; ++m)
#define EPI_ROW(u, ai, m) ((u).pm * 256 + (ai) * 128 + wr * 64 + (m) * 16 + fr)

struct EpiIn {
    static constexpr bool PERM = true;
    unsigned char* ws;
    __device__ __forceinline__ void operator()(const Acc& acc, const Unit& u, int wr, int wc, int fr, int fq) const {
        GAS unsigned char* w = (GAS unsigned char*)ws; asm volatile("" : "+s"(w));
        const GAS float* ssx = (const GAS float*)(w + WS_SSX); GAS unsigned char* gt = (GAS unsigned char*)(w + WS_GT); GAS bf16_t* inb = (GAS bf16_t*)(w + WS_IN); GAS bf16_t* kvc = (GAS bf16_t*)(w + WS_KVC); GAS bf16_t* qc = (GAS bf16_t*)(w + WS_QC);
        GAS bf16_t* kr = (GAS bf16_t*)(w + WS_KR); GAS float* kvss = (GAS float*)(w + WS_KVSS); GAS float* qss = (GAS float*)(w + WS_QSS); GAS float* krss = (GAS float*)(w + WS_KRSS);
        const int pn = u.pn;
        f32x4 sv[2][4];
        ROWS8(ai, m) sv[ai][m] = *(const GAS f32x4*)(ssx + (size_t)EPI_ROW(u, ai, m) * 16 + 4 * fq);
        ROWS8(ai, m) {
                const int row = EPI_ROW(u, ai, m);
                float st = (sv[ai][m][0] + sv[ai][m][1]) + (sv[ai][m][2] + sv[ai][m][3]); st = sum_x16(st); st = sum_x32(st);
                const float rs = __builtin_amdgcn_rsqf(st * (1.0f / 1024.0f) + EPS);
                f32x4 v00 = acc[ai][0][m][0] * rs, v01 = acc[ai][0][m][1] * rs, v10 = acc[ai][1][m][0] * rs, v11 = acc[ai][1][m][1] * rs;
                if (pn < 8) {
#pragma unroll
                    for (int j = 0; j < 4; ++j) { v00[j] = fast_sigmoid(v00[j]); v01[j] = fast_sigmoid(v01[j]); v10[j] = fast_sigmoid(v10[j]); v11[j] = fast_sigmoid(v11[j]); }
                    GAS unsigned char* p = gt + (size_t)row * 2048 + pn * 256 + wc * 64 + 8 * fq;
                    *(GAS u32x2*)p = (u32x2){pack4_u8(v00), pack4_u8(v01)}; *(GAS u32x2*)(p + 32) = (u32x2){pack4_u8(v10), pack4_u8(v11)};
                } else if (pn < 10) {
                    const int b = row >> 11, ts = row & 2047, c = ts >> 5, s = ts & 31;
#pragma unroll
                    for (int bj = 0; bj < 2; ++bj) { const int cu = (pn - 8) * 256 + wc * 64 + bj * 32 + 8 * fq, g = cu >> 4, j0 = cu & 15;
                        GAS bf16_t* p = inb + ((size_t)(g * 1024 + b * 64 + c) * KIN + s * 16 + j0);
                        *(GAS u32x4*)p = bj ? pack8(v10, v11) : pack8(v00, v01); }
                } else if (pn == 10) {
                    GAS bf16_t* p = kvc + (size_t)row * 256 + wc * 64 + 8 * fq;
                    *(GAS u32x4*)p = pack8(v00, v01); *(GAS u32x4*)(p + 32) = pack8(v10, v11);
                    float s = sumsq16(v00, v01, v10, v11); s = sum_x16(s); s = sum_x32(s);
                    if (fq == 0) kvss[(size_t)row * 4 + wc] = s;
                } else if (pn == 11) {
                    GAS bf16_t* p = qc + (size_t)row * 384 + wc * 64 + 8 * fq;
                    *(GAS u32x4*)p = pack8(v00, v01); *(GAS u32x4*)(p + 32) = pack8(v10, v11);
                    float s = sumsq16(v00, v01, v10, v11); s = sum_x16(s); s = sum_x32(s);
                    if (fq == 0) qss[(size_t)row * 8 + wc] = s;
                } else {
                    const f32x4 z = (f32x4){0.f, 0.f, 0.f, 0.f};
                    if (wc < 2) {
                        GAS bf16_t* p = qc + (size_t)row * 384 + 256 + wc * 64 + 8 * fq;
                        *(GAS u32x4*)p = pack8(v00, v01); *(GAS u32x4*)(p + 32) = pack8(v10, v11);
                        float s = sumsq16(v00, v01, v10, v11); s = sum_x16(s); s = sum_x32(s);
                        if (fq == 0) qss[(size_t)row * 8 + 4 + wc] = s;
                    } else {
                        if (fq == 0) qss[(size_t)row * 8 + 4 + wc] = 0.f;
                        if (wc == 2) { float s2 = sumsq16(v00, v01, z, z); s2 = sum_x16(s2); s2 = sum_x32(s2);
                            *(GAS u32x4*)(kr + (size_t)row * 32 + 8 * fq) = pack8(v00, v01); if (fq == 0) krss[row] = s2; }
                    }
                }
                asm volatile("" ::: "memory");
            }
    }
};

struct EpiPlain {
    static constexpr bool PERM = true;
    unsigned char* ws; size_t off; int ldc;
    __device__ __forceinline__ void operator()(const Acc& acc, const Unit& u, int wr, int wc, int fr, int fq) const {
        GAS unsigned char* w = (GAS unsigned char*)ws; asm volatile("" : "+s"(w)); GAS bf16_t* o = (GAS bf16_t*)(w + off);
        ROWS8(ai, m) {
                const int row = EPI_ROW(u, ai, m);
                GAS bf16_t* p = o + (size_t)row * ldc + u.pn * 256 + wc * 64 + 8 * fq;
                *(GAS u32x4*)p = pack8(acc[ai][0][m][0], acc[ai][0][m][1]); *(GAS u32x4*)(p + 32) = pack8(acc[ai][1][m][0], acc[ai][1][m][1]);
                asm volatile("" ::: "memory");
            }
    }
};

struct EpiKV {
    static constexpr bool PERM = true;
    unsigned char* ws; LAS const float* gkl;
    __device__ __forceinline__ void operator()(const Acc& acc, const Unit& u, int wr, int wc, int fr, int fq) const {
        GAS unsigned char* w = (GAS unsigned char*)ws; asm volatile("" : "+s"(w));
        const GAS float* kvss = (const GAS float*)(w + WS_KVSS); const GAS float* krss = (const GAS float*)(w + WS_KRSS); const GAS bf16_t* kr = (const GAS bf16_t*)(w + WS_KR); const GAS bf16_t* ropeb = (const GAS bf16_t*)(w + WS_ROPEB);
        GAS bf16_t* kb = (GAS bf16_t*)(w + WS_KB); GAS bf16_t* vb = (GAS bf16_t*)(w + WS_VB);
        const int pn = u.pn;
        if (pn < 2) {
            const int h = pn * 4 + wc, i0 = 8 * (fq & 1);
#pragma unroll
            for (int ai = 0; ai < 2; ++ai) {
                float kq[4], krs[4]; u32x4 kA[4], kB[4], cw4[4], sw4[4];
#pragma unroll
                for (int m = 0; m < 4; ++m) { const int row = EPI_ROW(u, ai, m); kq[m] = kvss[(size_t)row * 4 + fq]; krs[m] = krss[row];
                    const GAS bf16_t* kp0 = kr + (size_t)row * 32 + i0; kA[m] = *(const GAS u32x4*)kp0; kB[m] = *(const GAS u32x4*)(kp0 + 16);
                    const GAS bf16_t* rp = ropeb + (size_t)row * 32 + i0; cw4[m] = *(const GAS u32x4*)rp; sw4[m] = *(const GAS u32x4*)(rp + 16); }
#pragma unroll
                for (int m = 0; m < 4; ++m) {
                    const int row = EPI_ROW(u, ai, m);
                    float ks = kq[m]; ks = sum_x16(ks); ks = sum_x32(ks);
                    const float rkv = __builtin_amdgcn_rsqf(ks * (1.0f / 256.0f) + EPS);
                    f32x4 v00 = acc[ai][0][m][0] * rkv, v01 = acc[ai][0][m][1] * rkv, v10 = acc[ai][1][m][0] * rkv, v11 = acc[ai][1][m][1] * rkv;
                    float s = sumsq16(v00, v01, v10, v11); s = sum_x16(s); s = sum_x32(s);
                    const float rk = __builtin_amdgcn_rsqf((s + krs[m]) * (1.0f / 96.0f) + EPS);
                    const int b = row >> 11, sq = row & 2047;
                    GAS bf16_t* kp = kb + ((size_t)((b * NH + h) * SEQ + sq)) * 96;
                    { const f32x4 g0a = *(LAS const f32x4*)(gkl + 8 * fq), g0b = *(LAS const f32x4*)(gkl + 8 * fq + 4);
                      *(GAS u32x4*)(kp + 8 * fq) = pack8(v00 * g0a * rk, v01 * g0b * rk); }
                    { const f32x4 g1a = *(LAS const f32x4*)(gkl + 32 + 8 * fq), g1b = *(LAS const f32x4*)(gkl + 32 + 8 * fq + 4);
                      *(GAS u32x4*)(kp + 32 + 8 * fq) = pack8(v10 * g1a * rk, v11 * g1b * rk); }
                    asm volatile("" ::: "memory");
                    const f32x4 gAa = *(LAS const f32x4*)(gkl + 64 + i0), gAb = *(LAS const f32x4*)(gkl + 64 + i0 + 4), gBa = *(LAS const f32x4*)(gkl + 80 + i0), gBb = *(LAS const f32x4*)(gkl + 80 + i0 + 4);
                    const u32x4 a4 = kA[m], b4 = kB[m], cq = cw4[m], sq4 = sw4[m];
                    const f32x4 xAa = (f32x4){bflo(a4.x), bfhi(a4.x), bflo(a4.y), bfhi(a4.y)} * gAa * rk, xAb = (f32x4){bflo(a4.z), bfhi(a4.z), bflo(a4.w), bfhi(a4.w)} * gAb * rk;
                    const f32x4 xBa = (f32x4){bflo(b4.x), bfhi(b4.x), bflo(b4.y), bfhi(b4.y)} * gBa * rk, xBb = (f32x4){bflo(b4.z), bfhi(b4.z), bflo(b4.w), bfhi(b4.w)} * gBb * rk;
                    const f32x4 ca = (f32x4){bflo(cq.x), bfhi(cq.x), bflo(cq.y), bfhi(cq.y)}, cb = (f32x4){bflo(cq.z), bfhi(cq.z), bflo(cq.w), bfhi(cq.w)};
                    const f32x4 sa = (f32x4){bflo(sq4.x), bfhi(sq4.x), bflo(sq4.y), bfhi(sq4.y)}, sb = (f32x4){bflo(sq4.z), bfhi(sq4.z), bflo(sq4.w), bfhi(sq4.w)};
                    f32x4 oa, ob;
                    if (fq < 2) { oa = xAa * ca - xBa * sa; ob = xAb * cb - xBb * sb; } else { oa = xBa * ca + xAa * sa; ob = xBb * cb + xAb * sb; }
                    *(GAS u32x4*)(kp + 64 + 8 * fq) = pack8(oa, ob);
                    asm volatile("" ::: "memory");
                }
            }
        } else {
            const int h = (pn - 2) * 4 + wc;
            float kq[2][4];
            ROWS8(ai, m) kq[ai][m] = kvss[(size_t)EPI_ROW(u, ai, m) * 4 + fq];
            ROWS8(ai, m) {
                    const int row = EPI_ROW(u, ai, m);
                    float ks = kq[ai][m]; ks = sum_x16(ks); ks = sum_x32(ks);
                    const float rkv = __builtin_amdgcn_rsqf(ks * (1.0f / 256.0f) + EPS);
                    const int b = row >> 11, sq = row & 2047;
                    GAS bf16_t* vp = vb + ((size_t)((b * NH + h) * SEQ + sq)) * 64;
                    *(GAS u32x4*)(vp + 8 * fq) = pack8(acc[ai][0][m][0] * rkv, acc[ai][0][m][1] * rkv);
                    *(GAS u32x4*)(vp + 32 + 8 * fq) = pack8(acc[ai][1][m][0] * rkv, acc[ai][1][m][1] * rkv);
                    asm volatile("" ::: "memory");
                }
        }
    }
};

struct EpiS {
    static constexpr bool PERM = false;
    unsigned char* ws;
    __device__ __forceinline__ void operator()(const Acc& acc, const Unit& u, int wr, int wc, int fr, int fq) const {
        GAS unsigned char* w = (GAS unsigned char*)ws; asm volatile("" : "+s"(w)); GAS float* sst = (GAS float*)(w + WS_SST);
        ROWS8(ai, m) {
                const int row = EPI_ROW(u, ai, m);
                GAS float* p = sst + (size_t)row * 128 + wc * 32 + 4 * fq;
                *(GAS f32x4*)p = acc[ai][0][m][0]; *(GAS f32x4*)(p + 16) = acc[ai][0][m][1];
            }
    }
};

__device__ __forceinline__ float gelu_tanh(float x) {
    const float z = 0.7978845608028654f * (x + 0.044715f * x * x * x);
    return x * __builtin_amdgcn_rcpf(1.0f + __builtin_amdgcn_exp2f(-2.8853900817779268f * z));
}
struct EpiY {
    static constexpr bool PERM = true;
    unsigned char* ws;
    __device__ __forceinline__ void operator()(const Acc& acc, const Unit& u, int wr, int wc, int fr, int fq) const {
        GAS unsigned char* w = (GAS unsigned char*)ws; asm volatile("" : "+s"(w)); GAS bf16_t* yb = (GAS bf16_t*)(w + WS_YB);
        const int g = u.pm >> 2, pnl = u.pn & 1;
        ROWS8(ai, m) {
                const int rg = (u.pm & 3) * 256 + ai * 128 + wr * 64 + m * 16 + fr, b = rg >> 6, c = rg & 63;
#pragma unroll
                for (int bj = 0; bj < 2; ++bj) {
                    const int nl = pnl * 256 + wc * 64 + bj * 32 + 8 * fq, t = nl >> 4, i0 = nl & 15;
                    f32x4 a = acc[ai][bj][m][0], bq = acc[ai][bj][m][1];
#pragma unroll
                    for (int j = 0; j < 4; ++j) { a[j] = gelu_tanh(a[j]); bq[j] = gelu_tanh(bq[j]); }
                    GAS bf16_t* p = yb + (size_t)(b * SEQ + c * LC + t) * 512 + g * 16 + i0;
                    *(GAS u32x4*)p = pack8(a, bq);
                }
                asm volatile("" ::: "memory");
            }
    }
};

struct EpiProj {
    static constexpr bool PERM = true;
    unsigned char* ws;
    __device__ __forceinline__ void operator()(const Acc& acc, const Unit& u, int wr, int wc, int fr, int fq) const {
        GAS unsigned char* w = (GAS unsigned char*)ws; asm volatile("" : "+s"(w)); const GAS unsigned char* gt = (const GAS unsigned char*)(w + WS_GT); GAS bf16_t* mg = (GAS bf16_t*)(w + WS_MG);
        u32x2 gw[2][4][2];
        ROWS8(ai, m) { const GAS unsigned char* gp = gt + (size_t)EPI_ROW(u, ai, m) * 2048 + u.pn * 256 + wc * 64 + 8 * fq; gw[ai][m][0] = *(const GAS u32x2*)gp; gw[ai][m][1] = *(const GAS u32x2*)(gp + 32); }
        ROWS8(ai, m) {
                const int row = EPI_ROW(u, ai, m);
#pragma unroll
                for (int bj = 0; bj < 2; ++bj) {
                    const int col = u.pn * 256 + wc * 64 + bj * 32 + 8 * fq; const u32x2 g = gw[ai][m][bj];
                    const f32x4 a = acc[ai][bj][m][0] * unpack4_u8(g.x), b = acc[ai][bj][m][1] * unpack4_u8(g.y);
                    *(GAS u32x4*)(mg + (size_t)row * 1024 + col) = pack8(a, b);
                }
                asm volatile("" ::: "memory");
            }
    }
};

struct EpiGlu {
    static constexpr bool PERM = true;
    unsigned char* ws;
    __device__ __forceinline__ void operator()(const Acc& acc, const Unit& u, int wr, int wc, int fr, int fq) const {
        GAS unsigned char* w = (GAS unsigned char*)ws; asm volatile("" : "+s"(w)); const GAS unsigned char* gt = (const GAS unsigned char*)(w + WS_GT); GAS bf16_t* mg = (GAS bf16_t*)(w + WS_MG);
        u32x2 gw[2][4]; u32x4 mw[2][4];
        ROWS8(ai, m) { const size_t row = (size_t)EPI_ROW(u, ai, m); const int col = u.pn * 128 + wc * 32 + 8 * fq; gw[ai][m] = *(const GAS u32x2*)(gt + row * 2048 + 1024 + col); mw[ai][m] = *(const GAS u32x4*)(mg + row * 1024 + col); }
        ROWS8(ai, m) {
                const int row = EPI_ROW(u, ai, m), col = u.pn * 128 + wc * 32 + 8 * fq;
                const u32x2 g = gw[ai][m]; const u32x4 mo = mw[ai][m];
                const f32x4 g1a = unpack4_u8(g.x), g1b = unpack4_u8(g.y);
                f32x4 va = acc[ai][0][m][0], vb = acc[ai][0][m][1]; const f32x4 ga = acc[ai][1][m][0], gb = acc[ai][1][m][1];
                const f32x4 ma = (f32x4){bflo(mo.x), bfhi(mo.x), bflo(mo.y), bfhi(mo.y)}, mb = (f32x4){bflo(mo.z), bfhi(mo.z), bflo(mo.w), bfhi(mo.w)};
#pragma unroll
                for (int j = 0; j < 4; ++j) { va[j] = ma[j] + va[j] * fast_sigmoid(ga[j]) * g1a[j]; vb[j] = mb[j] + vb[j] * fast_sigmoid(gb[j]) * g1b[j]; }
                *(GAS u32x4*)(mg + (size_t)row * 1024 + col) = pack8(va, vb);
                asm volatile("" ::: "memory");
            }
    }
};

struct EpiOut {
    static constexpr bool PERM = true;
    unsigned char* ws;
    __device__ __forceinline__ void operator()(const Acc& acc, const Unit& u, int wr, int wc, int fr, int fq) const {
        GAS unsigned char* w = (GAS unsigned char*)ws; asm volatile("" : "+s"(w)); GAS bf16_t* xb = (GAS bf16_t*)(w + WS_XB); GAS float* ssx = (GAS float*)(w + WS_SSX);
        u32x4 xw[2][4][2];
        ROWS8(ai, m) { const GAS bf16_t* p = xb + (size_t)EPI_ROW(u, ai, m) * 1024 + u.pn * 256 + wc * 64 + 8 * fq; xw[ai][m][0] = *(const GAS u32x4*)p; xw[ai][m][1] = *(const GAS u32x4*)(p + 32); }
        ROWS8(ai, m) {
                const int row = EPI_ROW(u, ai, m);
                float s = 0.f;
#pragma unroll
                for (int bj = 0; bj < 2; ++bj) {
                    GAS bf16_t* p = xb + (size_t)row * 1024 + u.pn * 256 + wc * 64 + bj * 32 + 8 * fq; const u32x4 x4 = xw[ai][m][bj];
                    const f32x4 a = (f32x4){bflo(x4.x), bfhi(x4.x), bflo(x4.y), bfhi(x4.y)} + acc[ai][bj][m][0], b = (f32x4){bflo(x4.z), bfhi(x4.z), bflo(x4.w), bfhi(x4.w)} + acc[ai][bj][m][1];
                    *(GAS u32x4*)p = pack8(a, b);
                    s += ((a[0] * a[0] + a[1] * a[1]) + (a[2] * a[2] + a[3] * a[3])) + ((b[0] * b[0] + b[1] * b[1]) + (b[2] * b[2] + b[3] * b[3]));
                }
                s = sum_x16(s); s = sum_x32(s);
                if (fq == 0) ssx[(size_t)row * 16 + u.pn * 4 + wc] = s;
                asm volatile("" ::: "memory");
            }
    }
};

struct MoeOrder {
    static constexpr bool GATHER = false;
    const int* tseg; int tile0, ntile, NC, G, c;
    int loff = 0, lmax = 0x7fffffff;
    __device__ __forceinline__ int vcu() const { return (G % 8 == 0) ? (c % 8) * (G / 8) + c / 8 : c; }
    __device__ __forceinline__ bool unit(int L, Unit& u) const { const int pm = tile0 + L / NC, pnl = L % NC; u.pm = pm; u.pn = (tseg[pm] & 31) * NC + pnl; return true; }
    __device__ __forceinline__ bool next(int i, Unit& u) const {
        const int L = i * G + vcu() + loff; if (L >= ntile * NC || L >= lmax) return false;
        return unit(L, u);
    }
};
struct MoeGatherOrder : MoeOrder { static constexpr bool GATHER = true; const int* gidx; };
struct MoeTail { int lthr, T, s; };
__device__ __forceinline__ MoeTail moe_tail(int nU, int base, int G) { MoeTail t; const int nrem = nU > base ? nU - base : 0; t.T = nrem % G; t.lthr = base + (nrem - t.T); t.s = (t.T == 0) ? 1 : (4 * t.T <= G) ? 4 : (2 * t.T <= G) ? 2 : 1; return t; }
struct MoeDownBOrder : MoeOrder {
    MoeTail tl; int split;
    __device__ __forceinline__ bool next(int i, Unit& u) const {
        if (!split || tl.s == 1) return MoeOrder::next(i, u);
        const int vc = vcu(), L = i * G + vc;
        if (L < tl.lthr) return unit(L, u);
        if (i * G != tl.lthr || vc >= tl.s * tl.T) return false;
        return unit(tl.lthr + vc / tl.s, u);
    }
};
struct MoeDownAOrder : MoeOrder {
    int nbusy; MoeTail tl;
    __device__ __forceinline__ bool next(int i, Unit& u) const {
        const int vc = vcu(), F = G - nbusy; int L;
        if (vc >= nbusy) { const int j = vc - nbusy; if (i < 2) { L = i * F + j; if (L >= ntile * NC) return false; return unit(L, u); } L = 2 * F + (i - 2) * G + vc; }
        else L = 2 * F + i * G + vc;
        if (tl.s > 1 && L >= tl.lthr) { const int rr = L - vc; if (rr != tl.lthr || vc >= tl.s * tl.T) return false; return unit(tl.lthr + vc / tl.s, u); }
        if (L >= ntile * NC) return false;
        return unit(L, u);
    }
};

struct EpiGU {
    static constexpr bool PERM = true;
    unsigned char* ws;
    __device__ __forceinline__ void operator()(const Acc& acc, const Unit& u, int wr, int wc, int fr, int fq) const {
        GAS unsigned char* w = (GAS unsigned char*)ws; asm volatile("" : "+s"(w)); const GAS float* ars = (const GAS float*)(w + WS_ARS); GAS bf16_t* hh = (GAS bf16_t*)(w + WS_HH);
        const int pnl = u.pn & 1;
        float rsv[2][4];
        ROWS8(ai, m) rsv[ai][m] = ars[EPI_ROW(u, ai, m)];
        ROWS8(ai, m) {
                const int row = EPI_ROW(u, ai, m);
                const float rs = rsv[ai][m];
                f32x4 ga = acc[ai][0][m][0] * rs, gb = acc[ai][0][m][1] * rs, ua = acc[ai][1][m][0] * rs, ub = acc[ai][1][m][1] * rs;
#pragma unroll
                for (int j = 0; j < 4; ++j) { ga[j] = ga[j] * fast_sigmoid(ga[j]) * ua[j]; gb[j] = gb[j] * fast_sigmoid(gb[j]) * ub[j]; }
                *(GAS u32x4*)(hh + (size_t)row * 256 + pnl * 128 + wc * 32 + 8 * fq) = pack8(ga, gb);
                asm volatile("" ::: "memory");
            }
    }
};

template <bool PASS_B> struct EpiDown {
    static constexpr bool PERM = true;
    unsigned char* ws; float* out;
    int hsel = -1, lthr = 0, tile0 = 0, hsplit = 2;
    __device__ __forceinline__ void operator()(const Acc& acc, const Unit& u, int wr, int wc, int fr, int fq) const {
        GAS unsigned char* w = (GAS unsigned char*)ws; asm volatile("" : "+s"(w)); const GAS int* atok = (const GAS int*)(w + WS_ATOK); const GAS float* aw = (const GAS float*)(w + WS_AW); GAS float* ssx = (GAS float*)(w + WS_SSX);
        const GAS bf16_t* xsrc = (const GAS bf16_t*)(w + (PASS_B ? WS_MG : WS_XB)); GAS bf16_t* xb = (GAS bf16_t*)(w + (PASS_B ? WS_XB : WS_MG));
        GAS float* og = (GAS float*)out;
        const int pnl = u.pn & 3;
        int tk[2][4]; float wg[2][4]; u32x4 xw[2][4][2];
        const int hs = (hsel >= 0 && (u.pm - tile0) * 4 + pnl >= lthr) ? hsel : -1;
        ROWS8(ai, m) { const int row = EPI_ROW(u, ai, m); const bool mine = hs < 0 || (hsplit == 2 ? ai == hs : (ai == (hs >> 1) && (m >> 1) == (hs & 1)));
            tk[ai][m] = mine ? atok[row] : -1; wg[ai][m] = aw[row]; }
        ROWS8(ai, m) { const int t0 = tk[ai][m] < 0 ? 0 : tk[ai][m]; const GAS bf16_t* p = xsrc + (size_t)t0 * 1024 + pnl * 256 + wc * 64 + 8 * fq; xw[ai][m][0] = *(const GAS u32x4*)p; xw[ai][m][1] = *(const GAS u32x4*)(p + 32); }
        ROWS8(ai, m) {
                const int tok = tk[ai][m]; const float wgt = wg[ai][m];
                const int t0 = tok < 0 ? 0 : tok;
                float s = 0.f;
#pragma unroll
                for (int bj = 0; bj < 2; ++bj) {
                    const size_t o = (size_t)t0 * 1024 + pnl * 256 + wc * 64 + bj * 32 + 8 * fq; const u32x4 x4 = xw[ai][m][bj];
                    const f32x4 a = (f32x4){bflo(x4.x), bfhi(x4.x), bflo(x4.y), bfhi(x4.y)} + acc[ai][bj][m][0] * wgt, b = (f32x4){bflo(x4.z), bfhi(x4.z), bflo(x4.w), bfhi(x4.w)} + acc[ai][bj][m][1] * wgt;
                    if (tok >= 0) {
                        if (PASS_B && og) { *(GAS f32x4*)(og + o) = a; *(GAS f32x4*)(og + o + 4) = b; }
                        else *(GAS u32x4*)(xb + o) = pack8(a, b); }
                    s += ((a[0] * a[0] + a[1] * a[1]) + (a[2] * a[2] + a[3] * a[3])) + ((b[0] * b[0] + b[1] * b[1]) + (b[2] * b[2] + b[3] * b[3]));
                }
                if (PASS_B && !og) { s = sum_x16(s); s = sum_x32(s); if (fq == 0 && tok >= 0) ssx[(size_t)tok * 16 + pnl * 4 + wc] = s; }
                asm volatile("" ::: "memory");
            }
    }
};

struct SsmSOrder {
    static constexpr bool GATHER = false; int G, c;
    __device__ bool next(int i, Unit& u) const { const int cc = (c + G / 2) % G; const int L = i * G + cc; if (L >= 128) return false; u.pm = L; u.pn = L >> 2; return true; }
};
struct SsmYOrder {
    static constexpr bool GATHER = false; int G, c;
    __device__ bool next(int i, Unit& u) const { const int vc = (G % 8 == 0) ? (c % 8) * (G / 8) + c / 8 : c; const int L = i * G + vc; if (L >= 256) return false; u.pm = L >> 1; u.pn = (L >> 3) * 2 + (L & 1); return true; }
};
namespace att {
#define KSWZ(row, colB) ((row) * 256 + ((colB) ^ (((row) & 15) << 4)))
#define SBAR() __builtin_amdgcn_sched_barrier(0)
constexpr int SHM_K = 32768, SHM_V = 16384, OFF_V = 2 * SHM_K, OFF_WS = 2 * SHM_K + 2 * SHM_V;
__device__ __forceinline__ int crow(int r, int hi) { return (r & 3) + 8 * (r >> 2) + 4 * hi; }
__device__ __forceinline__ int v_st(int k, int c) { const int kk = (k & ~0xC) | ((k & 4) << 1) | ((k & 8) >> 1); return ((kk >> 3) * 2 + (c >> 5)) * 512 + ((kk & 7) * 32 + (c & 31)) * 2; }
__device__ __forceinline__ int v_rd_base(int lane) { return ((lane & 3) << 3) | (((lane >> 2) & 3) << 6) | (((lane >> 4) & 1) << 5) | (((lane >> 5) & 1) << 8); }
constexpr int v_rd_off(int d0, int ks, int half) { return d0 * 512 + ks * 2048 + half * 1024; }
template <int OFF> __device__ __forceinline__ s16x4 tr_read(int vb) {
    s16x4 r; asm volatile("ds_read_b64_tr_b16 %0, %1 offset:%2" : "=&v"(r) : "v"(vb), "i"(OFF) : "memory"); return r;
}
template <int D0> __device__ __forceinline__ void pv_one(f32x16& od, int vb, bf16x8 pa0, bf16x8 pa1, bf16x8 pa2, bf16x8 pa3) {
    const s16x4 l0 = tr_read<v_rd_off(D0, 0, 0)>(vb), h0 = tr_read<v_rd_off(D0, 0, 1)>(vb), l1 = tr_read<v_rd_off(D0, 1, 0)>(vb), h1 = tr_read<v_rd_off(D0, 1, 1)>(vb);
    const s16x4 l2 = tr_read<v_rd_off(D0, 2, 0)>(vb), h2 = tr_read<v_rd_off(D0, 2, 1)>(vb), l3 = tr_read<v_rd_off(D0, 3, 0)>(vb), h3 = tr_read<v_rd_off(D0, 3, 1)>(vb);
    asm volatile("s_waitcnt lgkmcnt(0)" ::: "memory"); SBAR();
#define PK(L, H) (bf16x8){L[0], L[1], L[2], L[3], H[0], H[1], H[2], H[3]}
    od = __builtin_amdgcn_mfma_f32_32x32x16_bf16(pa0, PK(l0, h0), od, 0, 0, 0);
    od = __builtin_amdgcn_mfma_f32_32x32x16_bf16(pa1, PK(l1, h1), od, 0, 0, 0);
    od = __builtin_amdgcn_mfma_f32_32x32x16_bf16(pa2, PK(l2, h2), od, 0, 0, 0);
    od = __builtin_amdgcn_mfma_f32_32x32x16_bf16(pa3, PK(l3, h3), od, 0, 0, 0);
#undef PK
}
__device__ __forceinline__ void attn_unit(char* lds, int b, int h, int qb, const bf16_t* TQ, const float* qss, const float* rope, const float* gq, float kbound,
                                          const bf16_t* KB, const bf16_t* VB, bf16_t* OB, int variant = 0) {
    int tid_ = threadIdx.x; asm volatile("" : "+v"(tid_));
    const int tid = tid_, wid = tid >> 6, lane = tid & 63, r32 = lane & 31, hi = lane >> 5;
    char* K_lds = lds; char* V_lds = lds + OFF_V; float* li_l = (float*)(lds + OFF_WS) + wid * 64;
    constexpr float C = 0.10206207261596575f * 1.4426950408889634f;
    const int row = b * SEQ + qb * 256 + wid * 32 + r32;
    bf16x8 qr[6]; float mb;
    {
        const bf16_t* tq = TQ + (size_t)row * 768 + h * 96 + hi * 8;
        float qf[6][8]; float ss = 0.f;
#pragma unroll
        for (int d0 = 0; d0 < 6; ++d0) { const u32x4 w = *(const u32x4*)(tq + d0 * 16);
            qf[d0][0] = bflo(w.x); qf[d0][1] = bfhi(w.x); qf[d0][2] = bflo(w.y); qf[d0][3] = bfhi(w.y); qf[d0][4] = bflo(w.z); qf[d0][5] = bfhi(w.z); qf[d0][6] = bflo(w.w); qf[d0][7] = bfhi(w.w);
#pragma unroll
            for (int j = 0; j < 8; ++j) ss += qf[d0][j] * qf[d0][j]; }
        ss = sum_x32(ss);
        const f32x4 qa = *(const f32x4*)(qss + (size_t)row * 8), qb4 = *(const f32x4*)(qss + (size_t)row * 8 + 4);
        const float a = __builtin_amdgcn_rsqf((((qa[0] + qa[1]) + (qa[2] + qa[3])) + ((qb4[0] + qb4[1]) + (qb4[2] + qb4[3]))) * (1.0f / 384.0f) + EPS);
        const float f = a * __builtin_amdgcn_rsqf(a * a * ss * (1.0f / 96.0f) + EPS);
#pragma unroll
        for (int d0 = 0; d0 < 6; ++d0) { const f32x4 g0 = *(const f32x4*)(gq + d0 * 16 + hi * 8), g1 = *(const f32x4*)(gq + d0 * 16 + hi * 8 + 4);
#pragma unroll
            for (int j = 0; j < 4; ++j) { qf[d0][j] *= f * g0[j]; qf[d0][4 + j] *= f * g1[j]; } }
        const float* rp = rope + (size_t)row * 32 + hi * 8;
        const f32x4 c0 = *(const f32x4*)rp, c1 = *(const f32x4*)(rp + 4), s0 = *(const f32x4*)(rp + 16), s1 = *(const f32x4*)(rp + 20);
#pragma unroll
        for (int j = 0; j < 8; ++j) { const float cs = j < 4 ? c0[j & 3] : c1[j & 3], sn = j < 4 ? s0[j & 3] : s1[j & 3]; const float x1 = qf[4][j], x2 = qf[5][j];
            qf[4][j] = x1 * cs - x2 * sn; qf[5][j] = x2 * cs + x1 * sn; }
        float qn = 0.f;
#pragma unroll
        for (int d0 = 0; d0 < 6; ++d0)
#pragma unroll
            for (int j = 0; j < 8; ++j) qn += qf[d0][j] * qf[d0][j];
        qn = sum_x32(qn);
        mb = sqrtf(qn) * kbound * C;
#pragma unroll
        for (int d0 = 0; d0 < 6; ++d0) { u32x4 w; w.x = cvt_pk_bf16(qf[d0][0] * C, qf[d0][1] * C); w.y = cvt_pk_bf16(qf[d0][2] * C, qf[d0][3] * C); w.z = cvt_pk_bf16(qf[d0][4] * C, qf[d0][5] * C); w.w = cvt_pk_bf16(qf[d0][6] * C, qf[d0][7] * C);
            qr[d0] = *reinterpret_cast<bf16x8*>(&w); }
    }
    const bf16_t* Kh = KB + (size_t)(b * NH + h) * SEQ * 96; const bf16_t* Vh = VB + (size_t)(b * NH + h) * SEQ * 64;
    const int sr = tid >> 2, sc = tid & 3;
    const int vb0 = (int)(uintptr_t)V_lds + v_rd_base(lane);
    const int NS = 2 * qb + 2, cw = 4 * qb + (wid >> 1);
    float l_reg = 0.f; f32x16 o0 = {}, o1 = {};
    bf16x8 k0r, k1r, k2r, v0r, v1r;
#define SLOAD(key0) do { const bf16_t* kp_ = Kh + (size_t)((key0) + sr) * 96 + sc * 8; k0r = *(const bf16x8*)kp_; k1r = *(const bf16x8*)(kp_ + 32); k2r = *(const bf16x8*)(kp_ + 64); \
        const bf16_t* vp_ = Vh + (size_t)((key0) + sr) * 64 + sc * 8; v0r = *(const bf16x8*)vp_; v1r = *(const bf16x8*)(vp_ + 32); } while (0)
#define SWRITE(bf) do { int t_ = threadIdx.x; asm volatile("" : "+v"(t_)); const int sr_ = t_ >> 2, sc_ = t_ & 3; \
        char* kd_ = K_lds + (bf) * SHM_K; *(bf16x8*)(kd_ + KSWZ(sr_, sc_ * 16)) = k0r; *(bf16x8*)(kd_ + KSWZ(sr_, (sc_ + 4) * 16)) = k1r; *(bf16x8*)(kd_ + KSWZ(sr_, (sc_ + 8) * 16)) = k2r; \
        char* vd_ = V_lds + (bf) * SHM_V + (sr_ >> 6) * 8192; *(bf16x8*)(vd_ + v_st(sr_ & 63, sc_ * 8)) = v0r; *(bf16x8*)(vd_ + v_st(sr_ & 63, (sc_ + 4) * 8)) = v1r; } while (0)
#define QKT(P0, P1, KS) do { const char* Ks_ = (KS); _Pragma("unroll") for (int r = 0; r < 16; ++r) { P0[r] = -mb; P1[r] = -mb; } \
        bf16x8 kf0[6], kf1[6]; \
        _Pragma("unroll") for (int d0 = 0; d0 < 6; ++d0) { const int cb = (d0 * 16 + hi * 8) * 2; \
            kf0[d0] = *reinterpret_cast<const bf16x8*>(Ks_ + KSWZ(r32, cb)); kf1[d0] = *reinterpret_cast<const bf16x8*>(Ks_ + KSWZ(32 + r32, cb)); } \
        SBAR();   \
        _Pragma("unroll") for (int d0 = 0; d0 < 6; ++d0) { \
            P0 = __builtin_amdgcn_mfma_f32_32x32x16_bf16(kf0[d0], qr[d0], P0, 0, 0, 0); P1 = __builtin_amdgcn_mfma_f32_32x32x16_bf16(kf1[d0], qr[d0], P1, 0, 0, 0); } } while (0)
#define PK4(P, BASE, OUT) do { unsigned a0 = cvt_pk_bf16(P[BASE + 0], P[BASE + 1]), a1 = cvt_pk_bf16(P[BASE + 2], P[BASE + 3]);   \
    unsigned b0_ = cvt_pk_bf16(P[BASE + 4], P[BASE + 5]), b1_ = cvt_pk_bf16(P[BASE + 6], P[BASE + 7]);                              \
    auto r0 = __builtin_amdgcn_permlane32_swap(a0, b0_, false, false); auto r1 = __builtin_amdgcn_permlane32_swap(a1, b1_, false, false); \
    u32x4 w = {r0[0], r1[0], r0[1], r1[1]}; OUT = *reinterpret_cast<bf16x8*>(&w); } while (0)
#define SMX(P0, P1) do { float ps = 0.f; _Pragma("unroll") for (int r = 0; r < 16; ++r) { P0[r] = __builtin_amdgcn_exp2f(P0[r]); P1[r] = __builtin_amdgcn_exp2f(P1[r]); ps += P0[r] + P1[r]; } \
        ps = sum_x32(ps); l_reg += ps; PK4(P0, 0, pa0); PK4(P0, 8, pa1); PK4(P1, 0, pa2); PK4(P1, 8, pa3); } while (0)
#define PV(VB_) do { const int vb_ = (VB_); pv_one<0>(o0, vb_, pa0, pa1, pa2, pa3); pv_one<1>(o1, vb_, pa0, pa1, pa2, pa3); } while (0)
#define PKV(L, H) (bf16x8){L[0], L[1], L[2], L[3], H[0], H[1], H[2], H[3]}
#define GAP_EXP4(P, B) do { P[B] = __builtin_amdgcn_exp2f(P[B]); P[B + 1] = __builtin_amdgcn_exp2f(P[B + 1]); P[B + 2] = __builtin_amdgcn_exp2f(P[B + 2]); P[B + 3] = __builtin_amdgcn_exp2f(P[B + 3]); asm volatile("" : "+v"(P)); SBAR(); } while (0)
#define GAP_SUM8(P, B) do { psum_ += ((P[B] + P[B + 1]) + (P[B + 2] + P[B + 3])) + ((P[B + 4] + P[B + 5]) + (P[B + 6] + P[B + 7])); asm volatile("" : "+v"(psum_)); SBAR(); } while (0)
#define GAP_PK(P, BASE, OUT) do { PK4(P, BASE, OUT); asm volatile("" : "+v"(OUT)); SBAR(); } while (0)
#define EXPALL(P0, P1) do { _Pragma("unroll") for (int r = 0; r < 16; ++r) { P0[r] = __builtin_amdgcn_exp2f(P0[r]); P1[r] = __builtin_amdgcn_exp2f(P1[r]); } } while (0)
#define SUMPACK(P0, P1) do { float ps = 0.f; _Pragma("unroll") for (int r = 0; r < 16; ++r) ps += P0[r] + P1[r]; ps = sum_x32(ps); l_reg += ps; PK4(P0, 0, pa0); PK4(P0, 8, pa1); PK4(P1, 0, pa2); PK4(P1, 8, pa3); } while (0)
#define BLK_QK(P0, P1, KS, S0, S1) do { const char* Ks_ = (KS); bf16x8 kf0[6], kf1[6]; \
        _Pragma("unroll") for (int d0 = 0; d0 < 6; ++d0) { const int cb = (d0 * 16 + hi * 8) * 2; kf0[d0] = *reinterpret_cast<const bf16x8*>(Ks_ + KSWZ(r32, cb)); kf1[d0] = *reinterpret_cast<const bf16x8*>(Ks_ + KSWZ(32 + r32, cb)); } \
        SBAR(); _Pragma("unroll") for (int r = 0; r < 16; ++r) { P0[r] = -mb; P1[r] = -mb; } float psum_ = 0.f; \
        P0 = __builtin_amdgcn_mfma_f32_32x32x16_bf16(kf0[0], qr[0], P0, 0, 0, 0); GAP_SUM8(S0, 0); \
        P1 = __builtin_amdgcn_mfma_f32_32x32x16_bf16(kf1[0], qr[0], P1, 0, 0, 0); GAP_SUM8(S0, 8); \
        P0 = __builtin_amdgcn_mfma_f32_32x32x16_bf16(kf0[1], qr[1], P0, 0, 0, 0); GAP_SUM8(S1, 0); \
        P1 = __builtin_amdgcn_mfma_f32_32x32x16_bf16(kf1[1], qr[1], P1, 0, 0, 0); GAP_SUM8(S1, 8); \
        P0 = __builtin_amdgcn_mfma_f32_32x32x16_bf16(kf0[2], qr[2], P0, 0, 0, 0); GAP_PK(S0, 0, pa0); \
        P1 = __builtin_amdgcn_mfma_f32_32x32x16_bf16(kf1[2], qr[2], P1, 0, 0, 0); GAP_PK(S0, 8, pa1); \
        P0 = __builtin_amdgcn_mfma_f32_32x32x16_bf16(kf0[3], qr[3], P0, 0, 0, 0); GAP_PK(S1, 0, pa2); \
        P1 = __builtin_amdgcn_mfma_f32_32x32x16_bf16(kf1[3], qr[3], P1, 0, 0, 0); GAP_PK(S1, 8, pa3); \
        P0 = __builtin_amdgcn_mfma_f32_32x32x16_bf16(kf0[4], qr[4], P0, 0, 0, 0); P1 = __builtin_amdgcn_mfma_f32_32x32x16_bf16(kf1[4], qr[4], P1, 0, 0, 0); \
        P0 = __builtin_amdgcn_mfma_f32_32x32x16_bf16(kf0[5], qr[5], P0, 0, 0, 0); P1 = __builtin_amdgcn_mfma_f32_32x32x16_bf16(kf1[5], qr[5], P1, 0, 0, 0); \
        psum_ = sum_x32(psum_); l_reg += psum_; SBAR(); } while (0)
#define BLK_PV(VB_, X0, X1) do { const int vb_ = (VB_); \
        const s16x4 a0l = tr_read<v_rd_off(0, 0, 0)>(vb_), a0h = tr_read<v_rd_off(0, 0, 1)>(vb_), b0l = tr_read<v_rd_off(1, 0, 0)>(vb_), b0h = tr_read<v_rd_off(1, 0, 1)>(vb_); \
        const s16x4 a1l = tr_read<v_rd_off(0, 1, 0)>(vb_), a1h = tr_read<v_rd_off(0, 1, 1)>(vb_), b1l = tr_read<v_rd_off(1, 1, 0)>(vb_), b1h = tr_read<v_rd_off(1, 1, 1)>(vb_); \
        const s16x4 a2l = tr_read<v_rd_off(0, 2, 0)>(vb_), a2h = tr_read<v_rd_off(0, 2, 1)>(vb_), b2l = tr_read<v_rd_off(1, 2, 0)>(vb_), b2h = tr_read<v_rd_off(1, 2, 1)>(vb_); \
        const s16x4 a3l = tr_read<v_rd_off(0, 3, 0)>(vb_), a3h = tr_read<v_rd_off(0, 3, 1)>(vb_), b3l = tr_read<v_rd_off(1, 3, 0)>(vb_), b3h = tr_read<v_rd_off(1, 3, 1)>(vb_); \
        asm volatile("s_waitcnt lgkmcnt(0)" ::: "memory"); SBAR(); \
        o0 = __builtin_amdgcn_mfma_f32_32x32x16_bf16(pa0, PKV(a0l, a0h), o0, 0, 0, 0); GAP_EXP4(X0, 0); \
        o1 = __builtin_amdgcn_mfma_f32_32x32x16_bf16(pa0, PKV(b0l, b0h), o1, 0, 0, 0); GAP_EXP4(X0, 4); \
        o0 = __builtin_amdgcn_mfma_f32_32x32x16_bf16(pa1, PKV(a1l, a1h), o0, 0, 0, 0); GAP_EXP4(X0, 8); \
        o1 = __builtin_amdgcn_mfma_f32_32x32x16_bf16(pa1, PKV(b1l, b1h), o1, 0, 0, 0); GAP_EXP4(X0, 12); \
        o0 = __builtin_amdgcn_mfma_f32_32x32x16_bf16(pa2, PKV(a2l, a2h), o0, 0, 0, 0); GAP_EXP4(X1, 0); \
        o1 = __builtin_amdgcn_mfma_f32_32x32x16_bf16(pa2, PKV(b2l, b2h), o1, 0, 0, 0); GAP_EXP4(X1, 4); \
        o0 = __builtin_amdgcn_mfma_f32_32x32x16_bf16(pa3, PKV(a3l, a3h), o0, 0, 0, 0); GAP_EXP4(X1, 8); \
        o1 = __builtin_amdgcn_mfma_f32_32x32x16_bf16(pa3, PKV(b3l, b3h), o1, 0, 0, 0); GAP_EXP4(X1, 12); } while (0)
    bool pend = false;
    if (wid < 4) __builtin_amdgcn_s_setprio(1);
    f32x16 pA0 = {}, pA1 = {}, pB0 = {}, pB1 = {}; bf16x8 pa0 = {}, pa1 = {}, pa2 = {}, pa3 = {};
    SLOAD(0);
    for (int s = 0; s < NS; ++s) {
        const int bf = s & 1;
        asm volatile("s_waitcnt vmcnt(0)" ::: "memory");
        SWRITE(bf);
        if (s + 1 < NS) SLOAD((s + 1) * 128);
        __syncthreads();
        const bool va = 2 * s <= cw, vb2 = 2 * s + 1 <= cw;
        const char* Kb_ = K_lds + bf * SHM_K; const int vbase = vb0 + bf * SHM_V;
        SBAR();
        if (va && vb2 && pend) {
            const int vprev = vb0 + (bf ^ 1) * SHM_V + 8192;
            BLK_QK(pA0, pA1, Kb_, pB0, pB1);
            BLK_PV(vprev, pA0, pA1);
            BLK_QK(pB0, pB1, Kb_ + 16384, pA0, pA1);
            BLK_PV(vbase, pB0, pB1);
        } else {
            if (pend) { SUMPACK(pB0, pB1); SBAR(); PV(vb0 + (bf ^ 1) * SHM_V + 8192); }
            if (va) { QKT(pA0, pA1, Kb_); EXPALL(pA0, pA1); SUMPACK(pA0, pA1); SBAR(); PV(vbase); }
            if (vb2) { QKT(pB0, pB1, Kb_ + 16384); EXPALL(pB0, pB1); }
        }
        pend = vb2;
    }
    if (pend) { SUMPACK(pB0, pB1); SBAR(); PV(vb0 + ((NS - 1) & 1) * SHM_V + 8192); }
    __builtin_amdgcn_s_setprio(0);
#undef BLK_QK
#undef BLK_PV
#undef SUMPACK
#undef EXPALL
#undef GAP_EXP4
#undef GAP_SUM8
#undef GAP_PK
#undef PKV
#undef SLOAD
#undef SWRITE
#undef QKT
#undef SMX
#undef PK4
#undef PV
    if (hi == 0) li_l[r32] = l_reg; asm volatile("s_waitcnt lgkmcnt(0)" ::: "memory");
    bf16_t* ot = (bf16_t*)(lds + OFF_WS + 2048) + wid * 2048;
#pragma unroll
    for (int r = 0; r < 16; ++r) { const int orow = crow(r, hi); const float rl = __builtin_amdgcn_rcpf(li_l[orow]);
        ot[orow * 64 + r32] = (bf16_t)f2bf(o0[r] * rl); ot[orow * 64 + 32 + r32] = (bf16_t)f2bf(o1[r] * rl); }
    asm volatile("s_waitcnt lgkmcnt(0)" ::: "memory");
    bf16_t* Ow = OB + (size_t)(b * SEQ + qb * 256 + wid * 32) * 512 + h * 64;
#pragma unroll
    for (int i = 0; i < 4; ++i) { const int ch = i * 64 + lane, orow = ch >> 3, oc = (ch & 7) * 8;
        *(u32x4*)(Ow + (size_t)orow * 512 + oc) = *(const u32x4*)(ot + orow * 64 + oc); }
    asm volatile("s_waitcnt lgkmcnt(0)" ::: "memory");
}
#undef KSWZ
}

__device__ __forceinline__ float wave_sum(float v) {
    return sum_x32(sum_x16(row_sum16(v)));
}
__device__ __forceinline__ float wave_max(float v) {
    return max_x32(max_x16(row_max16(v)));
}

struct TDesc { const float* W; const float* gain; bf16_t* WT; int K, N, kb, dr0, sc0; };
__device__ __forceinline__ void tr_load(const TDesc& d, f32x4 (&v)[8], int lane) {
    if (d.sc0 < 0) { float z = 0.f; asm volatile("" : "+v"(z));
#pragma unroll
        for (int i = 0; i < 8; ++i) v[i] = (f32x4){z, z, z, z};
        return; }
    const float* src = d.W + (size_t)(64 * d.kb + (lane >> 3)) * d.N + d.sc0 + 4 * (lane & 7);
#pragma unroll
    for (int i = 0; i < 8; ++i) v[i] = __builtin_nontemporal_load((const f32x4*)(src + (size_t)(8 * i) * d.N));
}
__device__ __forceinline__ void tr_store(const TDesc& d, const f32x4 (&v)[8], LAS float* scr, int lane) {
    const int k0 = 64 * d.kb, K = d.K;
    if (d.sc0 < 0) {
        unsigned z0 = 0u; asm volatile("" : "+v"(z0));
#pragma unroll
        for (int j = 0; j < 4; ++j) { const int n = (lane >> 3) + 8 * j; *(u32x4*)(d.WT + (size_t)(d.dr0 + n) * K + k0 + 8 * (lane & 7)) = (u32x4){z0, z0, z0, z0}; }
        return;
    }
#pragma unroll
    for (int i = 0; i < 8; ++i) { const int kk = 8 * i + (lane >> 3); const float g = d.gain ? d.gain[k0 + kk] : 1.0f; LAS float* s = scr + kk * 33 + 4 * (lane & 7);
        s[0] = v[i][0] * g; s[1] = v[i][1] * g; s[2] = v[i][2] * g; s[3] = v[i][3] * g; }
    asm volatile("s_waitcnt lgkmcnt(0)" ::: "memory");
    const int c = lane & 7;
#pragma unroll
    for (int j = 0; j < 4; ++j) { const int n = (lane >> 3) + 8 * j; const LAS float* s = scr + (8 * c) * 33 + n;
        u32x4 o; o.x = cvt_pk_bf16(s[0 * 33], s[1 * 33]); o.y = cvt_pk_bf16(s[2 * 33], s[3 * 33]); o.z = cvt_pk_bf16(s[4 * 33], s[5 * 33]); o.w = cvt_pk_bf16(s[6 * 33], s[7 * 33]);
        *(u32x4*)(d.WT + (size_t)(d.dr0 + n) * K + k0 + 8 * c) = o; }
    asm volatile("s_waitcnt lgkmcnt(0)" ::: "memory");
}
__device__ __forceinline__ int win_src(int nb) {
    if (nb < 64) return 1184 + 32 * nb;
    if (nb < 80) return 672 + 32 * (nb - 64);
    if (nb < 88) return 384 + 32 * (nb - 80);
    if (nb < 96) return 32 * (nb - 88);
    if (nb < 100) return 256 + 32 * (nb - 96);
    if (nb == 100) return 640;
    return -1;
}
__device__ __forceinline__ int ukv_src(int nb) { const int pn = nb >> 3, wc = (nb >> 1) & 3, bj = nb & 1; return pn < 2 ? 128 * (4 * pn + wc) + 32 * bj : 128 * (4 * (pn - 2) + wc) + 64 + 32 * bj; }

constexpr int MIXW_ITEMS = 16 * 104 + 6 * 24 + 4 * 32 + 8 * 32 + 8 * 64 + 16 * 32;
__device__ __forceinline__ TDesc mixw_desc(const Params& P, int it2) {
    const int l = it2 / MIXW_ITEMS; int r = it2 % MIXW_ITEMS;
    bf16_t* wm = (bf16_t*)(P.ws + WS_WMIX + (unsigned)(l * (int)WMIX_LAYER));
    if (r < 16 * 104) { const int kb = r / 104, nb = r % 104; return TDesc{P.in[3] + (unsigned)(l * 1024 * 3232), P.in[2] + l * 1024, wm + WM_IN / 2, 1024, 3232, kb, 32 * nb, win_src(nb)}; } r -= 16 * 104;
    if (r < 6 * 24) { const int kb = r / 24, nb = r % 24; return TDesc{P.in[5] + (unsigned)(l * 384 * 768), P.in[4] + l * 384, wm + WM_UQ / 2, 384, 768, kb, 32 * nb, 32 * nb}; } r -= 6 * 24;
    if (r < 4 * 32) { const int kb = r / 32, nb = r % 32; return TDesc{P.in[7] + (unsigned)(l * 256 * 1024), P.in[6] + l * 256, wm + WM_UKV / 2, 256, 1024, kb, 32 * nb, ukv_src(nb)}; } r -= 4 * 32;
    if (r < 8 * 32) { const int kb = r / 32, nb = r % 32; return TDesc{P.in[10] + (unsigned)(l * 512 * 1024), nullptr, wm + WM_PROJ / 2, 512, 1024, kb, 32 * nb, 32 * nb}; } r -= 8 * 32;
    if (r < 8 * 64) { const int kb = r / 64, nb = r % 64; const int pn = nb >> 3, q = (nb >> 1) & 3, half = nb & 1;
        return TDesc{P.in[19] + (unsigned)(l * 512 * 2048), nullptr, wm + WM_GLU / 2, 512, 2048, kb, 32 * nb, half * 1024 + 128 * pn + 32 * q}; } r -= 8 * 64;
    { const int kb = r / 32, nb = r % 32; return TDesc{P.in[20] + (unsigned)(l * 1024 * 1024), nullptr, wm + WM_OUT / 2, 1024, 1024, kb, 32 * nb, 32 * nb}; }
}
constexpr int EXPW_ITEMS = 32 * (256 + 128), EXPW_EARLY = 4096;
__device__ __forceinline__ TDesc expw_desc(const Params& P, int l, int it) {
    const int e = it / 384; int r = it % 384;
    if (r < 256) { const int kb = r >> 4, nb = r & 15, t2 = nb >> 3, q = (nb >> 1) & 3, half = nb & 1;
        return TDesc{(half ? P.in[25] : P.in[24]) + ((size_t)l * NE + e) * 1024 * 256, P.in[21] + l * 1024, (bf16_t*)(P.ws + WS_WGU) + (size_t)e * 512 * 1024, 1024, 256, kb, 32 * nb, 128 * t2 + 32 * q}; }
    r -= 256;
    { const int kb = r >> 5, nb = r & 31;
        return TDesc{P.in[26] + ((size_t)l * NE + e) * 256 * 1024, nullptr, (bf16_t*)(P.ws + WS_WD) + (size_t)e * 1024 * 256, 256, 1024, kb, 32 * nb, 32 * nb}; }
}
#define TR_LOOP(DESC_EXPR_OF_IT, FIRST, COUNT, STRIDE) do { \
    for (int it0 = (FIRST); it0 < (COUNT); it0 += 4 * (STRIDE)) { f32x4 va[8], vb[8], vc[8], vd[8]; \
        int it = it0; const TDesc da = DESC_EXPR_OF_IT; tr_load(da, va, lane); \
        it = it0 + (STRIDE); const bool h1 = it < (COUNT); if (!h1) it = it0; const TDesc db = DESC_EXPR_OF_IT; tr_load(db, vb, lane); \
        it = it0 + 2 * (STRIDE); const bool h2 = it < (COUNT); if (!h2) it = it0; const TDesc dc = DESC_EXPR_OF_IT; tr_load(dc, vc, lane); \
        it = it0 + 3 * (STRIDE); const bool h3 = it < (COUNT); if (!h3) it = it0; const TDesc dd = DESC_EXPR_OF_IT; tr_load(dd, vd, lane); \
        tr_store(da, va, scr, lane); if (h1) tr_store(db, vb, scr, lane); if (h2) tr_store(dc, vc, scr, lane); if (h3) tr_store(dd, vd, scr, lane); } } while (0)

constexpr int SSM_PARTS = 4, SSM_CH = 16 / SSM_PARTS;
__device__ __forceinline__ void ssm_tables(const Params& P, int l, int g, int r, LAS unsigned char* scr) {
    int tid_ = threadIdx.x; asm volatile("" : "+v"(tid_)); const int tid = tid_;
    LAS f32x2* pw = (LAS f32x2*)scr;
    LAS f32x2* Bb = pw + 33 * 64;
    LAS f32x2* Cc = Bb + 64 * 16;
    LAS float* Kd = (LAS float*)(Cc + SSM_CH * 64);
    LAS float* Dk = Kd + 32 * SSM_CH * 16;
    const int lg = l * SSG + g;
    const float dt = expf(P.in[13][lg]);
    const float* lre = P.in[11] + (size_t)lg * 64; const float* lim = P.in[12] + (size_t)lg * 64;
    for (int idx = tid; idx < 33 * 64; idx += 512) { const int d = idx >> 6, p = idx & 63;
        const float mag = expf(lre[p] * dt * (float)d);
        const double ang = (double)lim[p] * (double)dt * (double)d * 0.15915494309189535; const float fr = (float)(ang - floor(ang));
        pw[idx] = (f32x2){mag * __builtin_amdgcn_cosf(fr), mag * __builtin_amdgcn_sinf(fr)}; }
    if (tid < SSM_CH) Dk[tid] = P.in[18][(size_t)lg * 16 + SSM_CH * r + tid];
    if (tid < SSM_CH * 64) { const int i = SSM_CH * r + (tid >> 6), p = tid & 63; Cc[tid] = (f32x2){P.in[16][((size_t)lg * 16 + i) * 64 + p], P.in[17][((size_t)lg * 16 + i) * 64 + p]}; }
    __syncthreads();
    for (int idx = tid; idx < 1024; idx += 512) { const int p = idx >> 4, j = idx & 15;
        const float ar = pw[64 + p].x - 1.0f, ai = pw[64 + p].y, cr = lre[p], ci = lim[p], den = 1.0f / (cr * cr + ci * ci);
        const float qr = (ar * cr + ai * ci) * den, qi = (ai * cr - ar * ci) * den;
        const float br = P.in[14][((size_t)lg * 64 + p) * 16 + j], bi = P.in[15][((size_t)lg * 64 + p) * 16 + j];
        Bb[idx] = (f32x2){qr * br - qi * bi, qr * bi + qi * br}; }
    __syncthreads();
    for (int idx = tid; idx < 32 * SSM_CH * 16; idx += 512) { const int d = idx / (SSM_CH * 16), ii = (idx >> 4) % SSM_CH, j = idx & 15; float s = 0.f;
        for (int p = 0; p < 64; ++p) { const f32x2 c = Cc[ii * 64 + p], w = pw[d * 64 + p], bq = Bb[p * 16 + j];
            const float tr = c.x * w.x - c.y * w.y, ti = c.x * w.y + c.y * w.x; s += tr * bq.x - ti * bq.y; }
        Kd[idx] = s; }
    __syncthreads();
    bf16_t* tm = (bf16_t*)(P.ws + WS_TMAT) + (size_t)g * 512 * KIN;
    for (int v = tid; v < 32 * SSM_CH * (KIN / 8); v += 512) { const int nn = v / (KIN / 8), k0 = (v % (KIN / 8)) * 8, t = nn / SSM_CH, ii = nn % SSM_CH, i = SSM_CH * r + ii, n = t * 16 + i; float e[8];
#pragma unroll
        for (int q = 0; q < 8; ++q) { const int k = k0 + q; float val;
            if (k < 512) { const int s = k >> 4, j = k & 15; val = (s <= t) ? Kd[((t - s) * SSM_CH + ii) * 16 + j] + ((s == t && i == j) ? Dk[ii] : 0.f) : 0.f; }
            else { const int p = (k - 512) & 63; const f32x2 c = Cc[ii * 64 + p], w = pw[(t + 1) * 64 + p]; val = (k < 576) ? (c.x * w.x - c.y * w.y) : -(c.x * w.y + c.y * w.x); }
            e[q] = val; }
        *(u32x4*)(tm + (size_t)n * KIN + k0) = (u32x4){cvt_pk_bf16(e[0], e[1]), cvt_pk_bf16(e[2], e[3]), cvt_pk_bf16(e[4], e[5]), cvt_pk_bf16(e[6], e[7])}; }
    bf16_t* wst = (bf16_t*)(P.ws + WS_WST) + (size_t)g * 256 * 512;
    for (int v = tid; v < (256 / SSM_PARTS) * 64; v += 512) { const int n = (256 / SSM_PARTS) * r + (v >> 6), k0 = (v & 63) * 8; float e[8];
#pragma unroll
        for (int q = 0; q < 8; ++q) { const int k = k0 + q, s = k >> 4, j = k & 15, p = n & 63; float val = 0.f;
            if (n < 128) { const f32x2 w = pw[(31 - s) * 64 + p], bq = Bb[p * 16 + j]; val = (n < 64) ? (w.x * bq.x - w.y * bq.y) : (w.x * bq.y + w.y * bq.x); }
            e[q] = val; }
        *(u32x4*)(wst + (size_t)n * 512 + k0) = (u32x4){cvt_pk_bf16(e[0], e[1]), cvt_pk_bf16(e[2], e[3]), cvt_pk_bf16(e[4], e[5]), cvt_pk_bf16(e[6], e[7])}; }
    if (r == 0 && tid < 64) { const f32x2 w = pw[32 * 64 + tid]; float* lam = (float*)(P.ws + WS_LAM) + (size_t)(g * 64 + tid) * 2; lam[0] = w.x; lam[1] = w.y; }
    __syncthreads();
}

__device__ __forceinline__ void router_weights(const Params& P, int l, int gtid, int gthreads) {
    bf16_t* wr = (bf16_t*)(P.ws + WS_WMIX + (size_t)l * WMIX_LAYER + WM_R);
    for (int idx = gtid; idx < 48 * 1024; idx += gthreads) { const int n = idx >> 10, k = idx & 1023; float v = 0.f;
        if (n < 4) v = P.in[22][((size_t)l * 1024 + k) * 4 + n]; else if (n < 36) v = P.in[23][((size_t)l * 1024 + k) * 32 + (n - 4)];
        wr[idx] = (bf16_t)f2bf(v * P.in[21][l * 1024 + k]); }
}

__device__ __forceinline__ void ssm_scan_task(const Params& P, int w, int lane) {
    const float* sst = (const float*)(P.ws + WS_SST); bf16_t* inb = (bf16_t*)(P.ws + WS_IN); const float* lam = (const float*)(P.ws + WS_LAM);
    const int g = w >> 4, b = w & 15;
    const float lr = lam[(g * 64 + lane) * 2], li = lam[(g * 64 + lane) * 2 + 1];
    const size_t r0 = (size_t)g * 1024 + b * 64;
    float sr[NCH], si[NCH];
#pragma unroll
    for (int c = 0; c < NCH; ++c) {
        sr[c] = __builtin_bit_cast(float, __hip_atomic_load((unsigned*)(sst + (r0 + c) * 128 + lane), __ATOMIC_RELAXED, __HIP_MEMORY_SCOPE_AGENT));
        si[c] = __builtin_bit_cast(float, __hip_atomic_load((unsigned*)(sst + (r0 + c) * 128 + 64 + lane), __ATOMIC_RELAXED, __HIP_MEMORY_SCOPE_AGENT)); }
    float xr = 0.f, xi = 0.f;
#pragma unroll
    for (int c = 0; c < NCH; ++c) {
        inb[(r0 + c) * KIN + 512 + lane] = (bf16_t)f2bf(xr); inb[(r0 + c) * KIN + 576 + lane] = (bf16_t)f2bf(xi);
        const float nr = lr * xr - li * xi + sr[c], ni = lr * xi + li * xr + si[c]; xr = nr; xi = ni; }
}

__device__ __forceinline__ void router_phase(const Params& P, int l, LAS unsigned char* lds, int G, int c) {
    int tid_ = threadIdx.x; asm volatile("" : "+v"(tid_));
    const int tid = tid_, wid = tid >> 6, lane = tid & 63;
    const bf16_t* xb = (const bf16_t*)(P.ws + WS_XB); const bf16_t* wr = (const bf16_t*)(P.ws + WS_WMIX + (size_t)l * WMIX_LAYER + WM_R);
    const float* ssx = (const float*)(P.ws + WS_SSX);
    int* te = (int*)(P.ws + WS_TE); float* tw = (float*)(P.ws + WS_TW); float* trs = (float*)(P.ws + WS_TRS); int* cnt = (int*)(P.ws + WS_CNT);
    LAS float* lg = (LAS float*)lds + wid * (16 * 48); LAS int* lcnt = (LAS int*)(lds + 8 * 16 * 48 * 4);
    constexpr int WRP = 2064; LAS unsigned char* wl = lds + 32768;
    for (int q = tid; q < 48 * 128; q += 512) { const int row = q >> 7, ch = q & 127; *(LAS u32x4*)(wl + row * WRP + ch * 16) = *(const u32x4*)(wr + (size_t)row * 1024 + ch * 8); }
    for (int j = c >> 3; j < MT / 1024; j += G >> 3) { const int blk = (MT / 1024) * (c & 7) + j;
        if (tid < 64) lcnt[tid] = 0;
        __syncthreads();
        const int t0 = blk * 128 + wid * 16;
        f32x4 a0 = {0.f, 0.f, 0.f, 0.f}, a1 = a0, a2 = a0;
        const bf16_t* ap = xb + (size_t)(t0 + (lane & 15)) * 1024 + 8 * (lane >> 4);
        const LAS unsigned char* bl = wl + (lane & 15) * WRP + 16 * (lane >> 4);
        bf16x8 af[32];
#pragma unroll
        for (int kk = 0; kk < 32; ++kk) af[kk] = *(const bf16x8*)(ap + kk * 32);
#pragma unroll
        for (int kk = 0; kk < 32; ++kk) { const bf16x8 b0 = *(const LAS bf16x8*)(bl + kk * 64), b1 = *(const LAS bf16x8*)(bl + 16 * WRP + kk * 64), b2 = *(const LAS bf16x8*)(bl + 32 * WRP + kk * 64);
            a0 = __builtin_amdgcn_mfma_f32_16x16x32_bf16(af[kk], b0, a0, 0, 0, 0); a1 = __builtin_amdgcn_mfma_f32_16x16x32_bf16(af[kk], b1, a1, 0, 0, 0); a2 = __builtin_amdgcn_mfma_f32_16x16x32_bf16(af[kk], b2, a2, 0, 0, 0); }
#pragma unroll
        for (int r = 0; r < 4; ++r) { const int trow = (lane >> 4) * 4 + r, col = lane & 15; lg[trow * 48 + col] = a0[r]; lg[trow * 48 + 16 + col] = a1[r]; lg[trow * 48 + 32 + col] = a2[r]; }
        asm volatile("s_waitcnt lgkmcnt(0)" ::: "memory");
        if (lane < 16) { const int tok = t0 + lane; const f32x4* sp = (const f32x4*)(ssx + (size_t)tok * 16); const f32x4 s0 = sp[0], s1 = sp[1], s2 = sp[2], s3 = sp[3];
            const float s = (((s0[0] + s0[1]) + (s0[2] + s0[3])) + ((s1[0] + s1[1]) + (s1[2] + s1[3]))) + (((s2[0] + s2[1]) + (s2[2] + s2[3])) + ((s3[0] + s3[1]) + (s3[2] + s3[3])));
            const float rs = __builtin_amdgcn_rsqf(s * (1.0f / 1024.0f) + EPS);
            float gl[4]; int gi = 0; float gm;
#pragma unroll
            for (int q = 0; q < 4; ++q) gl[q] = lg[lane * 48 + q] * rs;
            gm = gl[0];
#pragma unroll
            for (int q = 1; q < 4; ++q) if (gl[q] > gm) { gm = gl[q]; gi = q; }
            float gs = 0.f;
#pragma unroll
            for (int q = 0; q < 4; ++q) gs += expf(gl[q] - gm);
            const float gwt = 1.0f / gs;
            float el[8];
#pragma unroll
            for (int q = 0; q < 8; ++q) el[q] = lg[lane * 48 + 4 + gi * 8 + q] * rs;
            int i0 = 0; float m0 = el[0];
#pragma unroll
            for (int q = 1; q < 8; ++q) if (el[q] > m0) { m0 = el[q]; i0 = q; }
            int i1 = -1; float m1 = -3.0e38f;
#pragma unroll
            for (int q = 0; q < 8; ++q) if (q != i0 && el[q] > m1) { m1 = el[q]; i1 = q; }
            const float e1 = expf(m1 - m0), w0 = gwt / (1.0f + e1), w1 = gwt * e1 / (1.0f + e1);
            const int e0i = gi * 8 + i0, e1i = gi * 8 + i1;
            te[tok * 2] = e0i; te[tok * 2 + 1] = e1i; tw[tok * 2] = w0; tw[tok * 2 + 1] = w1; trs[tok] = rs;
            atomicAdd((int*)&lcnt[e0i], 1); atomicAdd((int*)&lcnt[32 + e1i], 1); }
        __syncthreads();
        if (tid < 64) cnt[blk * 64 + tid] = lcnt[tid];
        __syncthreads();
    }
}

__device__ __forceinline__ void scatter_phase(const Params& P, LAS unsigned char* lds, int G, int c) {
    int tid_ = threadIdx.x; asm volatile("" : "+v"(tid_)); const int tid = tid_;
    const int* te = (const int*)(P.ws + WS_TE); const float* tw = (const float*)(P.ws + WS_TW); const float* trs = (const float*)(P.ws + WS_TRS); const int* cnt = (const int*)(P.ws + WS_CNT);
    int* atok = (int*)(P.ws + WS_ATOK); float* aw = (float*)(P.ws + WS_AW); float* ars = (float*)(P.ws + WS_ARS); int* tseg = (int*)(P.ws + WS_TSEG);
    LAS int* tot = (LAS int*)lds; LAS int* bef = tot + 64; LAS int* base = bef + 64; LAS int* le = base + 65; LAS int* ptot = le + 256; LAS int* pbef = ptot + 512;
    for (int blk = c; blk < MT / 128; blk += G) {
        { const int sg = tid & 63, part = tid >> 6; int t = 0, b = 0;
#pragma unroll 8
          for (int q = part * 32; q < part * 32 + 32; ++q) { const int v = cnt[q * 64 + sg]; t += v; b += (q < blk) ? v : 0; }
          ptot[part * 64 + sg] = t; pbef[part * 64 + sg] = b; }
        if (tid < 256) le[tid] = te[blk * 256 + tid];
        __syncthreads();
        if (tid < 64) { int t = 0, b = 0;
#pragma unroll
            for (int q = 0; q < 8; ++q) { t += ptot[q * 64 + tid]; b += pbef[q * 64 + tid]; }
            tot[tid] = t; bef[tid] = b; }
        __syncthreads();
        if (tid == 0) { int s = 0; for (int q = 0; q < 64; ++q) { base[q] = s; s += (tot[q] + 255) & ~255; } base[64] = s; }
        __syncthreads();
        if (tid < 256) {
            const int i = tid >> 1, k = tid & 1, sg = k * 32 + le[tid]; int rank = 0;
            for (int a = 0; a < tid; ++a) rank += ((a & 1) * 32 + le[a] == sg) ? 1 : 0;
            const int tok = blk * 128 + i, pos = base[sg] + bef[sg] + rank;
            atok[pos] = tok; aw[pos] = tw[tok * 2 + k]; ars[pos] = trs[tok]; }
        if (blk < 64) {
            int neg1 = -1; asm volatile("" : "+v"(neg1));
            for (int r = base[blk] + tot[blk] + tid; r < base[blk + 1]; r += 512) { atok[r] = neg1; aw[r] = 0.f; ars[r] = 0.f; }
            for (int t = (base[blk] >> 8) + tid; t < (base[blk + 1] >> 8); t += 512) tseg[t] = blk;
            if (blk == 0 && tid == 0) { tseg[512] = base[32] >> 8; tseg[513] = base[64] >> 8; } }
        __syncthreads();
    }
}
__constant__ double ROPE_INVF[16] = {1.0, 0.5623413251903491, 0.31622776601683794, 0.1778279410038923, 0.1, 0.05623413251903491, 0.03162277660168379, 0.01778279410038923, 0.01,
                                     0.005623413251903491, 0.0031622776601683794, 0.0017782794100389228, 0.001, 0.0005623413251903491, 0.00031622776601683794, 0.00017782794100389227};
constexpr int PH_PER_LAYER = 11, NPH = 1 + PH_PER_LAYER * DEPTH;

__global__ void __launch_bounds__(512, 2) mk_fwd(Params P_) {
    extern __shared__ __attribute__((aligned(16))) unsigned char lds_raw[];
    LAS unsigned char* lds = (LAS unsigned char*)lds_raw;
    const int G = gridDim.x;
#define WSFENCE const Params P = load_params(); unsigned char* ws = P.ws; int tid_f = threadIdx.x, c_f = blockIdx.x; asm volatile("" : "+v"(tid_f), "+s"(c_f)); \
    const int tid = tid_f, lane = tid & 63, wid = __builtin_amdgcn_readfirstlane(tid >> 6), c = c_f, gw = c * 8 + wid, ngw = G * 8; (void)ws; (void)tid; (void)lane; (void)wid; (void)gw; (void)ngw
    volatile LAS unsigned* MISC = (volatile LAS unsigned*)(lds + MISC_OFF);
    if (threadIdx.x < 64) MISC[threadIdx.x] = 0u;
    __syncthreads();
    XcdBarrier bar; bar.bar = (unsigned*)(P_.ws + WS_CTL); bar.x = 0; bar.st = nullptr;
    const bool multi = (P_.ph_hi - P_.ph_lo) > 1;
    const bool multi_all = multi && P_.ph_lo == 0;
    if (multi) bar = xcd_barrier_post((unsigned*)(P_.ws + WS_CTL), MISC + 8);
    LAS int* idxlds = (LAS int*)(lds + IDX_OFF);
    const int lo = P_.ph_lo, hi = P_.ph_hi;
#ifndef PHMASK
#define PHMASK 0x7fff
#endif
#define IN(k) (lo <= (k) && (k) < hi)
#define EN(i) ((PHMASK >> (i)) & 1)
#ifndef REPMASK
#define REPMASK 0
#endif
#define REPS(i) (((REPMASK >> (i)) & 1) ? 2 : 1)
#define SEAM(k) do { if (IN(k) && IN((k) + 1)) xcd_barrier(bar); } while (0)
#define XB_XID      4096
#define XB_NOLOCAL  8192
#define XB_PUBC     8256
#define XB_PUBX     8320
#define XB_PUB(slot) do { if (multi_all) { asm volatile("s_waitcnt vmcnt(0)" ::: "memory"); __syncthreads(); \
        if (tid == 0) { unsigned* cw_ = (unsigned*)(ws + WS_CTL); const unsigned nloc_ = bar.st[0]; \
            const unsigned old_ = nloc_ ? __hip_atomic_fetch_add(cw_ + XB_PUBX + 16 * (slot) + bar.x, 1u, __ATOMIC_RELAXED, __HIP_MEMORY_SCOPE_AGENT) : 0u; \
            if (nloc_ == 0u || old_ + 1u == nloc_) { __builtin_amdgcn_fence(__ATOMIC_RELEASE, "agent"); asm volatile("s_waitcnt vmcnt(0)" ::: "memory"); \
                __hip_atomic_fetch_add(cw_ + XB_PUBC + (slot), nloc_ ? nloc_ : 1u, __ATOMIC_RELAXED, __HIP_MEMORY_SCOPE_AGENT); } } } } while (0)
#define XB_AWAIT(slot) do { if (multi_all) { if (tid == 0) { unsigned* cw_ = (unsigned*)(ws + WS_CTL); XB_SPIN(xb_ld(cw_ + XB_PUBC + (slot)) < (unsigned)G, cw_); \
            __builtin_amdgcn_fence(__ATOMIC_ACQUIRE, "agent"); asm volatile("s_waitcnt vmcnt(0)" ::: "memory"); } __syncthreads(); } } while (0)
#define SEAM_LOCAL(k) do { if (IN(k) && IN((k) + 1)) { if (multi_all && xb_ld(&bar.bar[XB_NOLOCAL]) == 0u) xcd_barrier<true>(bar); else xcd_barrier(bar); } } while (0)

    if (EN(0) && IN(0)) { WSFENCE;
        if (tid == 0) __hip_atomic_store(&((unsigned*)(ws + WS_CTL))[XB_XID + c], xb_xcc_id() + 1u, __ATOMIC_RELAXED, __HIP_MEMORY_SCOPE_AGENT);
        LAS float* scr = (LAS float*)(lds + wid * 8448);
        TR_LOOP(mixw_desc(P, it), gw, MIXW_ITEMS, ngw);
        router_weights(P, 0, c * 512 + tid, G * 512); router_weights(P, 1, c * 512 + tid, G * 512);
        {
            const int* pos = (const int*)P.in[1]; float* rope = (float*)(ws + WS_ROPE);
            for (int idx = c * 512 + tid; idx < MT * 16; idx += G * 512) { const int tok = idx >> 4, i = idx & 15;
                const double t = (double)pos[tok] * ROPE_INVF[i] * 0.15915494309189535; const float fr = (float)(t - floor(t));
                const float cs = __builtin_amdgcn_cosf(fr), sn = __builtin_amdgcn_sinf(fr); bf16_t* ropeb = (bf16_t*)(ws + WS_ROPEB);
                rope[(size_t)tok * 32 + i] = cs; rope[(size_t)tok * 32 + 16 + i] = sn; ropeb[(size_t)tok * 32 + i] = (bf16_t)f2bf(cs); ropeb[(size_t)tok * 32 + 16 + i] = (bf16_t)f2bf(sn); }
        }
        {
            const float* x = P.in[0]; bf16_t* xb = (bf16_t*)(ws + WS_XB); float* ssx = (float*)(ws + WS_SSX);
            if (!(P.variant & 256)) for (int m = gw; m < MT; m += ngw) { const f32x4* xr = (const f32x4*)(x + (size_t)m * DM) + lane; f32x4 v[4]; float s = 0.f;
#pragma unroll
                for (int j = 0; j < 4; ++j) { v[j] = __builtin_nontemporal_load(xr + 64 * j); s += (v[j][0] * v[j][0] + v[j][1] * v[j][1]) + (v[j][2] * v[j][2] + v[j][3] * v[j][3]); }
                s = wave_sum(s);
                u32x2* o = (u32x2*)(xb + (size_t)m * DM) + lane;
#pragma unroll
                for (int j = 0; j < 4; ++j) { u32x2 w; w.x = cvt_pk_bf16(v[j][0], v[j][1]); w.y = cvt_pk_bf16(v[j][2], v[j][3]); o[64 * j] = w; }
                if (lane < 16) ssx[(size_t)m * 16 + lane] = lane == 0 ? s : 0.f; }
        }
    }
    SEAM(0);

    for (int l = 0; l < DEPTH; ++l) {
        const int pb = 1 + PH_PER_LAYER * l;
        if (EN(1) && IN(pb + 0)) { WSFENCE;
            if (l == 0 && tid < 64) {
                unsigned* bw = (unsigned*)(ws + WS_CTL); const unsigned mine = xb_xcc_id() + 1u; bool bad = (G & 7) != 0;
                for (int j = tid; j < (G >> 3); j += 64) bad = bad || (xb_ld(&bw[XB_XID + 8 * j + (c & 7)]) != mine);
                if (bad) __hip_atomic_store(&bw[XB_NOLOCAL], 1u, __ATOMIC_RELAXED, __HIP_MEMORY_SCOPE_AGENT); }
            pg8::Gemm g{(const bf16_t*)(ws + WS_XB), (const bf16_t*)(ws + WS_WMIX + (size_t)l * WMIX_LAYER + WM_IN), 1024, 1024, (P.variant >> 4) & 1}; pg8::StaticOrder S; S.init(MT, NIN, G, c);
            { const int nu = (MT / 256) * (NIN / 256), nshort = G - nu % G, first = nu % G;
              if (nu % G == 0) { for (int t = c; t < SSG * SSM_PARTS; t += G) ssm_tables(P, l, t / SSM_PARTS, t % SSM_PARTS, lds); }
              else if (c >= first) { for (int t = c - first; t < SSG * SSM_PARTS; t += nshort) ssm_tables(P, l, t / SSM_PARTS, t % SSM_PARTS, lds); }
              __syncthreads();
              { LAS float* scr = (LAS float*)(lds + 32768 + wid * 8448);
                if (nu % G == 0) TR_LOOP(expw_desc(P, l, it), gw, EXPW_EARLY, ngw);
                else if (c >= first) TR_LOOP(expw_desc(P, l, it), (c - first) * 8 + wid, EXPW_EARLY, nshort * 8); }
              __syncthreads(); }
            EpiIn E{ws};
            pg8::gemm_phase<EpiIn, pg8::StaticOrder>(lds, idxlds, g, S, E);
            XB_PUB(3 * l);
        }
        SEAM_LOCAL(pb + 0);
        if (EN(2) && IN(pb + 1)) { WSFENCE;
            { pg8::Gemm g{(const bf16_t*)(ws + WS_QC), (const bf16_t*)(ws + WS_WMIX + (size_t)l * WMIX_LAYER + WM_UQ), 384, 384, (P.variant >> 10) & 1}; pg8::StaticOrder S; S.init(MT, 768, G, c);
              EpiPlain E{ws, WS_TQ, 768}; pg8::gemm_phase<EpiPlain, pg8::StaticOrder>(lds, idxlds, g, S, E); }
            { pg8::Gemm g{(const bf16_t*)(ws + WS_KVC), (const bf16_t*)(ws + WS_WMIX + (size_t)l * WMIX_LAYER + WM_UKV), 256, 256, (P.variant >> 11) & 1}; pg8::StaticOrder S; S.init(MT, 1024, G, c);
              LAS float* gkl = (LAS float*)(lds + MISC_OFF + 256);
              if (tid < 96) gkl[tid] = P.in[9][l * 96 + tid];
              __syncthreads();
              EpiKV E{ws, gkl};
              pg8::gemm_phase<EpiKV, pg8::StaticOrder>(lds, idxlds, g, S, E); }
            XB_AWAIT(3 * l);
            { pg8::Gemm g{(const bf16_t*)(ws + WS_IN), (const bf16_t*)(ws + WS_WST), 512, KIN, (P.variant >> 12) & 1}; SsmSOrder S{G, c};
              EpiS E{ws}; pg8::gemm_phase<EpiS, SsmSOrder>(lds, idxlds, g, S, E);
              for (int L = (c + G / 2) % G; L < 128; L += G) { asm volatile("s_waitcnt vmcnt(0)" ::: "memory"); __syncthreads();
                  if (wid < 4) ssm_scan_task(P, (L >> 2) * 16 + 4 * (L & 3) + wid, lane); } }
        }
        SEAM_LOCAL(pb + 1);
        if (EN(3) && IN(pb + 2)) { WSFENCE;
            const float* gk = P.in[9] + l * 96;
            float gmx = fmaxf(fabsf(gk[lane]), lane < 32 ? fabsf(gk[64 + lane]) : 0.f); gmx = wave_max(gmx);
            const float kbound = 9.797958971132712f * gmx;
            __syncthreads();
            for (int j = c >> 3; j < 32; j += G >> 3) for (int k4 = 0; k4 < 4; ++k4) { const int b = 2 * (c & 7) + (j & 1), h = (j >> 1) & 7;
                const int qb = (j >> 4) == 0 ? ((k4 == 0) ? 7 : (k4 == 1) ? 0 : (k4 == 2) ? 5 : 2) : ((k4 == 0) ? 6 : (k4 == 1) ? 1 : (k4 == 2) ? 4 : 3);
                att::attn_unit((char*)lds_raw, b, h, qb, (const bf16_t*)(ws + WS_TQ), (const float*)(ws + WS_QSS), (const float*)(ws + WS_ROPE), P.in[8] + l * 96, kbound,
                               (const bf16_t*)(ws + WS_KB), (const bf16_t*)(ws + WS_VB), (bf16_t*)(ws + WS_OB), P.variant);
                __syncthreads(); }
        }
        SEAM(pb + 2);
        if (EN(4) && IN(pb + 3)) { WSFENCE;
            { pg8::Gemm g{(const bf16_t*)(ws + WS_IN), (const bf16_t*)(ws + WS_TMAT), KIN, KIN}; SsmYOrder S{G, c};
              EpiY E{ws}; pg8::gemm_phase<EpiY, SsmYOrder>(lds, idxlds, g, S, E);
              XB_PUB(3 * l + 1); }
            { pg8::Gemm g{(const bf16_t*)(ws + WS_OB), (const bf16_t*)(ws + WS_WMIX + (size_t)l * WMIX_LAYER + WM_PROJ), 512, 512}; pg8::StaticOrder S; S.init(MT, 1024, G, c);
              EpiProj E{ws}; pg8::gemm_phase<EpiProj, pg8::StaticOrder>(lds, idxlds, g, S, E); }
        }
        SEAM_LOCAL(pb + 3);
        if (EN(5) && IN(pb + 4)) { WSFENCE;
            XB_AWAIT(3 * l + 1);
            pg8::Gemm g{(const bf16_t*)(ws + WS_YB), (const bf16_t*)(ws + WS_WMIX + (size_t)l * WMIX_LAYER + WM_GLU), 512, 512, (P.variant >> 4) & 1}; pg8::StaticOrder S; S.init(MT, 2048, G, c);
            EpiGlu E{ws}; pg8::gemm_phase<EpiGlu, pg8::StaticOrder>(lds, idxlds, g, S, E);
        }
        SEAM_LOCAL(pb + 4);
        if (EN(6) && IN(pb + 5)) { WSFENCE;
            pg8::Gemm g{(const bf16_t*)(ws + WS_MG), (const bf16_t*)(ws + WS_WMIX + (size_t)l * WMIX_LAYER + WM_OUT), 1024, 1024}; pg8::StaticOrder S; S.init(MT, 1024, G, c);
            EpiOut E{ws}; pg8::gemm_phase<EpiOut, pg8::StaticOrder>(lds, idxlds, g, S, E);
        }
        SEAM_LOCAL(pb + 5);
        if (EN(7) && IN(pb + 6)) { WSFENCE;
            if (!(P.variant & 64)) router_phase(P, l, lds, G, c);
            if (multi_all) XB_PUB(3 * l + 2);
            { LAS float* scr = (LAS float*)(lds + 32768 + wid * 8448);
              TR_LOOP(expw_desc(P, l, it), EXPW_EARLY + gw, EXPW_ITEMS, ngw); }
            __syncthreads();
            if (multi_all) { XB_AWAIT(3 * l + 2); scatter_phase(P, lds, G, c); }
        }
        SEAM(pb + 6);
        if (!multi_all) { if (EN(8) && IN(pb + 7)) { WSFENCE; scatter_phase(P, lds, G, c); } SEAM(pb + 7); }
        if (EN(9) && IN(pb + 8)) { WSFENCE;
            const int* tseg = (const int*)(ws + WS_TSEG); const int ntT = tseg[513];
            pg8::Gemm g{(const bf16_t*)(ws + WS_XB), (const bf16_t*)(ws + WS_WGU), 1024, 1024};
            MoeGatherOrder S; S.tseg = tseg; S.tile0 = 0; S.ntile = ntT; S.NC = 2; S.G = G; S.c = c; S.gidx = (const int*)(ws + WS_ATOK); S.lmax = 2 * G;
            EpiGU E{ws}; pg8::gemm_phase<EpiGU, MoeGatherOrder>(lds, idxlds, g, S, E);
        }
        SEAM(pb + 8);
        if (EN(10) && IN(pb + 9)) { WSFENCE;
            const int* tseg = (const int*)(ws + WS_TSEG); const int ntA = tseg[512], ntT = tseg[513];
            const int nleft = (2 * ntT > 2 * G) ? 2 * ntT - 2 * G : 0;
            if (nleft > 0) { pg8::Gemm g{(const bf16_t*)(ws + WS_XB), (const bf16_t*)(ws + WS_WGU), 1024, 1024};
                MoeGatherOrder S; S.tseg = tseg; S.tile0 = 0; S.ntile = ntT; S.NC = 2; S.G = G; S.c = c; S.gidx = (const int*)(ws + WS_ATOK); S.loff = 2 * G;
                EpiGU E{ws}; pg8::gemm_phase<EpiGU, MoeGatherOrder>(lds, idxlds, g, S, E); }
            pg8::Gemm g{(const bf16_t*)(ws + WS_HH), (const bf16_t*)(ws + WS_WD), 256, 256};
            MoeDownAOrder S; S.tseg = tseg; S.tile0 = 0; S.ntile = ntA; S.NC = 4; S.G = G; S.c = c; S.nbusy = nleft < G ? nleft : G - 1;
            S.tl = moe_tail(4 * ntA, 2 * (G - S.nbusy), G);
            EpiDown<false> E{ws, nullptr, S.tl.s > 1 ? S.vcu() % S.tl.s : -1, S.tl.lthr, 0, S.tl.s}; pg8::gemm_phase<EpiDown<false>, MoeDownAOrder>(lds, idxlds, g, S, E);
        }
        SEAM(pb + 9);
        if (EN(11) && IN(pb + 10) && l + 1 < DEPTH) { WSFENCE;
            const int* tseg = (const int*)(ws + WS_TSEG); const int nU = (tseg[513] - tseg[512]) * 4, first = nU % G, nshort = G - first, vc = (G % 8 == 0) ? (c % 8) * (G / 8) + c / 8 : c;
            if (vc >= first) { LAS float* scr = (LAS float*)(lds + wid * 8448); TR_LOOP(mixw_desc(P, it), (l + 1) * MIXW_ITEMS + (vc - first) * 8 + wid, (l + 2) * MIXW_ITEMS, nshort * 8); }
            __syncthreads();
        }
        if (EN(11) && IN(pb + 10)) { WSFENCE;
            const int* tseg = (const int*)(ws + WS_TSEG); const int ntA = tseg[512], ntT = tseg[513];
            pg8::Gemm g{(const bf16_t*)(ws + WS_HH), (const bf16_t*)(ws + WS_WD), 256, 256, (P.variant >> 13) & 1};
            MoeDownBOrder S; S.tseg = tseg; S.tile0 = ntA; S.ntile = ntT - ntA; S.NC = 4; S.G = G; S.c = c;
            S.tl = moe_tail((ntT - ntA) * 4, 0, G); S.split = (l + 1 == DEPTH) ? 1 : 0;
            EpiDown<true> E{ws, l + 1 == DEPTH ? P.out : nullptr, (S.split && S.tl.s > 1) ? S.vcu() % S.tl.s : -1, S.tl.lthr, ntA, S.tl.s}; pg8::gemm_phase<EpiDown<true>, MoeDownBOrder>(lds, idxlds, g, S, E);
        }
        SEAM(pb + 10);
    }
#undef IN
#undef SEAM
}

#ifndef MK_PER_PHASE
#define MK_PER_PHASE 0
#endif
extern "C" void kernel_launch(void* const* d_in, const int* in_sizes, int n_in, void* d_out, int out_size, void* d_ws, size_t ws_size, hipStream_t stream) {
    static int grid = 0;
    if (grid == 0) {
        if (n_in != 27 || in_sizes[0] != MT * DM || out_size != MT * DM || ws_size < WS_END) {
            fprintf(stderr, "kernel_launch: unexpected shapes: n_in %d in0 %d out %d ws %zu (need %zu)\n", n_in, n_in > 0 ? in_sizes[0] : -1, out_size, ws_size, (size_t)WS_END); grid = -1; return; }
        int dev = 0, cus = 0, per_cu = 0;
        if (hipGetDevice(&dev) != hipSuccess || hipDeviceGetAttribute(&cus, hipDeviceAttributeMultiprocessorCount, dev) != hipSuccess) { grid = -1; return; }
        if (hipFuncSetAttribute((const void*)mk_fwd, hipFuncAttributeMaxDynamicSharedMemorySize, LDS_BYTES) != hipSuccess) { fprintf(stderr, "kernel_launch: hipFuncSetAttribute failed\n"); grid = -1; return; }
        if (hipOccupancyMaxActiveBlocksPerMultiprocessor(&per_cu, (const void*)mk_fwd, 512, LDS_BYTES) != hipSuccess || per_cu < 1)
            fprintf(stderr, "kernel_launch: occupancy query reports %d workgroups per CU\n", per_cu);
        (void)hipGetLastError();
        grid = cus;
    }
    if (grid < 0) return;
    if (hipMemsetAsync((char*)d_ws + WS_CTL, 0, CTL_ZERO_BYTES, stream) != hipSuccess) return;
    Params p{};
    for (int i = 0; i < 27; ++i) p.in[i] = (const float*)d_in[i];
    p.out = (float*)d_out; p.ws = (unsigned char*)d_ws;
#if MK_PER_PHASE
    for (int ph = 0; ph < NPH; ++ph) { p.ph_lo = ph; p.ph_hi = ph + 1; hipLaunchKernelGGL(mk_fwd, dim3(grid), dim3(512), LDS_BYTES, stream, p); }
#else
    p.ph_lo = 0; p.ph_hi = NPH; hipLaunchKernelGGL(mk_fwd, dim3(grid), dim3(512), LDS_BYTES, stream, p);
#endif
#ifdef PROBE_PHASES
    p.out = (float*)((unsigned char*)d_ws + WS_S5G);
#ifdef PROBE_VARIANT
    p.variant = PROBE_VARIANT;
#endif
    for (int l = 0; l < DEPTH; ++l) for (int k = 0; k < PH_PER_LAYER; ++k) if ((PROBE_PHASES >> k) & 1) { p.ph_lo = 1 + PH_PER_LAYER * l + k; p.ph_hi = p.ph_lo + 1; hipLaunchKernelGGL(mk_fwd, dim3(grid), dim3(512), LDS_BYTES, stream, p); }
    if ((PROBE_PHASES >> 14) & 1) { p.ph_lo = 0; p.ph_hi = 1; hipLaunchKernelGGL(mk_fwd, dim3(grid), dim3(512), LDS_BYTES, stream, p); }
#endif
    const hipError_t le = hipPeekAtLastError();
    if (le != hipSuccess) fprintf(stderr, "kernel_launch: launch failed: %s\n", hipGetErrorName(le));
}
```
